# Optimizing an MI355X kernel written in HIP

```python
import math
import jax, jax.numpy as jnp
from jax import lax
import numpy as np

D_MODEL = 1024
BATCH = 32
SEQ = 256
DEPTH = 2
DEC_BATCH = 4
DEC_SEQ = 2048
PAST_LEN = 512

GRID_W = 64
D_MIX = 1024
DIFF_HEADS = 4
DIFF_HD = 32
DIFF_VD = 64
LRU_W = 512
LRU_BLOCKS = 8
LRU_BW = 64
CONV_W = 4
CONV_LEFT = 2
LRU_C = 8.0
MLA_HEADS = 4
Q_RANK = 192
KV_RANK = 128
NOPE_DIM = 64
ROPE_DIM = 32
MLA_VD = 64
QK_DIM = 96
D_FF = 2816
N_MOD = 9
ROPE_BASE = 10000.0
Q_BLOCK = 128
EPS = 1e-6
SPLITS = [256, 256, 256, 512, 512, 192, 128, 32]
D_IN = 2144

kernel_name = "hybrid_diff_lru_mla_prefix_dit_step"


def rmsnorm(x, g):
    xf = x.astype(jnp.float32)
    y = xf * lax.rsqrt(jnp.mean(xf * xf, axis=-1, keepdims=True) + EPS)
    return (y * g.astype(jnp.float32)).astype(x.dtype)


def swiglu(h, w_in, w_out):
    g, u = jnp.split(h @ w_in, 2, axis=-1)
    return (jax.nn.silu(g) * u) @ w_out


def axial_rope(T, dim):
    rows = T // GRID_W
    row = jnp.repeat(jnp.arange(rows), GRID_W).astype(jnp.float32)
    col = jnp.tile(jnp.arange(GRID_W), rows).astype(jnp.float32)
    n = dim // 4
    inv = ROPE_BASE ** (-jnp.arange(n, dtype=jnp.float32) / n)
    ang = jnp.concatenate([row[:, None] * inv, col[:, None] * inv], axis=-1)
    return jnp.cos(ang), jnp.sin(ang)


def apply_rope(x, cos, sin):
    half = x.shape[-1] // 2
    shape = (cos.shape[0],) + (1,) * (x.ndim - 3) + (half,)
    c = cos.reshape(shape)
    s = sin.reshape(shape)
    x1 = x[..., :half].astype(jnp.float32)
    x2 = x[..., half:].astype(jnp.float32)
    return jnp.concatenate([x1 * c - x2 * s, x2 * c + x1 * s], axis=-1).astype(x.dtype)


def over_query_blocks(fn, q):
    B, T = q.shape[:2]
    nb = T // Q_BLOCK
    qb = jnp.moveaxis(q.reshape((B, nb, Q_BLOCK) + q.shape[2:]), 1, 0)
    ob = jnp.moveaxis(lax.map(fn, qb), 0, 1)
    return ob.reshape((B, T) + ob.shape[3:])


def diff_attention(q, k, v, lam):
    scale = DIFF_HD ** -0.5
    kf = k.astype(jnp.float32)
    vf = v.astype(jnp.float32)

    def block(qb):
        s = jnp.einsum("bqhcd,bkhcd->bchqk", qb.astype(jnp.float32), kf) * scale
        p = jax.nn.softmax(s, axis=-1)
        a = p[:, 0] - lam * p[:, 1]
        return jnp.einsum("bhqk,bkhv->bqhv", a, vf)

    return over_query_blocks(block, q)


def softmax_attention(q, k, v):
    scale = q.shape[-1] ** -0.5
    kf = k.astype(jnp.float32)
    vf = v.astype(jnp.float32)

    def block(qb):
        s = jnp.einsum("bqhd,bkhd->bhqk", qb.astype(jnp.float32), kf) * scale
        p = jax.nn.softmax(s, axis=-1)
        return jnp.einsum("bhqk,bkhv->bqhv", p, vf)

    return over_query_blocks(block, q)


def dwconv(x, w, b):
    T = x.shape[1]
    xp = jnp.pad(x, ((0, 0), (CONV_LEFT, CONV_W - 1 - CONV_LEFT), (0, 0)))
    out = xp[:, 0:T] * w[0]
    for j in range(1, CONV_W):
        out = out + xp[:, j:j + T] * w[j]
    return out + b


def rglru(x, h0, w_gate, b_gate, lam, reverse):
    B, T, W = x.shape
    xb = x.reshape(B, T, LRU_BLOCKS, LRU_BW)
    g = jnp.einsum("btnc,gncd->gbtnd", xb, w_gate.astype(jnp.float32)).reshape(2, B, T, W)
    g = g + b_gate.astype(jnp.float32)[:, None, None, :]
    r = jax.nn.sigmoid(g[0])
    i = jax.nn.sigmoid(g[1])
    log_a = -LRU_C * r * jax.nn.softplus(-lam.astype(jnp.float32))
    a = jnp.exp(log_a)
    b = jnp.sqrt(-jnp.expm1(2.0 * log_a)) * (i * x)

    def combine(e1, e2):
        a1, b1 = e1
        a2, b2 = e2
        return a1 * a2, a2 * b1 + b2

    A, Bs = lax.associative_scan(combine, (a, b), axis=1, reverse=reverse)
    h = A * h0.astype(jnp.float32)[:, None, :] + Bs
    final = h[:, 0] if reverse else h[:, -1]
    return h, final


def mla_keys_values(c_lat, k_rope, w_ukv, g_k, rope):
    B, Tk = c_lat.shape[:2]
    kv = (c_lat @ w_ukv).reshape(B, Tk, MLA_HEADS, NOPE_DIM + MLA_VD)
    k_nope, v = kv[..., :NOPE_DIM], kv[..., NOPE_DIM:]
    k_r = jnp.broadcast_to(k_rope[:, :, None, :], (B, Tk, MLA_HEADS, ROPE_DIM)).astype(k_nope.dtype)
    k = rmsnorm(jnp.concatenate([k_nope, k_r], axis=-1), g_k)
    if rope is not None:
        k = jnp.concatenate([k[..., :NOPE_DIM], apply_rope(k[..., NOPE_DIM:], rope[0], rope[1])], axis=-1)
    return k, v


def mixer(h, p, lidx, ctx):
    B, T, _ = h.shape
    dt = h.dtype
    latent = ctx is not None
    offs = [int(o) for o in np.cumsum(SPLITS)[:-1]]
    qa, ka, va, xb, gb, cq, ckv, kr = jnp.split(h @ p["w_in"], offs, axis=-1)

    qa = rmsnorm(qa.reshape(B, T, DIFF_HEADS, 2, DIFF_HD), p["diff_qk_norm"][0])
    ka = rmsnorm(ka.reshape(B, T, DIFF_HEADS, 2, DIFF_HD), p["diff_qk_norm"][1])
    va = va.reshape(B, T, DIFF_HEADS, DIFF_VD)
    lam_init = 0.8 - 0.6 * math.exp(-0.3 * lidx)
    lp = p["diff_lambda"].astype(jnp.float32)
    lam = jnp.exp(jnp.sum(lp[0] * lp[1])) - jnp.exp(jnp.sum(lp[2] * lp[3])) + lam_init
    if latent:
        cos_d, sin_d = axial_rope(T, DIFF_HD)
        q_rot = apply_rope(qa, cos_d, sin_d)
        k_all = jnp.concatenate([ctx["diff_k"].astype(dt), apply_rope(ka, cos_d, sin_d)], axis=1)
        v_all = jnp.concatenate([ctx["diff_v"].astype(dt), va], axis=1)
        o_a = diff_attention(q_rot, k_all, v_all, lam)
    else:
        o_a = diff_attention(qa, ka, va, lam)
    o_a = (rmsnorm(o_a, p["diff_subln"]) * (1.0 - lam_init)).astype(dt).reshape(B, T, DIFF_HEADS * DIFF_VD)

    xc = dwconv(xb, p["lru_conv_w"], p["lru_conv_b"]).astype(jnp.float32)
    h0 = ctx["lru"] if latent else jnp.zeros((B, 2, LRU_W), jnp.float32)
    hf, sf = rglru(xc, h0[:, 0], p["lru_w_gate"][0], p["lru_b_gate"][0], p["lru_lambda"][0], False)
    hb, sb = rglru(xc, h0[:, 1], p["lru_w_gate"][1], p["lru_b_gate"][1], p["lru_lambda"][1], True)
    o_b = ((hf + hb) * jax.nn.gelu(gb.astype(jnp.float32))).astype(dt)

    cq = rmsnorm(cq, p["mla_cq_norm"])
    qc = rmsnorm((cq @ p["mla_w_uq"]).reshape(B, T, MLA_HEADS, QK_DIM), p["mla_qk_norm"][0])
    ckv_n = rmsnorm(ckv, p["mla_ckv_norm"])
    if latent:
        rope_m = axial_rope(T, ROPE_DIM)
        qc = jnp.concatenate([qc[..., :NOPE_DIM], apply_rope(qc[..., NOPE_DIM:], rope_m[0], rope_m[1])], axis=-1)
        k_ctx, v_ctx = mla_keys_values(ctx["ckv"].astype(dt), ctx["krope"].astype(dt), p["mla_w_ukv"], p["mla_qk_norm"][1], None)
        k_lat, v_lat = mla_keys_values(ckv_n, kr, p["mla_w_ukv"], p["mla_qk_norm"][1], rope_m)
        o_c = softmax_attention(qc, jnp.concatenate([k_ctx, k_lat], axis=1), jnp.concatenate([v_ctx, v_lat], axis=1))
    else:
        k_c, v_c = mla_keys_values(ckv_n, kr, p["mla_w_ukv"], p["mla_qk_norm"][1], None)
        o_c = softmax_attention(qc, k_c, v_c)
    o_c = o_c.astype(dt).reshape(B, T, MLA_HEADS * MLA_VD)

    out = jnp.concatenate([o_a, o_b, o_c], axis=-1) @ p["w_out"]
    if latent:
        return out, None
    return out, (ka, va, ckv_n, kr, jnp.stack([sf, sb], axis=1))


def trunk_layer(x, cond, p, lidx, ctx):
    mod = jax.nn.silu(cond.astype(jnp.float32)) @ p["w_ada"] + p["b_ada"]
    mod = mod.reshape(cond.shape[0], N_MOD, 1, D_MODEL).astype(x.dtype)
    g = p["norm_g"]
    h = rmsnorm(x, g[0]) * (1.0 + mod[:, 1]) + mod[:, 0]
    x = x + 0.5 * mod[:, 2] * swiglu(h, p["w_ffn_in"][0], p["w_ffn_out"][0])
    h = rmsnorm(x, g[1]) * (1.0 + mod[:, 4]) + mod[:, 3]
    m, new_ctx = mixer(h, p, lidx, ctx)
    x = x + mod[:, 5] * m
    h = rmsnorm(x, g[2]) * (1.0 + mod[:, 7]) + mod[:, 6]
    x = x + 0.5 * mod[:, 8] * swiglu(h, p["w_ffn_in"][1], p["w_ffn_out"][1])
    return x, new_ctx


def setup_inputs(seed: int = 0) -> dict:
    key = jax.random.key(seed)
    ks = jax.random.split(key, 32)

    def nrm(k, shape, scale):
        return jax.random.normal(k, shape, jnp.float32) * scale

    def gain(k, shape):
        return 1.0 + 0.05 * jax.random.normal(k, shape, jnp.float32)

    return {
        "x_prompt": nrm(ks[0], (BATCH, SEQ, D_MODEL), 1.0),
        "x_sample": nrm(ks[1], (DEC_BATCH, DEC_SEQ, D_MODEL), 1.0),
        "cache_diff_k": nrm(ks[2], (DEC_BATCH, DEPTH, PAST_LEN, DIFF_HEADS, 2, DIFF_HD), 1.0),
        "cache_diff_v": nrm(ks[3], (DEC_BATCH, DEPTH, PAST_LEN, DIFF_HEADS, DIFF_VD), 1.0),
        "cache_mla_ckv": nrm(ks[4], (DEC_BATCH, DEPTH, PAST_LEN, KV_RANK), 1.0),
        "cache_mla_krope": nrm(ks[5], (DEC_BATCH, DEPTH, PAST_LEN, ROPE_DIM), 1.0),
        "state_lru": nrm(ks[6], (DEC_BATCH, DEPTH, 2, LRU_W), 0.5),
        "c": nrm(ks[7], (DEC_BATCH, D_MODEL), 1.0),
        "c_ctx": nrm(ks[8], (D_MODEL,), 1.0),
        "norm_g": gain(ks[9], (DEPTH, 3, D_MODEL)),
        "w_ada": nrm(ks[10], (DEPTH, D_MODEL, N_MOD * D_MODEL), 0.5 * D_MODEL ** -0.5),
        "b_ada": nrm(ks[11], (DEPTH, N_MOD * D_MODEL), 0.02),
        "w_ffn_in": nrm(ks[12], (DEPTH, 2, D_MODEL, 2 * D_FF), D_MODEL ** -0.5),
        "w_ffn_out": nrm(ks[13], (DEPTH, 2, D_FF, D_MODEL), D_FF ** -0.5),
        "w_in": nrm(ks[14], (DEPTH, D_MODEL, D_IN), D_MODEL ** -0.5),
        "w_out": nrm(ks[15], (DEPTH, D_MIX, D_MODEL), D_MIX ** -0.5),
        "diff_qk_norm": gain(ks[16], (DEPTH, 2, DIFF_HD)),
        "diff_lambda": nrm(ks[17], (DEPTH, 4, DIFF_HD), 0.1),
        "diff_subln": gain(ks[18], (DEPTH, DIFF_VD)),
        "lru_conv_w": nrm(ks[19], (DEPTH, CONV_W, LRU_W), CONV_W ** -0.5),
        "lru_conv_b": nrm(ks[20], (DEPTH, LRU_W), 0.02),
        "lru_w_gate": nrm(ks[21], (DEPTH, 2, 2, LRU_BLOCKS, LRU_BW, LRU_BW), LRU_BW ** -0.5),
        "lru_b_gate": nrm(ks[22], (DEPTH, 2, 2, LRU_W), 0.02),
        "lru_lambda": jax.random.uniform(ks[23], (DEPTH, 2, LRU_W), jnp.float32, 2.0, 6.0),
        "mla_cq_norm": gain(ks[24], (DEPTH, Q_RANK)),
        "mla_ckv_norm": gain(ks[25], (DEPTH, KV_RANK)),
        "mla_w_uq": nrm(ks[26], (DEPTH, Q_RANK, MLA_HEADS * QK_DIM), Q_RANK ** -0.5),
        "mla_w_ukv": nrm(ks[27], (DEPTH, KV_RANK, MLA_HEADS * (NOPE_DIM + MLA_VD)), KV_RANK ** -0.5),
        "mla_qk_norm": gain(ks[28], (DEPTH, 2, QK_DIM)),
    }


def reference(x_prompt, x_sample, cache_diff_k, cache_diff_v, cache_mla_ckv, cache_mla_krope, state_lru, c, c_ctx,
              norm_g, w_ada, b_ada, w_ffn_in, w_ffn_out, w_in, w_out, diff_qk_norm, diff_lambda, diff_subln,
              lru_conv_w, lru_conv_b, lru_w_gate, lru_b_gate, lru_lambda, mla_cq_norm, mla_ckv_norm,
              mla_w_uq, mla_w_ukv, mla_qk_norm):
    xp = x_prompt
    xs = x_sample
    ks_, vs_, ckvs_, krs_, lrus_ = [], [], [], [], []
    for l in range(DEPTH):
        p = {
            "norm_g": norm_g[l], "w_ada": w_ada[l], "b_ada": b_ada[l],
            "w_ffn_in": w_ffn_in[l], "w_ffn_out": w_ffn_out[l], "w_in": w_in[l], "w_out": w_out[l],
            "diff_qk_norm": diff_qk_norm[l], "diff_lambda": diff_lambda[l], "diff_subln": diff_subln[l],
            "lru_conv_w": lru_conv_w[l], "lru_conv_b": lru_conv_b[l], "lru_w_gate": lru_w_gate[l],
            "lru_b_gate": lru_b_gate[l], "lru_lambda": lru_lambda[l],
            "mla_cq_norm": mla_cq_norm[l], "mla_ckv_norm": mla_ckv_norm[l], "mla_w_uq": mla_w_uq[l],
            "mla_w_ukv": mla_w_ukv[l], "mla_qk_norm": mla_qk_norm[l],
        }
        xp, (k_l, v_l, ckv_l, kr_l, lru_l) = trunk_layer(xp, c_ctx[None, :], p, l, None)
        ks_.append(k_l)
        vs_.append(v_l)
        ckvs_.append(ckv_l)
        krs_.append(kr_l)
        lrus_.append(lru_l)
        ctx = {"diff_k": cache_diff_k[:, l], "diff_v": cache_diff_v[:, l], "ckv": cache_mla_ckv[:, l],
               "krope": cache_mla_krope[:, l], "lru": state_lru[:, l]}
        xs, _ = trunk_layer(xs, c, p, l, ctx)
    new_diff_k = jnp.stack(ks_, axis=1)
    new_diff_v = jnp.stack(vs_, axis=1)
    new_mla_ckv = jnp.stack(ckvs_, axis=1)
    new_mla_krope = jnp.stack(krs_, axis=1)
    new_state_lru = jnp.stack(lrus_, axis=1)
    return (xp, xs, new_diff_k, new_diff_v, new_mla_ckv, new_mla_krope, new_state_lru)
```

```cpp
#include <hip/hip_runtime.h>
#include <cstdio>
#include <cstdint>

#define GAS __attribute__((address_space(1)))
#define LAS __attribute__((address_space(3)))
typedef _Float16 f16;
typedef _Float16 f16x2 __attribute__((ext_vector_type(2)));
typedef _Float16 f16x4 __attribute__((ext_vector_type(4)));
typedef _Float16 f16x8 __attribute__((ext_vector_type(8)));
typedef float f32x2 __attribute__((ext_vector_type(2)));
typedef float f32x4 __attribute__((ext_vector_type(4)));
typedef float f32x16 __attribute__((ext_vector_type(16)));
typedef unsigned u32x2 __attribute__((ext_vector_type(2)));
typedef unsigned u32x4 __attribute__((ext_vector_type(4)));
typedef GAS unsigned gu32;

#ifndef MK_PH_HI
#define MK_PH_HI 18
#endif
#ifndef REP_Q
#define REP_Q -2
#endif
#ifndef REP_N
#define REP_N 1
#endif
#ifndef REP_MODE
#define REP_MODE 0
#endif
#ifndef MK_MULTI
#define MK_MULTI 0
#endif

constexpr int DM = 1024, NBP = 32, TP = 256, NBS = 4, TS = 2048, PAST = 512, DEPTH = 2;
constexpr int MP = NBP * TP, MS = NBS * TS, M = MP + MS;
constexpr int DFF = 2816, NFF2 = 5632, DIN = 2144, DINP = 2304, NMODV = 9216;
constexpr int TKS = PAST + TS;
constexpr float EPS = 1e-6f;
constexpr float LOG2E = 1.4426950408889634f;
constexpr int PC_QA = 0, PC_KA = 256, PC_VA = 512, PC_XB = 768, PC_GB = 1280, PC_CQ = 1792, PC_CKV = 1984, PC_KR = 2112;
constexpr size_t OUT_YP = 0, OUT_YS = 8388608, OUT_DK = 16777216, OUT_DV = 20971520, OUT_CKV = 25165824, OUT_KR = 27262976, OUT_ST = 27787264;
enum { I_XP = 0, I_XS, I_CDK, I_CDV, I_CCKV, I_CKR, I_ST, I_C, I_CCTX, I_NG, I_WADA, I_BADA, I_WFI, I_WFO, I_WIN, I_WOUT, I_DQKN, I_DLAM, I_DSUB,
       I_CONVW, I_CONVB, I_WGATE, I_BGATE, I_LLAM, I_CQN, I_CKVN, I_WUQ, I_WUKV, I_QKN, N_IN };

constexpr size_t MiB = 1u << 20;
constexpr size_t WS_CTL = 0, CTL_ZERO_BYTES = 1 * MiB;
constexpr size_t WS_MOD = 1 * MiB;
constexpr size_t WS_WUQ = 2 * MiB;
constexpr size_t WS_WUKV = 2 * MiB + 512 * 1024;
constexpr size_t WS_WUKV0 = 3 * MiB + 512 * 1024;
constexpr size_t WS_IDN = 3 * MiB + 768 * 1024;
constexpr size_t WS_WG = 3 * MiB;
constexpr size_t WS_SUM = 4 * MiB;
constexpr size_t WS_XBUF = 4 * MiB + 2 * MiB + 512 * 1024;
constexpr size_t WS_WFI = 8 * MiB;
constexpr size_t WS_WFO = 52 * MiB;
constexpr size_t WS_WIN = 74 * MiB;
constexpr size_t WS_WOUT = 83 * MiB;
constexpr size_t WS_H = 88 * MiB;
constexpr size_t WS_OCAT = 120 * MiB;
constexpr size_t WS_ACT = 152 * MiB;
constexpr size_t WS_XC = 224 * MiB;
constexpr size_t WS_QA = 240 * MiB;
constexpr size_t WS_QC = 248 * MiB;
constexpr size_t WS_KAS = 260 * MiB;
constexpr size_t WS_KAP = 265 * MiB;
constexpr size_t WS_VATS = 269 * MiB;
constexpr size_t WS_VATP = 274 * MiB;
constexpr size_t WS_KCS = 278 * MiB;
constexpr size_t WS_KCP = 286 * MiB;
constexpr size_t WS_VCTS = 292 * MiB;
constexpr size_t WS_VCTP = 297 * MiB;
constexpr size_t WS_XH = 301 * MiB;
constexpr size_t WS_END = 333 * MiB;
constexpr int CW_BAR = 4096;
constexpr int CW_Q = 16384;
constexpr int CW_PAN = 65536;

constexpr int RING_BYTES = 131072;
constexpr int LDSCTL_OFF = RING_BYTES, MISC_OFF = LDSCTL_OFF + 320;
constexpr int LDS_BYTES = 147456;

__device__ __forceinline__ int crow(int r, int hi) { return (r & 3) + 8 * (r >> 2) + 4 * hi; }
__device__ __forceinline__ int swap23(int x) { return (x & ~12) | ((x & 4) << 1) | ((x & 8) >> 1); }
__device__ __forceinline__ f16x2 cvt2(float a, float b) { f32x2 v = {a, b}; return __builtin_convertvector(v, f16x2); }
__device__ __forceinline__ f16x4 cvt4(float a, float b, float c, float d) { f32x4 v = {a, b, c, d}; return __builtin_convertvector(v, f16x4); }
__device__ __forceinline__ f16x4 cvt4v(f32x4 v) { return __builtin_convertvector(v, f16x4); }
__device__ __forceinline__ f32x4 tof32(f16x4 v) { return __builtin_convertvector(v, f32x4); }
__device__ __forceinline__ f16x8 pack8(f16x4 a, f16x4 b) { return __builtin_shufflevector(a, b, 0, 1, 2, 3, 4, 5, 6, 7); }
__device__ __forceinline__ float fexp2(float x) { return __builtin_amdgcn_exp2f(x); }
__device__ __forceinline__ float frcp(float x) { return __builtin_amdgcn_rcpf(x); }
__device__ __forceinline__ float sigmoidf_(float x) { return frcp(1.0f + fexp2(-x * LOG2E)); }
__device__ __forceinline__ float wave_sum(float v) {
#pragma unroll
    for (int o = 1; o < 64; o <<= 1) v += __shfl_xor(v, o);
    return v;
}
#define FENCE() asm volatile("" ::: "memory")
__device__ __forceinline__ int lane_id_fresh() { int l; asm volatile("v_mbcnt_lo_u32_b32 %0, -1, 0\n\tv_mbcnt_hi_u32_b32 %0, -1, %0" : "=v"(l)); return l; }
#define MFMA32(a, b, c) __builtin_amdgcn_mfma_f32_32x32x16_f16((a), (b), (c), 0, 0, 0)

namespace pg8 {
#define PG8_LAS __attribute__((address_space(3)))
constexpr int BM = 256, BK = 64, HALF = 128, HTB = HALF * BK * 2, STAGE_BYTES = 8 * HTB, NXCD = 8, WGM = 8;
__host__ __device__ __forceinline__ int lds_byte(int r, int c) { const int st = (r >> 4) * 2 + (c >> 5), rr = r & 15, cc = c & 31, ob = rr * 64 + cc * 2; return st * 1024 + (ob ^ (((ob >> 9) & 1) << 5)); }
__host__ __device__ __forceinline__ void stage_rc(int b, int& R, int& C) { const int st = b / 1024, sb = b % 1024, swz = sb ^ (((sb >> 9) & 1) << 5); R = (st >> 1) * 16 + swz / 64; C = (st & 1) * 32 + (swz % 64) / 2; }
__host__ __device__ __forceinline__ int perm32(int rho) { const int n = rho >> 4, i = rho & 15; return 8 * (i >> 2) + 4 * n + (i & 3); }
struct Unit { int pm, pn; };
struct Gemm { const f16* A; const f16* Bt; int M, N, K; };
struct StaticOrder {
    int nM, nN, nwg, G, c;
    __host__ __device__ void init(int M_, int N_, int G_, int c_) { nM = M_ / BM; nN = N_ / BM; nwg = nM * nN; G = G_; c = c_; }
    __host__ __device__ bool next(int i, Unit& u) const {
        const long L = (long)i * G + c; if (L >= nwg) return false;
        int wgid = (int)L; { const int q = nwg / NXCD, r = nwg % NXCD, xcd = wgid % NXCD, off = wgid / NXCD; wgid = (xcd < r ? xcd * (q + 1) : r * (q + 1) + (xcd - r) * q) + off; }
        const int nig = WGM * nN, gid = wgid / nig, fm = gid * WGM, gsz = (nM - fm) < WGM ? (nM - fm) : WGM;
        u.pm = fm + ((wgid % nig) % gsz); u.pn = (wgid % nig) / gsz; return true;
    }
};
struct EpiSwiglu {
    static constexpr bool PERM = true, AFTER_DRAIN = false;
    f16* O;
    __device__ __forceinline__ void operator()(const f32x4 (&acc)[2][2][4][2], const Unit& u, int wr, int wc, int fr, int fq) const {
        const int row0 = u.pm * BM + wr * 64 + fr, col0 = u.pn * 128 + wc * 32 + 8 * fq;
#pragma unroll
        for (int ai = 0; ai < 2; ++ai)
#pragma unroll
            for (int m = 0; m < 4; ++m) {
                f16* rowp = O + (size_t)(row0 + ai * HALF + m * 16) * DFF + col0;
                f32x4 a0, a1;
#pragma unroll
                for (int e = 0; e < 4; ++e) {
                    const float g0 = acc[ai][0][m][0][e], g1 = acc[ai][0][m][1][e];
                    a0[e] = g0 * sigmoidf_(g0) * acc[ai][1][m][0][e];
                    a1[e] = g1 * sigmoidf_(g1) * acc[ai][1][m][1][e];
                }
                *(f16x8*)rowp = pack8(cvt4v(a0), cvt4v(a1));
            }
    }
};
struct EpiStore {
    static constexpr bool PERM = true, AFTER_DRAIN = false;
    f16* O; int ldc;
    __device__ __forceinline__ void operator()(const f32x4 (&acc)[2][2][4][2], const Unit& u, int wr, int wc, int fr, int fq) const {
        const int row0 = u.pm * BM + wr * 64 + fr, col0 = u.pn * BM + wc * 32 + 8 * fq;
#pragma unroll
        for (int ai = 0; ai < 2; ++ai)
#pragma unroll
            for (int m = 0; m < 4; ++m) {
                f16* rowp = O + (size_t)(row0 + ai * HALF + m * 16) * ldc + col0;
#pragma unroll
                for (int bj = 0; bj < 2; ++bj) *(f16x8*)(rowp + bj * HALF) = pack8(cvt4v(acc[ai][bj][m][0]), cvt4v(acc[ai][bj][m][1]));
            }
    }
};
struct EpiResidNorm {
    static constexpr bool PERM = false, AFTER_DRAIN = true;
    float* X; f16* XH; const float* modl; int gidx; float coef;
    int donorm; f16* H; const float* gn; const float* shn;
    float* xbuf; unsigned* cnt;
    __device__ __forceinline__ void fused(f32x4 (&acc)[2][2][4][2], const Unit& u, int wr, int wc, int fr, int fq, PG8_LAS unsigned char* lds, int wid, int lane) const {
        const int cond = (u.pm < 32) ? 4 : ((u.pm - 32) >> 3);
        const int col0 = u.pn * BM + wc * 32 + 4 * fq;
        {
            const float* gp = modl + (size_t)cond * NMODV + gidx * DM + col0;
            f32x4 gv[2][2];
#pragma unroll
            for (int bj = 0; bj < 2; ++bj)
#pragma unroll
                for (int n = 0; n < 2; ++n) gv[bj][n] = *(const f32x4*)(gp + bj * HALF + n * 16) * coef;
#pragma unroll
            for (int ai = 0; ai < 2; ++ai)
#pragma unroll
                for (int m = 0; m < 4; ++m) {
                    const f16* rowp = XH + (size_t)(u.pm * BM + ai * HALF + wr * 64 + m * 16 + fr) * DM + col0;
                    f32x4 xv[2][2];
#pragma unroll
                    for (int bj = 0; bj < 2; ++bj)
#pragma unroll
                        for (int n = 0; n < 2; ++n) xv[bj][n] = tof32(*(const f16x4*)(rowp + bj * HALF + n * 16));
#pragma unroll
                    for (int bj = 0; bj < 2; ++bj)
#pragma unroll
                        for (int n = 0; n < 2; ++n) { const f32x4 v = xv[bj][n] + gv[bj][n] * acc[ai][bj][m][n]; acc[ai][bj][m][n] = v; }
                    asm volatile("" : "+v"(acc[ai][0][m][0]), "+v"(acc[ai][0][m][1]), "+v"(acc[ai][1][m][0]), "+v"(acc[ai][1][m][1]));
                    if (m & 1) asm volatile("" ::: "memory");
                }
        }
        if (!donorm) {
#pragma unroll
            for (int ai = 0; ai < 2; ++ai)
#pragma unroll
                for (int m = 0; m < 4; ++m) {
                    float* rowp = X + (size_t)(u.pm * BM + ai * HALF + wr * 64 + m * 16 + fr) * DM + col0;
#pragma unroll
                    for (int bj = 0; bj < 2; ++bj)
#pragma unroll
                        for (int n = 0; n < 2; ++n) *(f32x4*)(rowp + bj * HALF + n * 16) = acc[ai][bj][m][n];
                }
            return;
        }
        PG8_LAS float* P = (PG8_LAS float*)lds;
        PG8_LAS float* S = (PG8_LAS float*)(lds + 4096);
#pragma unroll
        for (int ai = 0; ai < 2; ++ai)
#pragma unroll
            for (int m = 0; m < 4; ++m) {
                float q = 0.f;
#pragma unroll
                for (int bj = 0; bj < 2; ++bj)
#pragma unroll
                    for (int n = 0; n < 2; ++n) { const f32x4 x = acc[ai][bj][m][n]; q += (x[0] * x[0] + x[1] * x[1]) + (x[2] * x[2] + x[3] * x[3]); }
                q += __shfl_xor(q, 16); q += __shfl_xor(q, 32);
                if (fq == 0) P[(ai * HALF + wr * 64 + m * 16 + fr) * 4 + wc] = q;
            }
        asm volatile("s_waitcnt lgkmcnt(0)" ::: "memory"); __builtin_amdgcn_s_barrier(); asm volatile("" ::: "memory");
        const int row = wid * 32 + (lane & 31);
        if (lane < 32) {
            const float tot = (P[row * 4 + 0] + P[row * 4 + 1]) + (P[row * 4 + 2] + P[row * 4 + 3]);
            __hip_atomic_store(xbuf + ((size_t)(u.pm * BM + row) * 4 + u.pn), tot, __ATOMIC_RELAXED, __HIP_MEMORY_SCOPE_AGENT);
        }
        asm volatile("s_waitcnt vmcnt(0)" ::: "memory");
        if (lane == 0) __hip_atomic_fetch_add(cnt + 64 * u.pm, 1u, __ATOMIC_RELAXED, __HIP_MEMORY_SCOPE_AGENT);
#pragma unroll
        for (int ai = 0; ai < 2; ++ai)
#pragma unroll
            for (int m = 0; m < 4; ++m) {
                f16* rowp = XH + (size_t)(u.pm * BM + ai * HALF + wr * 64 + m * 16 + fr) * DM + col0;
#pragma unroll
                for (int bj = 0; bj < 2; ++bj)
#pragma unroll
                    for (int n = 0; n < 2; ++n) *(f16x4*)(rowp + bj * HALF + n * 16) = cvt4v(acc[ai][bj][m][n]);
            }
        if (wid == 0) {
            unsigned spins = 0;
            for (;;) {
                if ((unsigned)__builtin_amdgcn_readfirstlane(__hip_atomic_load(cnt + 64 * u.pm, __ATOMIC_RELAXED, __HIP_MEMORY_SCOPE_AGENT)) >= 32u) break;
                if (++spins > (1u << 20)) break;
                __builtin_amdgcn_s_sleep(2);
            }
            __builtin_amdgcn_fence(__ATOMIC_ACQUIRE, "agent");
        }
        asm volatile("s_waitcnt vmcnt(0) lgkmcnt(0)" ::: "memory"); __builtin_amdgcn_s_barrier(); asm volatile("" ::: "memory");
        if (lane < 32) {
            const float* slot = xbuf + (size_t)(u.pm * BM + row) * 4;
            const float t0 = __hip_atomic_load(slot + 0, __ATOMIC_RELAXED, __HIP_MEMORY_SCOPE_AGENT), t1 = __hip_atomic_load(slot + 1, __ATOMIC_RELAXED, __HIP_MEMORY_SCOPE_AGENT);
            const float t2 = __hip_atomic_load(slot + 2, __ATOMIC_RELAXED, __HIP_MEMORY_SCOPE_AGENT), t3 = __hip_atomic_load(slot + 3, __ATOMIC_RELAXED, __HIP_MEMORY_SCOPE_AGENT);
            S[row] = 1.0f / sqrtf(((t0 + t1) + (t2 + t3)) * (1.0f / DM) + EPS);
        }
        asm volatile("s_waitcnt lgkmcnt(0)" ::: "memory"); __builtin_amdgcn_s_barrier(); asm volatile("" ::: "memory");
        const float* shp = shn + (size_t)cond * NMODV + col0;
        f32x4 gsv[2][2], shv[2][2];
#pragma unroll
        for (int bj = 0; bj < 2; ++bj)
#pragma unroll
            for (int n = 0; n < 2; ++n) { const int co = bj * HALF + n * 16;
                gsv[bj][n] = *(const f32x4*)(gn + col0 + co) * (*(const f32x4*)(shp + DM + co) + 1.0f); shv[bj][n] = *(const f32x4*)(shp + co); }
#pragma unroll
        for (int ai = 0; ai < 2; ++ai)
#pragma unroll
            for (int m = 0; m < 4; ++m) { const int r = ai * HALF + wr * 64 + m * 16 + fr; const float sr = S[r];
#pragma unroll
                for (int bj = 0; bj < 2; ++bj)
#pragma unroll
                    for (int n = 0; n < 2; ++n) *(f16x4*)(H + (size_t)(u.pm * BM + r) * DM + col0 + bj * HALF + n * 16) = cvt4v(acc[ai][bj][m][n] * sr * gsv[bj][n] + shv[bj][n]); }
    }
};

template <class Epi, class Sched, bool ALIGN_EPI, bool SP2>
__device__ __forceinline__ void gemm_phase(PG8_LAS unsigned char* lds, const Gemm g, const Sched& S, const Epi& E, int wave_id) {
    const int lane = lane_id_fresh(), wid = wave_id, tid = wid * 64 + lane, wr = wid >> 2, wc = wid & 3, fr = lane & 15, fq = lane >> 4;
    const int K = g.K, nt = K / BK;
    unsigned voffA[2], voffB[2];
#pragma unroll
    for (int i = 0; i < 2; ++i) { int R, C; stage_rc(tid * 16 + i * 8192, R, C); const int Rb = Epi::PERM ? ((R & ~31) + perm32(R & 31)) : R;
        voffA[i] = (unsigned)(R * K + C) * 2u; voffB[i] = (unsigned)(Rb * K + C) * 2u; }
    const size_t kstep = (size_t)(BK * 2);
    const size_t hstep = (size_t)HALF * K * 2;
    const size_t tstep = 2 * hstep;
    const unsigned ldsw = (unsigned)wid * 1024u;
    const int aoff = lds_byte(wr * 64 + fr, fq * 8), boff = lds_byte(wc * 32 + fr, fq * 8);
#define PG8_SA(b, h) (((b) * 2 + (h)) * HTB)
#define PG8_SB(b, h) ((4 + (b) * 2 + (h)) * HTB)
#define PG8_STAGE(bufoff, gbase, voff) do { _Pragma("unroll") for (int _i = 0; _i < 2; ++_i) \
        __builtin_amdgcn_global_load_lds((const unsigned*)((const char*)(gbase) + (voff)[_i]), (PG8_LAS unsigned*)(lds + (bufoff) + ldsw + _i * 8192), 16, 0, 0); } while (0)
#define PG8_LDA(dst, b, h) do { _Pragma("unroll") for (int m = 0; m < 4; ++m) _Pragma("unroll") for (int k = 0; k < 2; ++k) dst[m][k] = *(const PG8_LAS f16x8*)(lds + PG8_SA(b, h) + aoff + m * 2048 + k * 1024); } while (0)
#define PG8_LDB(dst, b, h) do { _Pragma("unroll") for (int n = 0; n < 2; ++n) _Pragma("unroll") for (int k = 0; k < 2; ++k) dst[n][k] = *(const PG8_LAS f16x8*)(lds + PG8_SB(b, h) + boff + n * 2048 + k * 1024); } while (0)
#define PG8_MMA(ai, bj, At, Bt) do { __builtin_amdgcn_s_setprio(1); _Pragma("unroll") for (int m = 0; m < 4; ++m) _Pragma("unroll") for (int n = 0; n < 2; ++n) _Pragma("unroll") for (int k = 0; k < 2; ++k) \
        acc[ai][bj][m][n] = __builtin_amdgcn_mfma_f32_16x16x32_f16(Bt[n][k], At[m][k], acc[ai][bj][m][n], 0, 0, 0); __builtin_amdgcn_s_setprio(0); } while (0)
#define PG8_WAIT_V(n) asm volatile("s_waitcnt vmcnt(" #n ")" ::: "memory")
#define PG8_WAIT_L(n) asm volatile("s_waitcnt lgkmcnt(" #n ")" ::: "memory")
#define PG8_BAR __builtin_amdgcn_s_barrier()
#define PG8_SCHED __builtin_amdgcn_sched_barrier(0)
    Unit cur, nxt; int ui = 0;
    if (!S.next(0, cur)) return;
    f32x4 acc[2][2][4][2];
#pragma unroll
    for (int a = 0; a < 2; ++a)
#pragma unroll
        for (int b = 0; b < 2; ++b)
#pragma unroll
            for (int m = 0; m < 4; ++m)
#pragma unroll
                for (int n = 0; n < 2; ++n) acc[a][b][m][n] = (f32x4){0.f, 0.f, 0.f, 0.f};
    f16x8 At[4][2], B0[2][2], B1[2][2];
    const char* cA = (const char*)g.A + (size_t)cur.pm * tstep; const char* cB = (const char*)g.Bt + (size_t)cur.pn * tstep;
    if constexpr (SP2) {
        PG8_STAGE(PG8_SB(0, 0), cB, voffB); PG8_STAGE(PG8_SB(0, 1), cB + hstep, voffB); PG8_STAGE(PG8_SA(0, 0), cA, voffA); PG8_STAGE(PG8_SA(0, 1), cA + hstep, voffA);
        if (wr == 1) PG8_BAR;
        PG8_WAIT_V(2); PG8_BAR;
        PG8_STAGE(PG8_SB(1, 0), cB + kstep, voffB); PG8_STAGE(PG8_SA(1, 0), cA + kstep, voffA); PG8_STAGE(PG8_SB(1, 1), cB + hstep + kstep, voffB);
        PG8_WAIT_V(6); PG8_BAR;
    } else {
        PG8_STAGE(PG8_SB(0, 0), cB, voffB); PG8_STAGE(PG8_SA(0, 0), cA, voffA); PG8_STAGE(PG8_SB(0, 1), cB + hstep, voffB); PG8_STAGE(PG8_SA(0, 1), cA + hstep, voffA);
        if (wr == 1) PG8_BAR;
        PG8_WAIT_V(4); PG8_BAR;
        PG8_STAGE(PG8_SB(1, 0), cB + kstep, voffB); PG8_STAGE(PG8_SA(1, 0), cA + kstep, voffA); PG8_STAGE(PG8_SB(1, 1), cB + hstep + kstep, voffB);
        PG8_WAIT_V(6); PG8_BAR;
    }
    for (;;) {
        const bool has_next = S.next(ui + 1, nxt);
        const char* nA = has_next ? (const char*)g.A + (size_t)nxt.pm * tstep : cA; const char* nB = has_next ? (const char*)g.Bt + (size_t)nxt.pn * tstep : cB;
        for (int t = 0; t < nt; t += 2) {
            const bool last = (t == nt - 2);
            const char* a1 = cA + (size_t)(t + 1) * kstep;
            const char* a2 = last ? nA : cA + (size_t)(t + 2) * kstep; const char* b2 = last ? nB : cB + (size_t)(t + 2) * kstep;
            const char* a3 = a2 + kstep; const char* b3 = b2 + kstep;
            if constexpr (SP2) {
            PG8_LDB(B0, 0, 0); PG8_LDB(B1, 0, 1); PG8_SCHED; PG8_LDA(At, 0, 0); PG8_STAGE(PG8_SA(1, 1), a1 + hstep, voffA);
            PG8_WAIT_V(8); PG8_WAIT_L(0); PG8_BAR; PG8_MMA(0, 0, At, B0); PG8_MMA(0, 1, At, B1); PG8_BAR; PG8_SCHED;
            PG8_LDA(At, 0, 1); PG8_STAGE(PG8_SB(0, 0), b2, voffB); PG8_STAGE(PG8_SB(0, 1), b2 + hstep, voffB); PG8_STAGE(PG8_SA(0, 0), a2, voffA);
            PG8_WAIT_V(8); PG8_WAIT_L(0); PG8_BAR; PG8_MMA(1, 0, At, B0); PG8_MMA(1, 1, At, B1); PG8_BAR; PG8_SCHED;
            PG8_LDB(B0, 1, 0); PG8_LDB(B1, 1, 1); PG8_SCHED; PG8_LDA(At, 1, 0); PG8_STAGE(PG8_SA(0, 1), a2 + hstep, voffA);
            PG8_WAIT_V(8); PG8_WAIT_L(0); PG8_BAR; PG8_MMA(0, 0, At, B0); PG8_MMA(0, 1, At, B1); PG8_BAR; PG8_SCHED;
            PG8_LDA(At, 1, 1); PG8_STAGE(PG8_SB(1, 0), b3, voffB); PG8_STAGE(PG8_SB(1, 1), b3 + hstep, voffB); PG8_STAGE(PG8_SA(1, 0), a3, voffA);
            PG8_WAIT_V(8); PG8_WAIT_L(0); PG8_BAR; PG8_MMA(1, 0, At, B0); PG8_MMA(1, 1, At, B1); PG8_BAR; PG8_SCHED;
            } else {
            PG8_LDB(B0, 0, 0); PG8_SCHED; PG8_LDA(At, 0, 0); PG8_STAGE(PG8_SA(1, 1), a1 + hstep, voffA);
            PG8_WAIT_L(8); PG8_BAR; PG8_WAIT_L(0); PG8_MMA(0, 0, At, B0); PG8_BAR; PG8_SCHED;
            PG8_LDB(B1, 0, 1); PG8_STAGE(PG8_SB(0, 0), b2, voffB);
            PG8_BAR; PG8_WAIT_L(0); PG8_MMA(0, 1, At, B1); PG8_BAR;
            PG8_LDA(At, 0, 1); PG8_STAGE(PG8_SA(0, 0), a2, voffA);
            PG8_BAR; PG8_WAIT_L(0); PG8_MMA(1, 0, At, B0); PG8_BAR; PG8_SCHED;
            PG8_STAGE(PG8_SB(0, 1), b2 + hstep, voffB);
            PG8_WAIT_V(6); PG8_BAR; PG8_MMA(1, 1, At, B1); PG8_BAR;
            PG8_LDB(B0, 1, 0); PG8_SCHED; PG8_LDA(At, 1, 0); PG8_STAGE(PG8_SA(0, 1), a2 + hstep, voffA);
            PG8_WAIT_L(8); PG8_BAR; PG8_WAIT_L(0); PG8_MMA(0, 0, At, B0); PG8_BAR; PG8_SCHED;
            PG8_LDB(B1, 1, 1); PG8_STAGE(PG8_SB(1, 0), b3, voffB);
            PG8_BAR; PG8_WAIT_L(0); PG8_MMA(0, 1, At, B1); PG8_BAR;
            PG8_LDA(At, 1, 1); PG8_STAGE(PG8_SA(1, 0), a3, voffA);
            PG8_BAR; PG8_WAIT_L(0); PG8_MMA(1, 0, At, B0); PG8_BAR; PG8_SCHED;
            PG8_STAGE(PG8_SB(1, 1), b3 + hstep, voffB);
            PG8_WAIT_V(6); PG8_BAR; PG8_MMA(1, 1, At, B1); PG8_BAR;
            }
        }
        if constexpr (ALIGN_EPI) { if (wr == 0) PG8_BAR; }
        if constexpr (!Epi::AFTER_DRAIN) E(acc, cur, wr, wc, fr, fq);
        if (!has_next) break;
#pragma unroll
        for (int a = 0; a < 2; ++a)
#pragma unroll
            for (int b = 0; b < 2; ++b)
#pragma unroll
                for (int m = 0; m < 4; ++m)
#pragma unroll
                    for (int n = 0; n < 2; ++n) acc[a][b][m][n] = (f32x4){0.f, 0.f, 0.f, 0.f};
        cur = nxt; cA = nA; cB = nB; ++ui;
        if constexpr (ALIGN_EPI) { if (wr == 1) PG8_BAR; }
    }
    PG8_WAIT_V(0);
    if constexpr (!ALIGN_EPI) { if (wr == 0) PG8_BAR; }
    PG8_BAR;
    if constexpr (Epi::AFTER_DRAIN) E.fused(acc, cur, wr, wc, fr, fq, lds, wid, lane);
#undef PG8_SA
#undef PG8_SB
#undef PG8_STAGE
#undef PG8_LDA
#undef PG8_LDB
#undef PG8_MMA
#undef PG8_WAIT_V
#undef PG8_WAIT_L
#undef PG8_BAR
#undef PG8_SCHED
}
}

#define XB_TMO      128
#define XB_XCNT(j)  (256  + 64 * (j))
#define XB_XSUB(j)  (1280 + 64 * (j))
#define XB_XGEN(j)  (2304 + 64 * (j))
#define XB_TOP      3328
#define XB_TOPGEN   3392
#define XCD_BAR_WORDS 3456
#define XB_SPIN_CAP (1u << 18)
__device__ __forceinline__ unsigned xb_ld(unsigned* p)              { return __hip_atomic_load(p, __ATOMIC_RELAXED, __HIP_MEMORY_SCOPE_AGENT); }
__device__ __forceinline__ unsigned xb_add(unsigned* p, unsigned v) { return __hip_atomic_fetch_add(p, v, __ATOMIC_RELAXED, __HIP_MEMORY_SCOPE_AGENT); }
__device__ __forceinline__ unsigned xb_xcc_id() { return (unsigned)__builtin_amdgcn_s_getreg((3 << 11) | 20) & 0xFu; }
#define XB_SPIN(cond, bar) do { unsigned _sp = 0; while (cond) { __builtin_amdgcn_s_sleep(1); \
    if ((++_sp & 255u) == 0u) { if (xb_ld(&(bar)[XB_TMO])) break; if (_sp > XB_SPIN_CAP) { atomicAdd(&(bar)[XB_TMO], 1u); break; } } } } while (0)
struct XcdBarrier { unsigned* bar; unsigned x; volatile LAS unsigned* st; };
__device__ __forceinline__ XcdBarrier xcd_barrier_post(unsigned* bar, volatile LAS unsigned* st) {
    XcdBarrier b; b.bar = bar; b.x = xb_xcc_id(); b.st = st;
    if (threadIdx.x == 0) (void)xb_add(&bar[XB_XCNT(b.x)], 1u);
    return b;
}
__device__ __forceinline__ void xcd_barrier_complete(unsigned* bar, unsigned x, unsigned& nloc, unsigned& nx) {
    const unsigned G = gridDim.x * gridDim.y * gridDim.z;
    unsigned sum, cnt, mine, sp = 0u;
    for (;;) {
        sum = 0u; cnt = 0u; mine = 0u;
#pragma unroll
        for (unsigned j = 0; j < 16; ++j) { const unsigned c = xb_ld(&bar[XB_XCNT(j)]); sum += c; cnt += (c > 0u) ? 1u : 0u; mine = (j == x) ? c : mine; }
        if (sum == G) break;
        __builtin_amdgcn_s_sleep(1);
        if ((++sp & 255u) == 0u) { if (xb_ld(&bar[XB_TMO])) break; if (sp > XB_SPIN_CAP) { atomicAdd(&bar[XB_TMO], 1u); break; } }
    }
    nloc = mine > 0u ? mine : 1u; nx = cnt > 0u ? cnt : 1u;
}
__device__ __forceinline__ void xcd_barrier(const XcdBarrier& b, int wave_id) {
    asm volatile("s_waitcnt vmcnt(0)" ::: "memory");
    __syncthreads();
    if (wave_id == 0 && lane_id_fresh() == 0) {
        unsigned* bar = b.bar;
        __builtin_amdgcn_s_waitcnt(0);
        unsigned nloc = b.st[0], nx = b.st[1];
        if (nloc == 0u) { xcd_barrier_complete(bar, b.x, nloc, nx); b.st[0] = nloc; b.st[1] = nx; }
        const unsigned old = xb_add(&bar[XB_XSUB(b.x)], 1u);
        const unsigned gen = old / nloc;
        if (old + 1u == (gen + 1u) * nloc) {
            __builtin_amdgcn_fence(__ATOMIC_RELEASE, "agent");
            asm volatile("s_waitcnt vmcnt(0)" ::: "memory");
            const unsigned og = xb_add(&bar[XB_TOP], 1u);
            const unsigned tg = og / nx;
            if (og + 1u == (tg + 1u) * nx) xb_add(&bar[XB_TOPGEN], 1u);
            else XB_SPIN(xb_ld(&bar[XB_TOPGEN]) == tg, bar);
            __builtin_amdgcn_fence(__ATOMIC_ACQUIRE, "agent");
            xb_add(&bar[XB_XGEN(b.x)], 1u);
            asm volatile("s_waitcnt vmcnt(0)" ::: "memory");
        } else {
            XB_SPIN(xb_ld(&bar[XB_XGEN(b.x)]) == gen, bar);
            __builtin_amdgcn_fence(__ATOMIC_ACQUIRE, "agent");
            asm volatile("s_waitcnt vmcnt(0)" ::: "memory");
        }
    }
    __syncthreads();
}

struct Args { const float* in[N_IN]; float* out; unsigned char* ws; int ph_lo, ph_hi; };
static_assert(sizeof(Args) == N_IN * 8 + 8 + 8 + 8, "Args has no padding");

struct Ctx {
    const float* const* in; float* out; unsigned char* ws;
    LAS unsigned char* lds;
    int tid, lane, wave, gw, ngw, bid, G;
};
#define WSP(T, off) ((T*)(C.ws + (off)))
__device__ __forceinline__ Ctx ctx_fresh(const Ctx& C0) {
    Ctx C = C0; C.lane = lane_id_fresh(); C.tid = C.wave * 64 + C.lane;
    int bid = blockIdx.x, G = gridDim.x; asm volatile("" : "+s"(bid), "+s"(G));
    C.bid = bid; C.G = G; C.gw = bid * 8 + C.wave; C.ngw = G * 8;
    return C;
}

__device__ __forceinline__ int wq_next(unsigned* ctr, int lane) {
    unsigned v = 0;
    if (lane == 0) v = __hip_atomic_fetch_add(ctr, 1u, __ATOMIC_RELAXED, __HIP_MEMORY_SCOPE_AGENT);
    return (int)__builtin_amdgcn_readfirstlane(v);
}

__device__ __forceinline__ void transpose_item(const float* W, int ldw, f16* WT, int ldt, int dst_row0, int k0, int n0, LAS float* scr, int lane) {
#pragma unroll 8
    for (int i = 0; i < 32; ++i) { const int kk = 2 * i + (lane >> 5); scr[kk * 33 + (lane & 31)] = __builtin_nontemporal_load(&W[(size_t)(k0 + kk) * ldw + n0 + (lane & 31)]); }
    asm volatile("s_waitcnt lgkmcnt(0)" ::: "memory");
    const int c = lane & 7;
#pragma unroll
    for (int j = 0; j < 4; ++j) { const int n = (lane >> 3) + 8 * j; const LAS float* s = scr + (8 * c) * 33 + n;
        const f16x8 o = pack8(cvt4(s[0 * 33], s[1 * 33], s[2 * 33], s[3 * 33]), cvt4(s[4 * 33], s[5 * 33], s[6 * 33], s[7 * 33]));
        __builtin_nontemporal_store(o, (f16x8*)(WT + (size_t)(dst_row0 + n) * ldt + k0 + 8 * c)); }
    asm volatile("s_waitcnt lgkmcnt(0)" ::: "memory");
}
__device__ __forceinline__ void phase_prep(const Ctx& C0) {
    const Ctx C = ctx_fresh(C0);
    {
        LAS float* sc = (LAS float*)C.lds;
        LAS float* red = (LAS float*)(C.lds + 20480);
        const float* cv = C.in[I_C]; const float* cctx = C.in[I_CCTX];
        for (int i = C.tid; i < 5 * 1024; i += 512) { const int c = i >> 10, k = i & 1023; const float v = (c < 4) ? cv[c * 1024 + k] : cctx[k]; sc[i] = v / (1.0f + __expf(-v)); }
        __syncthreads();
        float* mod = WSP(float, WS_MOD);
        for (int item = C.bid; item < 2 * 144; item += C.G) {
            const int l = item / 144, j0 = (item % 144) * 64, k0 = C.wave * 128;
            const float* wp = C.in[I_WADA] + ((size_t)l * 1024 + k0) * NMODV + j0 + C.lane;
            float a0 = 0.f, a1 = 0.f, a2 = 0.f, a3 = 0.f, a4 = 0.f;
#pragma unroll 16
            for (int kk = 0; kk < 128; ++kk) {
                const float w = __builtin_nontemporal_load(&wp[(size_t)kk * NMODV]);
                a0 += sc[0 * 1024 + k0 + kk] * w; a1 += sc[1 * 1024 + k0 + kk] * w; a2 += sc[2 * 1024 + k0 + kk] * w; a3 += sc[3 * 1024 + k0 + kk] * w; a4 += sc[4 * 1024 + k0 + kk] * w;
            }
            red[(C.wave * 5 + 0) * 64 + C.lane] = a0; red[(C.wave * 5 + 1) * 64 + C.lane] = a1; red[(C.wave * 5 + 2) * 64 + C.lane] = a2;
            red[(C.wave * 5 + 3) * 64 + C.lane] = a3; red[(C.wave * 5 + 4) * 64 + C.lane] = a4;
            __syncthreads();
            if (C.tid < 320) { const int c = C.tid >> 6, ln = C.tid & 63; float s = 0.f;
#pragma unroll
                for (int w = 0; w < 8; ++w) s += red[(w * 5 + c) * 64 + ln];
                mod[((size_t)l * 5 + c) * NMODV + j0 + ln] = s + C.in[I_BADA][(size_t)l * NMODV + j0 + ln]; }
            __syncthreads();
        }
    }
    __syncthreads();
    {
        LAS float* scr = (LAS float*)(C.lds + C.wave * 16384);
        constexpr int IFI = 16 * 176, IFO = 44 * 32, IIN = 16 * 67, IOUT = 16 * 32;
        constexpr int NIT = 4 * IFI + 4 * IFO + 2 * IIN + 2 * IOUT;
        for (int it = C.gw; it < NIT; it += C.ngw) {
            int r = it;
            if (r < 4 * IFI) { const int mat = r / IFI, rr = r % IFI, kb = rr / 176, n0 = (rr % 176) * 32;
                const int drow = (n0 < DFF) ? ((n0 >> 7) * 256 + (n0 & 127)) : (((n0 - DFF) >> 7) * 256 + 128 + ((n0 - DFF) & 127));
                transpose_item(C.in[I_WFI] + (size_t)mat * 1024 * NFF2, NFF2, WSP(f16, WS_WFI) + (size_t)mat * NFF2 * 1024, 1024, drow, kb * 64, n0, scr, C.lane); continue; }
            r -= 4 * IFI;
            if (r < 4 * IFO) { const int mat = r / IFO, rr = r % IFO, kb = rr / 32, n0 = (rr % 32) * 32;
                transpose_item(C.in[I_WFO] + (size_t)mat * DFF * 1024, 1024, WSP(f16, WS_WFO) + (size_t)mat * 1024 * DFF, DFF, n0, kb * 64, n0, scr, C.lane); continue; }
            r -= 4 * IFO;
            if (r < 2 * IIN) { const int l = r / IIN, rr = r % IIN, kb = rr / 67, n0 = (rr % 67) * 32;
                transpose_item(C.in[I_WIN] + (size_t)l * 1024 * DIN, DIN, WSP(f16, WS_WIN) + (size_t)l * DINP * 1024, 1024, n0, kb * 64, n0, scr, C.lane); continue; }
            r -= 2 * IIN;
            { const int l = r / IOUT, rr = r % IOUT, kb = rr / 32, n0 = (rr % 32) * 32;
                transpose_item(C.in[I_WOUT] + (size_t)l * 1024 * 1024, 1024, WSP(f16, WS_WOUT) + (size_t)l * 1024 * 1024, 1024, n0, kb * 64, n0, scr, C.lane); }
        }
    }
    {
        const int gt = C.bid * 512 + C.tid, ngt = C.G * 512;
        for (int i = gt; i < 2 * 160 * 128; i += ngt) { const int l = i / (160 * 128), rr = i % (160 * 128);
            unsigned z = 0u; asm volatile("" : "+v"(z));
            *(u32x4*)(WSP(f16, WS_WIN) + ((size_t)l * DINP + DIN) * 1024 + (size_t)rr * 8) = (u32x4){z, z, z, z}; }
        f16* wuq = WSP(f16, WS_WUQ);
        for (int i = gt; i < 2 * 384 * 192; i += ngt) { const int e = i & 7, r = (i >> 3) & 31, rest = i >> 8, c = rest % 24, rest2 = rest / 24, t3 = rest2 % 3, lh = rest2 / 3, l = lh >> 2, hd = lh & 3;
            wuq[i] = (f16)(C.in[I_CQN][l * 192 + 8 * c + e] * C.in[I_WUQ][(size_t)l * 192 * 384 + (size_t)(8 * c + e) * 384 + hd * 96 + 32 * t3 + r]); }
        f16* wukv = WSP(f16, WS_WUKV);
        for (int i = gt; i < 2 * 512 * 128; i += ngt) { const int e = i & 7, r = (i >> 3) & 31, rest = i >> 8, c = rest & 15, rest2 = rest >> 4, t4 = rest2 & 3, lh = rest2 >> 2, l = lh >> 2, hd = lh & 3;
            const float w = C.in[I_WUKV][(size_t)l * 128 * 512 + (size_t)(8 * c + e) * 512 + hd * 128 + 32 * t4 + r];
            wukv[i] = (f16)(C.in[I_CKVN][l * 128 + 8 * c + e] * w); WSP(f16, WS_WUKV0)[i] = (f16)w; }
        for (int i = gt; i < 4096; i += ngt) WSP(f16, WS_IDN)[i] = ((i >> 6) == (i & 63)) ? (f16)1.0f : (f16)0.0f;
        f16* wg = WSP(f16, WS_WG);
        for (int i = gt; i < 64 * 4096; i += ngt) { const int m = i >> 12, d = (i >> 6) & 63, c = i & 63; wg[i] = (f16)C.in[I_WGATE][(size_t)m * 4096 + c * 64 + d]; }
    }
}

template <bool FIRST>
__device__ __forceinline__ void phase_norm(const Ctx& C0, int l, int sub) {
    const Ctx C = ctx_fresh(C0);
    const float* gvec = C.in[I_NG] + ((size_t)l * 3 + sub) * DM;
    const float* modl = WSP(float, WS_MOD) + (size_t)l * 5 * NMODV;
    f16* H = WSP(f16, WS_H);
    for (int row = C.gw; row < M; row += C.ngw) {
        const float* src = FIRST ? ((row < MP) ? C.in[I_XP] + (size_t)row * DM : C.in[I_XS] + (size_t)(row - MP) * DM) : C.out + (size_t)row * DM;
        const int cond = (row < MP) ? 4 : ((row - MP) >> 11);
        const float* shp = modl + (size_t)cond * NMODV + (3 * sub) * DM; const float* scp = shp + DM;
        f32x4 v[4]; float ss = 0.f;
#pragma unroll
        for (int j = 0; j < 4; ++j) { v[j] = FIRST ? __builtin_nontemporal_load((const f32x4*)(src + 256 * j + 4 * C.lane)) : *(const f32x4*)(src + 256 * j + 4 * C.lane); ss += (v[j].x * v[j].x + v[j].y * v[j].y) + (v[j].z * v[j].z + v[j].w * v[j].w); }
        const float rstd = 1.0f / sqrtf(wave_sum(ss) * (1.0f / DM) + EPS);
        f32x4 gs[4], shv[4];
#pragma unroll
        for (int j = 0; j < 4; ++j) { const int k = 256 * j + 4 * C.lane; gs[j] = *(const f32x4*)(gvec + k) * (*(const f32x4*)(scp + k) + 1.0f); shv[j] = *(const f32x4*)(shp + k); }
#pragma unroll
        for (int j = 0; j < 4; ++j) {
            const int k = 256 * j + 4 * C.lane;
            *(f16x4*)(H + (size_t)row * DM + k) = cvt4v(v[j] * rstd * gs[j] + shv[j]);
            if (FIRST) *(f16x4*)(WSP(f16, WS_XH) + (size_t)row * DM + k) = cvt4v(v[j]);
        }
    }
}

__device__ __forceinline__ void glds16(const void* gsrc, unsigned lds_dst) { unsigned keep;
    asm volatile("s_mov_b32 %0, m0\n\ts_mov_b32 m0, %2\n\ts_nop 0\n\tglobal_load_lds_dwordx4 %1, off\n\ts_mov_b32 m0, %0" : "=&s"(keep) : "v"(gsrc), "s"(lds_dst) : "memory"); }
#define ATT_GLDS(g, l) glds16((const void*)(g), (unsigned)__builtin_amdgcn_readfirstlane((unsigned)(uintptr_t)(l)))
#define ATT_WAITBAR(N) asm volatile("s_waitcnt vmcnt(" #N ") lgkmcnt(0)\n\ts_barrier" ::: "memory")
#define ATT_LBAR() asm volatile("s_waitcnt lgkmcnt(0)\n\ts_barrier" ::: "memory")
struct MxTok { int b, t, key, ktile, kin; size_t row, ob; };
template <int KIND>
__device__ __forceinline__ MxTok mx_decode(int wt, int tok, int l) {
    MxTok m; m.row = 0;
    if (KIND == 0) { m.row = (size_t)wt * 32 + tok; m.b = (int)(m.row >> 8); m.t = (int)(m.row & 255); m.key = m.t; }
    else if (KIND == 1) { m.row = (size_t)wt * 32 + tok; const int rs = (int)m.row - MP; m.b = rs >> 11; m.t = rs & 2047; m.key = PAST + m.t; }
    else { const int idx = (wt - 512) * 32 + tok; m.b = idx >> 9; m.t = idx & 511; m.key = m.t; }
    m.ktile = m.key >> 6; m.kin = m.key & 63; m.ob = ((size_t)m.b * 2 + l) * TP + m.t;
    return m;
}
template <int KIND>
__device__ __forceinline__ void mx_rope(int t, int hi, float (&cr)[4], float (&sr)[4], float (&cc)[4], float (&scn)[4]) {
#pragma unroll
    for (int e = 0; e < 4; ++e) { cr[e] = 1.f; sr[e] = 0.f; cc[e] = 1.f; scn[e] = 0.f; }
    if (KIND == 1) {
        const float gr = (float)(t >> 6), gc = (float)(t & 63);
#pragma unroll
        for (int e = 0; e < 4; ++e) { const float inv = exp2f(-(float)(4 * hi + e) * (13.287712379549449f / 8.0f));
            const float fr = gr * inv * 0.15915494309189535f, fc = gc * inv * 0.15915494309189535f;
            sr[e] = __builtin_amdgcn_sinf(fr); cr[e] = __builtin_amdgcn_cosf(fr); scn[e] = __builtin_amdgcn_sinf(fc); cc[e] = __builtin_amdgcn_cosf(fc); }
    }
}
template <int KIND, int SUB>
__device__ __forceinline__ void mx_a(const Ctx& C, int l, int wt) {
    const int lane = lane_id_fresh(), tok = lane & 31, hi = lane >> 5;
    constexpr int Tk = (KIND == 0) ? TP : TKS, NT = Tk / 64;
    const MxTok m = mx_decode<KIND>(wt, tok, l);
    const f16* prow = WSP(f16, WS_ACT) + m.row * DINP;
    f16* KA = (KIND == 0) ? WSP(f16, WS_KAP) : WSP(f16, WS_KAS);
    f16* VA = (KIND == 0) ? WSP(f16, WS_VATP) : WSP(f16, WS_VATS);
    if (SUB < 2) {
        if (KIND != 2) {
            constexpr int qk = SUB;
            float cr[4], sr[4], cc[4], scn[4];
            mx_rope<KIND>(m.t, hi, cr, sr, cc, scn);
            f32x4 gain[4];
#pragma unroll
            for (int g = 0; g < 4; ++g) gain[g] = *(const f32x4*)(C.in[I_DQKN] + ((size_t)l * 2 + qk) * 32 + 8 * g + 4 * hi);
            f16x4 raw[8][4];
#pragma unroll
            for (int hc = 0; hc < 8; ++hc)
#pragma unroll
                for (int g = 0; g < 4; ++g) raw[hc][g] = *(const f16x4*)(prow + (qk ? PC_KA : PC_QA) + hc * 32 + 4 * hi + 8 * g);
#pragma unroll
            for (int hc = 0; hc < 8; ++hc) {
                f32x4 x[4]; float ss = 0.f;
#pragma unroll
                for (int g = 0; g < 4; ++g) { x[g] = tof32(raw[hc][g]); ss += (x[g].x * x[g].x + x[g].y * x[g].y) + (x[g].z * x[g].z + x[g].w * x[g].w); }
                ss += __shfl_xor(ss, 32);
                const float rstd = 1.0f / sqrtf(ss * (1.0f / 32.0f) + EPS);
#pragma unroll
                for (int g = 0; g < 4; ++g) x[g] = x[g] * rstd * gain[g];
                if (qk == 1 && KIND == 0) {
                    float* o = C.out + OUT_DK + m.ob * 256 + hc * 32 + 4 * hi;
#pragma unroll
                    for (int g = 0; g < 4; ++g) *(f32x4*)(o + 8 * g) = x[g];
                }
                if (KIND == 1) {
#pragma unroll
                    for (int e = 0; e < 4; ++e) {
                        const float a1 = x[0][e], a2 = x[2][e]; x[0][e] = a1 * cr[e] - a2 * sr[e]; x[2][e] = a2 * cr[e] + a1 * sr[e];
                        const float b1 = x[1][e], b2 = x[3][e]; x[1][e] = b1 * cc[e] - b2 * scn[e]; x[3][e] = b2 * cc[e] + b1 * scn[e];
                    }
                }
                if (qk == 0) {
                    const float sc = 0.17677669529663687f * LOG2E;
                    f16* o = WSP(f16, WS_QA) + m.row * 256 + hc * 32 + 4 * hi;
#pragma unroll
                    for (int g = 0; g < 4; ++g) *(f16x4*)(o + 8 * g) = cvt4v(x[g] * sc);
                } else {
                    f16* o = KA + ((((size_t)m.b * 4 + (hc >> 1)) * NT + m.ktile) * 8 + (hc & 1) * 4) * 512 + m.kin * 8 + 4 * hi;
#pragma unroll
                    for (int g = 0; g < 4; ++g) *(f16x4*)(o + g * 512) = cvt4v(x[g]);
                }
            }
        } else if (SUB == 1) {
            const float* ck = C.in[I_CDK] + (((size_t)m.b * 2 + l) * PAST + m.t) * 256;
            f32x4 raw[8][4];
#pragma unroll
            for (int hc = 0; hc < 8; ++hc)
#pragma unroll
                for (int g = 0; g < 4; ++g) raw[hc][g] = *(const f32x4*)(ck + hc * 32 + 4 * hi + 8 * g);
#pragma unroll
            for (int hc = 0; hc < 8; ++hc) {
                f16* o = KA + ((((size_t)m.b * 4 + (hc >> 1)) * NT + m.ktile) * 8 + (hc & 1) * 4) * 512 + m.kin * 8 + 4 * hi;
#pragma unroll
                for (int g = 0; g < 4; ++g) *(f16x4*)(o + g * 512) = cvt4v(raw[hc][g]);
            }
        }
    } else {
        if (KIND != 2) {
            f16x8 rawv[4][4];
#pragma unroll
            for (int hd = 0; hd < 4; ++hd)
#pragma unroll
                for (int j = 0; j < 4; ++j) rawv[hd][j] = *(const f16x8*)(prow + PC_VA + hd * 64 + 32 * hi + 8 * j);
#pragma unroll
            for (int hd = 0; hd < 4; ++hd) {
                f16* vt = VA + ((((size_t)m.b * 4 + hd) * NT + m.ktile) * 2 + hi) * 2048 + m.kin * 32;
#pragma unroll
                for (int j = 0; j < 4; ++j) {
                    const f16x8 v = rawv[hd][j];
                    if (KIND == 0) {
                        float* o = C.out + OUT_DV + m.ob * 256 + hd * 64 + 32 * hi + 8 * j;
                        *(f32x4*)o = (f32x4){(float)v[0], (float)v[1], (float)v[2], (float)v[3]}; *(f32x4*)(o + 4) = (f32x4){(float)v[4], (float)v[5], (float)v[6], (float)v[7]};
                    }
                    *(f16x8*)(vt + 8 * j) = v;
                }
            }
        } else {
            const float* cvp = C.in[I_CDV] + (((size_t)m.b * 2 + l) * PAST + m.t) * 256;
#pragma unroll
            for (int hd = 0; hd < 4; ++hd) {
                f16* vt = VA + ((((size_t)m.b * 4 + hd) * NT + m.ktile) * 2 + hi) * 2048 + m.kin * 32;
                f32x4 rawc[8];
#pragma unroll
                for (int j = 0; j < 8; ++j) rawc[j] = *(const f32x4*)(cvp + hd * 64 + 32 * hi + 4 * j);
#pragma unroll
                for (int j = 0; j < 8; ++j) *(f16x4*)(vt + 4 * j) = cvt4v(rawc[j]);
            }
        }
    }
}
template <int KIND>
__device__ __forceinline__ void mx_q(const Ctx& C, int l, int wt, int hd, LAS unsigned char* wl) {
    const int lane = lane_id_fresh(), tok = lane & 31, hi = lane >> 5;
    const MxTok m = mx_decode<KIND>(wt, tok, l);
    const f16* prow = WSP(f16, WS_ACT) + m.row * DINP;
    float cr[4], sr[4], cc[4], scn[4];
    mx_rope<KIND>(m.t, hi, cr, sr, cc, scn);
    f16x8 bq[12]; float ss = 0.f;
#pragma unroll
    for (int ks = 0; ks < 12; ++ks) { bq[ks] = *(const f16x8*)(prow + PC_CQ + 16 * ks + 8 * hi);
#pragma unroll
        for (int e = 0; e < 8; ++e) { const float f = (float)bq[ks][e]; ss += f * f; } }
    ss += __shfl_xor(ss, 32);
    const float rstd = 1.0f / sqrtf(ss * (1.0f / 192.0f) + EPS);
    const float* gq = C.in[I_QKN] + ((size_t)l * 2 + 0) * 96;
    f32x4 gqv[3][4];
#pragma unroll
    for (int t3 = 0; t3 < 3; ++t3)
#pragma unroll
        for (int g = 0; g < 4; ++g) gqv[t3][g] = *(const f32x4*)(gq + 32 * t3 + 8 * g + 4 * hi);
    ATT_WAITBAR(0);
    LAS unsigned char* wp = wl + hi * 512 + tok * 16;
    f32x16 acc[3];
#pragma unroll
    for (int t3 = 0; t3 < 3; ++t3) { acc[t3] = (f32x16){};
#pragma unroll
        for (int ks = 0; ks < 12; ++ks) acc[t3] = MFMA32(*(const LAS f16x8*)(wp + (t3 * 24 + 2 * ks) * 512), bq[ks], acc[t3]); }
    float s2 = 0.f;
#pragma unroll
    for (int t3 = 0; t3 < 3; ++t3)
#pragma unroll
        for (int r = 0; r < 16; ++r) s2 += acc[t3][r] * acc[t3][r];
    s2 += __shfl_xor(s2, 32);
    const float rs = rstd / sqrtf(s2 * (rstd * rstd) * (1.0f / 96.0f) + EPS);
#pragma unroll
    for (int t3 = 0; t3 < 3; ++t3)
#pragma unroll
        for (int g = 0; g < 4; ++g) { const f32x4 gg = gqv[t3][g];
#pragma unroll
            for (int e = 0; e < 4; ++e) acc[t3][4 * g + e] *= rs * gg[e]; }
    if (KIND == 1) {
#pragma unroll
        for (int e = 0; e < 4; ++e) {
            const float a1 = acc[2][e], a2 = acc[2][8 + e]; acc[2][e] = a1 * cr[e] - a2 * sr[e]; acc[2][8 + e] = a2 * cr[e] + a1 * sr[e];
            const float b1 = acc[2][4 + e], b2 = acc[2][12 + e]; acc[2][4 + e] = b1 * cc[e] - b2 * scn[e]; acc[2][12 + e] = b2 * cc[e] + b1 * scn[e];
        }
    }
    const float sc = 0.10206207261596575f * LOG2E;
    f16* o = WSP(f16, WS_QC) + m.row * 384 + hd * 96 + 4 * hi;
#pragma unroll
    for (int t3 = 0; t3 < 3; ++t3)
#pragma unroll
        for (int g = 0; g < 4; ++g) *(f16x4*)(o + 32 * t3 + 8 * g) = cvt4(acc[t3][4 * g] * sc, acc[t3][4 * g + 1] * sc, acc[t3][4 * g + 2] * sc, acc[t3][4 * g + 3] * sc);
}
template <int KIND>
__device__ __forceinline__ void mx_kv(const Ctx& C, int l, int wt, int hd, LAS unsigned char* wl) {
    const int lane = lane_id_fresh(), tok = lane & 31, hi = lane >> 5;
    constexpr int Tk = (KIND == 0) ? TP : TKS, NT = Tk / 64;
    const MxTok m = mx_decode<KIND>(wt, tok, l);
    const f16* prow = WSP(f16, WS_ACT) + m.row * DINP;
    f16* KC = (KIND == 0) ? WSP(f16, WS_KCP) : WSP(f16, WS_KCS);
    f16* VC = (KIND == 0) ? WSP(f16, WS_VCTP) : WSP(f16, WS_VCTS);
    float cr[4], sr[4], cc[4], scn[4];
    mx_rope<KIND>(m.t, hi, cr, sr, cc, scn);
    f16x8 bk[8]; f32x4 kr[4]; float rstd = 1.0f;
    if (KIND != 2) {
        float ss = 0.f;
#pragma unroll
        for (int ks = 0; ks < 8; ++ks) { bk[ks] = *(const f16x8*)(prow + PC_CKV + 16 * ks + 8 * hi);
#pragma unroll
            for (int e = 0; e < 8; ++e) { const float f = (float)bk[ks][e]; ss += f * f; } }
        ss += __shfl_xor(ss, 32);
        rstd = 1.0f / sqrtf(ss * (1.0f / 128.0f) + EPS);
        if (KIND == 0 && hd == 0) {
            f32x4 gv0[8], gv1[8];
#pragma unroll
            for (int ks = 0; ks < 8; ++ks) { gv0[ks] = *(const f32x4*)(C.in[I_CKVN] + (size_t)l * 128 + 16 * ks + 8 * hi); gv1[ks] = *(const f32x4*)(C.in[I_CKVN] + (size_t)l * 128 + 16 * ks + 8 * hi + 4); }
#pragma unroll
            for (int ks = 0; ks < 8; ++ks) {
                const f32x4 g0 = gv0[ks], g1 = gv1[ks];
                const f16x8 v = bk[ks];
                float* o = C.out + OUT_CKV + m.ob * 128 + 16 * ks + 8 * hi;
                *(f32x4*)o = (f32x4){(float)v[0] * rstd * g0[0], (float)v[1] * rstd * g0[1], (float)v[2] * rstd * g0[2], (float)v[3] * rstd * g0[3]};
                *(f32x4*)(o + 4) = (f32x4){(float)v[4] * rstd * g1[0], (float)v[5] * rstd * g1[1], (float)v[6] * rstd * g1[2], (float)v[7] * rstd * g1[3]};
            }
        }
#pragma unroll
        for (int g = 0; g < 4; ++g) kr[g] = tof32(*(const f16x4*)(prow + PC_KR + 8 * g + 4 * hi));
        if (KIND == 0 && hd == 0) { float* o = C.out + OUT_KR + m.ob * 32 + 4 * hi;
#pragma unroll
            for (int g = 0; g < 4; ++g) *(f32x4*)(o + 8 * g) = kr[g]; }
    } else {
        const float* cp = C.in[I_CCKV] + (((size_t)m.b * 2 + l) * PAST + m.t) * 128;
#pragma unroll
        for (int ks = 0; ks < 8; ++ks) bk[ks] = pack8(cvt4v(*(const f32x4*)(cp + 16 * ks + 8 * hi)), cvt4v(*(const f32x4*)(cp + 16 * ks + 8 * hi + 4)));
        const float* kp = C.in[I_CKR] + (((size_t)m.b * 2 + l) * PAST + m.t) * 32;
#pragma unroll
        for (int g = 0; g < 4; ++g) kr[g] = *(const f32x4*)(kp + 8 * g + 4 * hi);
    }
    float skr = 0.f;
#pragma unroll
    for (int g = 0; g < 4; ++g) skr += (kr[g].x * kr[g].x + kr[g].y * kr[g].y) + (kr[g].z * kr[g].z + kr[g].w * kr[g].w);
    const float* gk = C.in[I_QKN] + ((size_t)l * 2 + 1) * 96;
    f32x4 gkv[3][4];
#pragma unroll
    for (int t3 = 0; t3 < 3; ++t3)
#pragma unroll
        for (int g = 0; g < 4; ++g) gkv[t3][g] = *(const f32x4*)(gk + 32 * t3 + 8 * g + 4 * hi);
    ATT_WAITBAR(0);
    LAS unsigned char* wp = wl + hi * 512 + tok * 16;
    f32x16 acc[2];
#pragma unroll
    for (int t4 = 0; t4 < 2; ++t4) { acc[t4] = (f32x16){};
#pragma unroll
        for (int ks = 0; ks < 8; ++ks) acc[t4] = MFMA32(*(const LAS f16x8*)(wp + (t4 * 16 + 2 * ks) * 512), bk[ks], acc[t4]); }
    float s2 = 0.f;
#pragma unroll
    for (int t4 = 0; t4 < 2; ++t4)
#pragma unroll
        for (int r = 0; r < 16; ++r) s2 += acc[t4][r] * acc[t4][r];
    s2 = s2 * (rstd * rstd) + skr;
    s2 += __shfl_xor(s2, 32);
    const float rs = 1.0f / sqrtf(s2 * (1.0f / 96.0f) + EPS), rsn = rs * rstd;
    f16* ko = KC + ((((size_t)m.b * 4 + hd) * NT + m.ktile) * 12) * 512 + m.kin * 8 + 4 * hi;
#pragma unroll
    for (int t4 = 0; t4 < 2; ++t4)
#pragma unroll
        for (int g = 0; g < 4; ++g) { const f32x4 gg = gkv[t4][g];
            *(f16x4*)(ko + (4 * t4 + g) * 512) = cvt4(acc[t4][4 * g] * rsn * gg[0], acc[t4][4 * g + 1] * rsn * gg[1], acc[t4][4 * g + 2] * rsn * gg[2], acc[t4][4 * g + 3] * rsn * gg[3]); }
    f32x4 kn[4];
#pragma unroll
    for (int g = 0; g < 4; ++g) kn[g] = kr[g] * rs * gkv[2][g];
    if (KIND == 1) {
#pragma unroll
        for (int e = 0; e < 4; ++e) {
            const float a1 = kn[0][e], a2 = kn[2][e]; kn[0][e] = a1 * cr[e] - a2 * sr[e]; kn[2][e] = a2 * cr[e] + a1 * sr[e];
            const float b1 = kn[1][e], b2 = kn[3][e]; kn[1][e] = b1 * cc[e] - b2 * scn[e]; kn[3][e] = b2 * cc[e] + b1 * scn[e];
        }
    }
#pragma unroll
    for (int g = 0; g < 4; ++g) *(f16x4*)(ko + (8 + g) * 512) = cvt4v(kn[g]);
    f16* vo = VC + ((((size_t)m.b * 4 + hd) * NT + m.ktile) * 2) * 2048 + m.kin * 32 + 4 * hi;
#pragma unroll
    for (int t4 = 2; t4 < 4; ++t4) {
        f32x16 av = (f32x16){};
#pragma unroll
        for (int ks = 0; ks < 8; ++ks) av = MFMA32(*(const LAS f16x8*)(wp + (t4 * 16 + 2 * ks) * 512), bk[ks], av);
#pragma unroll
        for (int g = 0; g < 4; ++g) *(f16x4*)(vo + (t4 - 2) * 2048 + 8 * g) = cvt4(av[4 * g] * rstd, av[4 * g + 1] * rstd, av[4 * g + 2] * rstd, av[4 * g + 3] * rstd);
    }
}

template <int DIR, bool PASS2>
__device__ __forceinline__ void lru_dir(const Ctx& C, int l, int ch, int n, const f16x8 (&bx)[2][4], int b, int T, int cidx, int seqch0, bool prompt, int row0, int lane) {
    const int l31 = lane & 31, hi = lane >> 5;
    const f16* wg = WSP(f16, WS_WG);
    const f16* PROJ = WSP(f16, WS_ACT);
    float* SUM = WSP(float, WS_SUM);
    f16* OC = WSP(f16, WS_OCAT);
    const int nch = T >> 6;
    float bg0[2], bg1[2], spl[2], hc[2], At[2], Bt[2];
#pragma unroll
    for (int t2 = 0; t2 < 2; ++t2) {
        const int chn = 64 * n + 32 * t2 + l31;
        bg0[t2] = C.in[I_BGATE][((size_t)(l * 2 + DIR) * 2 + 0) * 512 + chn]; bg1[t2] = C.in[I_BGATE][((size_t)(l * 2 + DIR) * 2 + 1) * 512 + chn];
        spl[t2] = -8.0f * LOG2E * log1pf(__expf(-C.in[I_LLAM][(size_t)(l * 2 + DIR) * 512 + chn]));
        At[t2] = 1.0f; Bt[t2] = 0.0f; hc[t2] = 0.0f;
    }
    if (PASS2) {
        const int cnt = (DIR == 0) ? cidx : (nch - 1 - cidx), m = (cnt + 1) >> 1;
        const int lo = hi ? m : 0, up = hi ? cnt : m;
        float A0 = 1.f, B0 = 0.f, A1 = 1.f, B1 = 0.f;
#pragma unroll 1
        for (int ib = lo; ib < up; ib += 8) {
            float a0[8], b0[8], a1[8], b1[8];
#pragma unroll
            for (int k = 0; k < 8; ++k) {
                const int i = (ib + k < up) ? ib + k : up - 1, j = (DIR == 0) ? i : (nch - 1 - i);
                const float* p = SUM + ((((size_t)(seqch0 + j)) * 8 + n) * 2 + DIR) * 128 + l31;
                a0[k] = p[0]; b0[k] = p[64]; a1[k] = p[32]; b1[k] = p[96];
            }
#pragma unroll
            for (int k = 0; k < 8; ++k) if (ib + k < up) { B0 = a0[k] * B0 + b0[k]; A0 *= a0[k]; B1 = a1[k] * B1 + b1[k]; A1 *= a1[k]; }
        }
        {
            const float pa0 = __shfl_xor(A0, 32), pb0 = __shfl_xor(B0, 32), pa1 = __shfl_xor(A1, 32), pb1 = __shfl_xor(B1, 32);
            const float fa0 = hi ? pa0 : A0, fb0 = hi ? pb0 : B0, sa0 = hi ? A0 : pa0, sb0 = hi ? B0 : pb0;
            const float fa1 = hi ? pa1 : A1, fb1 = hi ? pb1 : B1, sa1 = hi ? A1 : pa1, sb1 = hi ? B1 : pb1;
            float h00 = 0.f, h01 = 0.f;
            if (!prompt) { const float* st = C.in[I_ST] + (((size_t)b * 2 + l) * 2 + DIR) * 512 + 64 * n + l31; h00 = st[0]; h01 = st[32]; }
            hc[0] = sa0 * (fa0 * h00 + fb0) + sb0; hc[1] = sa1 * (fa1 * h01 + fb1) + sb1;
        }
    }
    const f16* idp = WSP(f16, WS_IDN);
    __builtin_amdgcn_sched_barrier(0);
#pragma unroll
    for (int t2 = 0; t2 < 2; ++t2) {
        f16x8 w0[4], w1[4], idn[4];
#pragma unroll
        for (int ks = 0; ks < 4; ++ks) {
            w0[ks] = *(const f16x8*)(wg + ((((size_t)(l * 2 + DIR) * 2 + 0) * 8 + n) * 64 + 32 * t2 + l31) * 64 + 16 * ks + 8 * hi);
            w1[ks] = *(const f16x8*)(wg + ((((size_t)(l * 2 + DIR) * 2 + 1) * 8 + n) * 64 + 32 * t2 + l31) * 64 + 16 * ks + 8 * hi);
            idn[ks] = *(const f16x8*)(idp + (32 * t2 + l31) * 64 + 16 * ks + 8 * hi);
        }
#pragma unroll
        for (int sci = 0; sci < 2; ++sci) {
            const int sc = DIR ? 1 - sci : sci;
            f32x16 g0 = (f32x16){}, g1 = (f32x16){}, X = (f32x16){};
#pragma unroll
            for (int ks = 0; ks < 4; ++ks) { g0 = MFMA32(bx[sc][ks], w0[ks], g0); g1 = MFMA32(bx[sc][ks], w1[ks], g1); X = MFMA32(bx[sc][ks], idn[ks], X); }
#pragma unroll
            for (int r = 0; r < 16; ++r) {
                const float rr = sigmoidf_(g0[r] + bg0[t2]), ii = sigmoidf_(g1[r] + bg1[t2]);
                const float a = fexp2(rr * spl[t2]);
                g0[r] = a; g1[r] = __builtin_amdgcn_sqrtf(fmaxf(1.0f - a * a, 0.f)) * (ii * X[r]);
            }
            float As[4], Bs[4], Ap[4], Bp[4];
#pragma unroll
            for (int g = 0; g < 4; ++g) {
                float pa = 1.f, pb = 0.f;
#pragma unroll
                for (int ee = 0; ee < 4; ++ee) { const int e = DIR ? 3 - ee : ee; pb = g0[4 * g + e] * pb + g1[4 * g + e]; pa *= g0[4 * g + e]; }
                As[g] = pa; Bs[g] = pb; Ap[g] = __shfl_xor(pa, 32); Bp[g] = __shfl_xor(pb, 32);
            }
            float h = hc[t2];
#pragma unroll
            for (int gi = 0; gi < 4; ++gi) {
                const int g = DIR ? 3 - gi : gi;
                const bool mine_first = DIR ? (hi == 1) : (hi == 0);
                const float fa = mine_first ? As[g] : Ap[g], fb = mine_first ? Bs[g] : Bp[g], sa = mine_first ? Ap[g] : As[g], sb = mine_first ? Bp[g] : Bs[g];
                const float mid = fa * h + fb;
                float hh = mine_first ? h : mid;
                if (PASS2) {
#pragma unroll
                    for (int ee = 0; ee < 4; ++ee) { const int e = DIR ? 3 - ee : ee; hh = g0[4 * g + e] * hh + g1[4 * g + e]; g1[4 * g + e] = hh; }
                }
                h = sa * mid + sb;
                if (!PASS2) { Bt[t2] = sa * (fa * Bt[t2] + fb) + sb; At[t2] *= fa * sa; }
            }
            hc[t2] = h;
            if (PASS2) {
                f16* op = OC + (size_t)(row0 + 32 * sc + 4 * hi) * DM + 256 + 64 * n + 32 * t2 + l31;
                if (DIR == 0) {
#pragma unroll
                    for (int r = 0; r < 16; ++r) op[(size_t)((r & 3) + 8 * (r >> 2)) * DM] = (f16)g1[r];
                } else {
                    f32x16 G = (f32x16){};
#pragma unroll
                    for (int ks = 0; ks < 4; ++ks) {
                        const f16x8 gbf = *(const f16x8*)(PROJ + (size_t)(row0 + 32 * sc + l31) * DINP + PC_GB + 64 * n + 16 * ks + 8 * hi);
                        G = MFMA32(gbf, idn[ks], G);
                    }
                    float hfv[16];
#pragma unroll
                    for (int r = 0; r < 16; ++r) hfv[r] = (float)op[(size_t)((r & 3) + 8 * (r >> 2)) * DM];
#pragma unroll
                    for (int r = 0; r < 16; ++r) {
                        f16* q = op + (size_t)((r & 3) + 8 * (r >> 2)) * DM;
                        const float hf = hfv[r];
                        const float x = G[r], u = 0.7978845608028654f * (x + 0.044715f * x * x * x);
                        const float th = 1.0f - 2.0f * frcp(1.0f + fexp2(2.0f * u * LOG2E));
                        *q = (f16)((hf + g1[r]) * (0.5f * x * (1.0f + th)));
                    }
                }
            }
            FENCE(); __builtin_amdgcn_sched_barrier(0);
        }
    }
    if (!PASS2) {
        if (hi == 0) { float* sa = SUM + ((((size_t)ch) * 8 + n) * 2 + DIR) * 128 + l31; sa[0] = At[0]; sa[64] = Bt[0]; sa[32] = At[1]; sa[96] = Bt[1]; }
    } else if (prompt) {
        const bool fin = (DIR == 0) ? (cidx == nch - 1) : (cidx == 0);
        if (fin && hi == 0) { float* o = C.out + OUT_ST + (((size_t)b * 2 + l) * 2 + DIR) * 512 + 64 * n + l31; o[0] = hc[0]; o[32] = hc[1]; }
    }
}
template <bool PASS2>
__device__ __forceinline__ void lru_item(const Ctx& C, int l, int ch, int n) {
    const int lane = lane_id_fresh(), l31 = lane & 31, hi = lane >> 5;
    const f16* PROJ = WSP(f16, WS_ACT);
    const int row0 = ch * 64;
    const bool prompt = row0 < MP;
    int b, t0, T, seqrow0;
    if (prompt) { b = row0 >> 8; t0 = row0 & 255; T = TP; seqrow0 = b * TP; } else { const int rs = row0 - MP; b = rs >> 11; t0 = rs & 2047; T = TS; seqrow0 = MP + b * TS; }
    const int cidx = t0 >> 6, seqch0 = seqrow0 >> 6;
    f16x8 bx[2][4];
    f16x8* xcbuf = WSP(f16x8, WS_XC) + ((size_t)(ch * 8 + n) * 8) * 64 + lane;
    if (PASS2) {
#pragma unroll
        for (int sc = 0; sc < 2; ++sc)
#pragma unroll
            for (int ks = 0; ks < 4; ++ks) bx[sc][ks] = xcbuf[(sc * 4 + ks) * 64];
    } else
#pragma unroll
    for (int ks = 0; ks < 4; ++ks) {
        int chn = 64 * n + 16 * ks + 8 * hi; asm volatile("" : "+v"(chn));
        f32x4 w0[4], w1[4];
#pragma unroll
        for (int j = 0; j < 4; ++j) { w0[j] = *(const f32x4*)(C.in[I_CONVW] + ((size_t)l * 4 + j) * 512 + chn); w1[j] = *(const f32x4*)(C.in[I_CONVW] + ((size_t)l * 4 + j) * 512 + chn + 4); }
        const f32x4 c0 = *(const f32x4*)(C.in[I_CONVB] + (size_t)l * 512 + chn), c1 = *(const f32x4*)(C.in[I_CONVB] + (size_t)l * 512 + chn + 4);
#pragma unroll
        for (int sc = 0; sc < 2; ++sc) {
            const int t = t0 + 32 * sc + l31;
            f16x8 v[4]; float wm[4];
#pragma unroll
            for (int j = 0; j < 4; ++j) { const int tt = t + j - 2; const bool ok = (tt >= 0 && tt < T); wm[j] = ok ? 1.0f : 0.0f;
                v[j] = *(const f16x8*)(PROJ + (size_t)(seqrow0 + (ok ? tt : t)) * DINP + PC_XB + chn); }
            f32x4 a0 = c0, a1 = c1;
#pragma unroll
            for (int j = 0; j < 4; ++j) { a0 += (w0[j] * wm[j]) * (f32x4){(float)v[j][0], (float)v[j][1], (float)v[j][2], (float)v[j][3]}; a1 += (w1[j] * wm[j]) * (f32x4){(float)v[j][4], (float)v[j][5], (float)v[j][6], (float)v[j][7]}; }
            bx[sc][ks] = pack8(cvt4v(a0), cvt4v(a1));
            xcbuf[(sc * 4 + ks) * 64] = bx[sc][ks];
        }
        FENCE(); __builtin_amdgcn_sched_barrier(0);
    }
    __builtin_amdgcn_sched_barrier(0);
    lru_dir<0, PASS2>(C, l, ch, n, bx, b, T, cidx, seqch0, prompt, row0, lane);
    FENCE(); __builtin_amdgcn_sched_barrier(0);
    lru_dir<1, PASS2>(C, l, ch, n, bx, b, T, cidx, seqch0, prompt, row0, lane);
}

constexpr int ATT_SLOT = 20480, ATT_VOFF = 12288;
constexpr float ATT_THR = 8.0f;
typedef short v4i16_t __attribute__((ext_vector_type(4)));
__device__ __forceinline__ f16x4 lds_tr(LAS unsigned char* p) { return __builtin_bit_cast(f16x4, __builtin_amdgcn_ds_read_tr16_b64_v4i16((LAS v4i16_t*)p)); }
template <int TYPE>
__device__ __forceinline__ void attn_unit(const Ctx& C, int l, int kind, int b, int hd, int qblk) {
    const int lane = lane_id_fresh(), tok = lane & 31, hi = lane >> 5, wid = C.wave;
    constexpr int NC = TYPE ? 12 : 8, KTILE = NC * 512;
    const int Tk = kind ? TKS : TP, NT = Tk >> 6;
    const size_t row = (kind ? (size_t)MP + (size_t)b * TS : (size_t)b * TP) + 256 * qblk + 32 * wid + tok;
    const f16* Kimg = (TYPE ? (kind ? WSP(f16, WS_KCS) : WSP(f16, WS_KCP)) : (kind ? WSP(f16, WS_KAS) : WSP(f16, WS_KAP))) + ((size_t)b * 4 + hd) * NT * KTILE + lane * 8;
    const f16* Vimg = (TYPE ? (kind ? WSP(f16, WS_VCTS) : WSP(f16, WS_VCTP)) : (kind ? WSP(f16, WS_VATS) : WSP(f16, WS_VATP))) + ((size_t)b * 4 + hd) * NT * 4096 + wid * 512 + lane * 8;
    LAS unsigned char* lds = C.lds;
    const bool two = (TYPE == 1) && (wid < 4);
#define ATT_DMA(t, sl) do { const f16* kt_ = Kimg + (size_t)(t) * KTILE; LAS unsigned char* ls_ = lds + (sl) * ATT_SLOT; \
        ATT_GLDS(kt_ + wid * 512, ls_ + wid * 1024); if (two) ATT_GLDS(kt_ + (8 + wid) * 512, ls_ + (8 + wid) * 1024); \
        ATT_GLDS(Vimg + (size_t)(t) * 4096, ls_ + ATT_VOFF + wid * 1024); } while (0)
    f16x8 bq[TYPE ? 6 : 4];
    if (TYPE) {
#pragma unroll
        for (int ks = 0; ks < 6; ++ks) bq[ks] = *(const f16x8*)(WSP(f16, WS_QC) + row * 384 + hd * 96 + 16 * ks + 8 * hi);
    } else {
#pragma unroll
        for (int i = 0; i < 4; ++i) bq[i] = *(const f16x8*)(WSP(f16, WS_QA) + row * 256 + hd * 64 + 16 * i + 8 * hi);
    }
    float lam = 0.f, lam_init = 0.f;
    if (TYPE == 0) {
        const float* lp = C.in[I_DLAM] + (size_t)l * 128;
        float s1 = (lane < 32) ? lp[lane] * lp[32 + lane] : 0.f, s2 = (lane < 32) ? lp[64 + lane] * lp[96 + lane] : 0.f;
        s1 = wave_sum(s1); s2 = wave_sum(s2);
        lam_init = 0.8f - 0.6f * expf(-0.3f * (float)l);
        lam = expf(s1) - expf(s2) + lam_init;
    }
#pragma unroll
    for (int i = 0; i < (TYPE ? 6 : 4); ++i) asm volatile("" : "+v"(bq[i]));
    asm volatile("" : "+v"(lam), "+v"(lam_init));
    ATT_DMA(0, 0); ATT_DMA(1, 1);
    if (two) { ATT_WAITBAR(3); } else { ATT_WAITBAR(2); }
    float m0 = 0.f, m1 = 0.f;
    f32x16 O0[2], O1[2], L0 = (f32x16){}, L1 = (f32x16){}; O0[0] = (f32x16){}; O0[1] = (f32x16){}; O1[0] = (f32x16){}; O1[1] = (f32x16){};
    const f16x8 ones = {(f16)1.0f, (f16)1.0f, (f16)1.0f, (f16)1.0f, (f16)1.0f, (f16)1.0f, (f16)1.0f, (f16)1.0f};
    int s_cur = 0, s_nx2 = 2;
    LAS unsigned char* vb0 = lds + ATT_VOFF + (4 * hi + ((lane & 15) >> 2)) * 64 + ((lane >> 4) & 1) * 32 + (lane & 3) * 8;
    LAS unsigned char* kb0 = lds + hi * 1024 + tok * 16;
#pragma unroll 1
    for (int t = 0; t < NT; ++t) {
        if (t + 2 < NT) ATT_DMA(t + 2, s_nx2);
        LAS unsigned char* kb = kb0 + s_cur * ATT_SLOT; LAS unsigned char* vb = vb0 + s_cur * ATT_SLOT;
        f16x8 pf[TYPE ? 1 : 2][2][2];
#pragma unroll
        for (int c = 0; c < (TYPE ? 1 : 2); ++c) {
            f32x16 S[2];
            {
                f16x8 kf[2][TYPE ? 6 : 2];
#pragma unroll
                for (int sub = 0; sub < 2; ++sub)
#pragma unroll
                    for (int ks = 0; ks < (TYPE ? 6 : 2); ++ks) kf[sub][ks] = *(const LAS f16x8*)(kb + c * 4096 + ks * 2048 + sub * 512);
                __builtin_amdgcn_sched_barrier(0);
#pragma unroll
                for (int sub = 0; sub < 2; ++sub) { S[sub] = (f32x16){};
#pragma unroll
                    for (int ks = 0; ks < (TYPE ? 6 : 2); ++ks) S[sub] = MFMA32(kf[sub][ks], bq[c * 2 + ks], S[sub]); }
                __builtin_amdgcn_sched_barrier(0);
            }
            float ma = fmaxf(fmaxf(S[0][0], S[0][1]), S[1][0]), mb = fmaxf(fmaxf(S[0][2], S[0][3]), S[1][1]);
            ma = fmaxf(fmaxf(ma, S[1][2]), S[1][3]);
#pragma unroll
            for (int r = 4; r < 16; r += 4) { ma = fmaxf(fmaxf(ma, S[0][r]), S[0][r + 1]); mb = fmaxf(fmaxf(mb, S[0][r + 2]), S[0][r + 3]); ma = fmaxf(fmaxf(ma, S[1][r]), S[1][r + 1]); mb = fmaxf(fmaxf(mb, S[1][r + 2]), S[1][r + 3]); }
            float rm = fmaxf(ma, mb); rm = fmaxf(rm, __shfl_xor(rm, 32));
            float mref = c ? m1 : m0;
            if (t == 0) mref = rm;
            else if (__any(rm - mref > ATT_THR)) {
                const float dl = fmaxf(rm - mref, 0.f), f = fexp2(-dl); mref += dl;
                if (c == 0) {
#pragma unroll
                    for (int r = 0; r < 16; ++r) { O0[0][r] *= f; O0[1][r] *= f; L0[r] *= f; }
                } else {
#pragma unroll
                    for (int r = 0; r < 16; ++r) { O1[0][r] *= f; O1[1][r] *= f; L1[r] *= f; }
                }
            }
            if (c == 0) m0 = mref; else m1 = mref;
#pragma unroll
            for (int sub = 0; sub < 2; ++sub)
#pragma unroll
                for (int r = 0; r < 16; ++r) S[sub][r] = fexp2(S[sub][r] - mref);
#pragma unroll
            for (int sub = 0; sub < 2; ++sub)
#pragma unroll
                for (int sp = 0; sp < 2; ++sp) pf[c][sub][sp] = pack8(cvt4(S[sub][8 * sp], S[sub][8 * sp + 1], S[sub][8 * sp + 2], S[sub][8 * sp + 3]), cvt4(S[sub][8 * sp + 4], S[sub][8 * sp + 5], S[sub][8 * sp + 6], S[sub][8 * sp + 7]));
        }
#pragma unroll
        for (int vt = 0; vt < 2; ++vt) {
            f16x4 vlo[4], vhi[4];
#pragma unroll
            for (int k4 = 0; k4 < 4; ++k4) { vlo[k4] = lds_tr(vb + vt * 4096 + k4 * 1024); vhi[k4] = lds_tr(vb + vt * 4096 + k4 * 1024 + 512); }
            __builtin_amdgcn_sched_barrier(0);
#pragma unroll
            for (int k4 = 0; k4 < 4; ++k4) {
                const f16x8 vf = pack8(vlo[k4], vhi[k4]);
                O0[vt] = MFMA32(vf, pf[0][k4 >> 1][k4 & 1], O0[vt]);
                if (TYPE == 0) O1[vt] = MFMA32(vf, pf[TYPE ? 0 : 1][k4 >> 1][k4 & 1], O1[vt]);
            }
            __builtin_amdgcn_sched_barrier(0);
        }
#pragma unroll
        for (int k4 = 0; k4 < 4; ++k4) { L0 = MFMA32(ones, pf[0][k4 >> 1][k4 & 1], L0); if (TYPE == 0) L1 = MFMA32(ones, pf[TYPE ? 0 : 1][k4 >> 1][k4 & 1], L1); }
        if (t + 1 < NT) {
            if (t + 2 < NT) { if (two) { ATT_WAITBAR(3); } else { ATT_WAITBAR(2); } } else { ATT_WAITBAR(0); }
        }
        s_nx2 = s_cur; s_cur = (s_cur == 2) ? 0 : s_cur + 1;
    }
#undef ATT_DMA
    f16* o = WSP(f16, WS_OCAT) + row * DM + (TYPE ? 768 : 0) + hd * 64 + 4 * hi;
    if (TYPE) {
        const float inv = 1.0f / L0[0];
#pragma unroll
        for (int vt = 0; vt < 2; ++vt)
#pragma unroll
            for (int g = 0; g < 4; ++g) *(f16x4*)(o + 32 * vt + 8 * g) = cvt4(O0[vt][4 * g] * inv, O0[vt][4 * g + 1] * inv, O0[vt][4 * g + 2] * inv, O0[vt][4 * g + 3] * inv);
    } else {
        const float i0 = 1.0f / L0[0], i1 = lam / L1[0];
        float ss = 0.f;
#pragma unroll
        for (int vt = 0; vt < 2; ++vt)
#pragma unroll
            for (int r = 0; r < 16; ++r) { const float v = O0[vt][r] * i0 - O1[vt][r] * i1; O0[vt][r] = v; ss += v * v; }
        ss += __shfl_xor(ss, 32);
        const float rs = (1.0f / sqrtf(ss * (1.0f / 64.0f) + EPS)) * (1.0f - lam_init);
        const float* sg = C.in[I_DSUB] + (size_t)l * 64 + 4 * hi;
        f32x4 sgv[2][4];
#pragma unroll
        for (int vt = 0; vt < 2; ++vt)
#pragma unroll
            for (int g = 0; g < 4; ++g) sgv[vt][g] = *(const f32x4*)(sg + 32 * vt + 8 * g);
#pragma unroll
        for (int vt = 0; vt < 2; ++vt)
#pragma unroll
            for (int g = 0; g < 4; ++g) { const f32x4 gg = sgv[vt][g];
                *(f16x4*)(o + 32 * vt + 8 * g) = cvt4(O0[vt][4 * g] * rs * gg[0], O0[vt][4 * g + 1] * rs * gg[1], O0[vt][4 * g + 2] * rs * gg[2], O0[vt][4 * g + 3] * rs * gg[3]); }
    }
    ATT_LBAR();
}

template <int mode>
__device__ __forceinline__ void phase_mx(const Ctx& C0, int l, unsigned* ctr) {
    const Ctx C = ctx_fresh(C0);
#pragma unroll 1
    for (int u = C.bid; u < 544; u += C.G) {
        ATT_LBAR();
        if (mode == 1 || mode == 4) continue;
#ifndef NO_MXT
        const int lane = lane_id_fresh();
        if (u < 288) {
            const int g = u >> 2, hd = u & 3;
            const f16* wsrc = ((g < 64) ? WSP(f16, WS_WUKV) : WSP(f16, WS_WUKV0)) + ((size_t)(l * 4 + hd) * 32) * 512 + lane * 8;
#pragma unroll
            for (int i = 0; i < 4; ++i) ATT_GLDS(wsrc + (C.wave + 8 * i) * 512, C.lds + (C.wave + 8 * i) * 1024);
            if (g < 32) mx_kv<0>(C, l, g * 8 + C.wave, hd, C.lds); else if (g < 64) mx_kv<1>(C, l, g * 8 + C.wave, hd, C.lds); else mx_kv<2>(C, l, 512 + (g - 64) * 8 + C.wave, hd, C.lds);
        } else {
            const int v = u - 288, g = v >> 2, hd = v & 3;
            const f16* wsrc = WSP(f16, WS_WUQ) + ((size_t)(l * 4 + hd) * 36) * 512 + lane * 8;
#pragma unroll
            for (int i = 0; i < 5; ++i) if (C.wave + 8 * i < 36) ATT_GLDS(wsrc + (C.wave + 8 * i) * 512, C.lds + (C.wave + 8 * i) * 1024);
            if (g < 32) mx_q<0>(C, l, g * 8 + C.wave, hd, C.lds); else mx_q<1>(C, l, g * 8 + C.wave, hd, C.lds);
        }
#endif
    }
    constexpr int NA = 512 + 576 + 576;
#ifndef NO_LRU1
    if (mode != 2 && mode != 3 && mode != 4)
#pragma unroll 1
        for (int i = C.gw; i < 2048; i += C.ngw) lru_item<false>(C, l, i >> 3, i & 7);
#endif
#ifndef NO_MXT
    if (mode != 1 && mode != 3)
#pragma unroll 1
        for (int it = C.ngw - 1 - C.gw; it < NA; it += C.ngw) {
            if (it < 512) { if (it < 256) mx_a<0, 0>(C, l, it); else mx_a<1, 0>(C, l, it); }
            else if (it < 1088) { const int w = it - 512; if (w < 256) mx_a<0, 1>(C, l, w); else if (w < 512) mx_a<1, 1>(C, l, w); else mx_a<2, 1>(C, l, w); }
            else { const int w = it - 1088; if (w < 256) mx_a<0, 2>(C, l, w); else if (w < 512) mx_a<1, 2>(C, l, w); else mx_a<2, 2>(C, l, w); }
        }
#endif
}

template <int mode>
__device__ __forceinline__ void phase_att(const Ctx& C0, int l, unsigned* ctr) {
    const Ctx C = ctx_fresh(C0);
    const int half = C.G >> 1;
    if (mode != 1) {
#pragma unroll 1
        for (int u = C.bid; u < 128; u += half) { if (C.bid >= half) break;
#ifndef NO_ATTA
            if (mode == 0 || mode == 2 || mode == 5) { const int pr = (u & 7) * 2 + ((u >> 3) >> 3), qb = (u >> 3) & 7;
                attn_unit<0>(C, l, 1, pr >> 2, pr & 3, qb); }
#endif
        }
        if (C.bid >= half) {
#pragma unroll 1
            for (int u = C.bid - half; u < 128; u += half) {
#ifndef NO_ATTC
                if (mode == 0 || mode == 2 || mode == 6) { const int pr = (u & 7) * 2 + ((u >> 3) >> 3), qb = (u >> 3) & 7;
                    attn_unit<1>(C, l, 1, pr >> 2, pr & 3, qb); }
#endif
            }
#pragma unroll 1
            for (int u = C.bid - half; u < 128; u += half) {
#ifndef NO_ATTA
                if (mode == 0 || mode == 2 || mode == 7) attn_unit<0>(C, l, 0, u >> 2, u & 3, 0);
#endif
#ifndef NO_ATTC
                if (mode == 0 || mode == 2 || mode == 7) attn_unit<1>(C, l, 0, u >> 2, u & 3, 0);
#endif
            }
        }
    }
#ifndef NO_LRU2
    if (mode == 0 || mode == 1) {
#pragma unroll 1
        for (int it = C.gw; it < 2048; it += C.ngw) lru_item<true>(C, l, it >> 3, it & 7);
    }
#endif
}

__global__ void __launch_bounds__(512, 2) mk_fwd(Args args) {
    extern __shared__ __attribute__((aligned(16))) unsigned char lds_raw[];
    Ctx C;
    C.in = args.in; C.out = args.out; C.ws = args.ws;
    C.lds = (LAS unsigned char*)lds_raw;
    C.tid = threadIdx.x; C.lane = C.tid & 63; C.wave = __builtin_amdgcn_readfirstlane(C.tid >> 6);
    C.gw = 0; C.ngw = 0; C.bid = 0; C.G = 0;
    volatile LAS unsigned* MISC = (volatile LAS unsigned*)(C.lds + MISC_OFF);
    for (int u = C.tid; u < (LDS_BYTES - LDSCTL_OFF) / 4; u += 512) ((LAS unsigned*)(C.lds + LDSCTL_OFF))[u] = 0u;
    __syncthreads();
    unsigned* ctl = (unsigned*)(args.ws + WS_CTL);
    XcdBarrier bar = xcd_barrier_post(ctl + CW_BAR, MISC + 8);
    const int lo = args.ph_lo, hi = args.ph_hi;
#define IN(k) (lo <= (k) && (k) < hi)
#define SEAM(k) do { if (IN(k) && IN((k) + 1)) xcd_barrier(bar); } while (0)

    int rep = 0;
#pragma unroll 1
    for (int p = lo; p < hi; ++p) {
        const int l = (p >= 10) ? 1 : 0, q = (p < 2) ? -1 - p : (p - 2 - 8 * l);
        int bid = blockIdx.x, G = gridDim.x; asm volatile("" : "+s"(bid), "+s"(G));
        const float* modl = WSP(float, WS_MOD) + (size_t)l * 5 * NMODV;
        if (q == -1) {
#ifndef NO_PREP
            phase_prep(C);
#endif
        } else if (q == -2) phase_norm<true>(C, 0, 0);
        else if (q == 0 || q == 6) {
            const int s = (q == 6);
            pg8::Gemm g{WSP(f16, WS_H), WSP(f16, WS_WFI) + (size_t)(l * 2 + s) * NFF2 * 1024, M, NFF2, 1024}; pg8::StaticOrder S; S.init(M, NFF2, G, bid);
            pg8::EpiSwiglu E{WSP(f16, WS_ACT)};
            pg8::gemm_phase<pg8::EpiSwiglu, pg8::StaticOrder, true, true>(C.lds, g, S, E, C.wave);
        } else if (q == 1 || q == 7 || q == 5) {
            const int s = (q == 7);
            const f16* A = (q == 5) ? WSP(f16, WS_OCAT) : WSP(f16, WS_ACT);
            const f16* B = (q == 5) ? WSP(f16, WS_WOUT) + (size_t)l * 1024 * 1024 : WSP(f16, WS_WFO) + (size_t)(l * 2 + s) * 1024 * DFF;
            pg8::Gemm g{A, B, M, 1024, (q == 5) ? 1024 : DFF}; pg8::StaticOrder S; S.init(M, 1024, G, bid);
            const int nl = (q == 7) ? l + 1 : l, nsub = (q == 1) ? 1 : ((q == 5) ? 2 : 0), donorm = (nl < DEPTH) ? 1 : 0, nlc = donorm ? nl : l;
            pg8::EpiResidNorm E{C.out, WSP(f16, WS_XH), modl, (q == 5) ? 5 : (s ? 8 : 2), (rep > 0) ? 0.0f : ((q == 5) ? 1.0f : 0.5f),
                                donorm, WSP(f16, WS_H), C.in[I_NG] + ((size_t)nlc * 3 + nsub) * DM, WSP(float, WS_MOD) + (size_t)nlc * 5 * NMODV + (3 * nsub) * DM,
                                WSP(float, WS_XBUF), ctl + CW_PAN + (p + 18 * rep) * 4096};
            pg8::gemm_phase<pg8::EpiResidNorm, pg8::StaticOrder, false, true>(C.lds, g, S, E, C.wave);
        } else if (q == 2) {
            pg8::Gemm g{WSP(f16, WS_H), WSP(f16, WS_WIN) + (size_t)l * DINP * 1024, M, DINP, 1024}; pg8::StaticOrder S; S.init(M, DINP, G, bid);
            pg8::EpiStore E{WSP(f16, WS_ACT), DINP};
            pg8::gemm_phase<pg8::EpiStore, pg8::StaticOrder, true, true>(C.lds, g, S, E, C.wave);
        } else if (q == 3) { if (REP_MODE != 0 && rep) phase_mx<REP_MODE>(C, l, ctl + CW_Q + 64 * (p + 32 * rep)); else phase_mx<0>(C, l, ctl + CW_Q + 64 * (p + 32 * rep)); }
        else if (q == 4) { if (REP_MODE != 0 && rep) phase_att<REP_MODE>(C, l, ctl + CW_Q + 64 * (p + 32 * rep)); else phase_att<0>(C, l, ctl + CW_Q + 64 * (p + 32 * rep)); }
        if (REP_Q == 99 && p == 1) { for (int k = 0; k < 10; ++k) xcd_barrier(bar, C.wave); }
        if (q == REP_Q && rep < REP_N) { ++rep; --p; xcd_barrier(bar, C.wave); continue; }
        rep = 0;
        if (p + 1 < hi) xcd_barrier(bar, C.wave);
    }
#undef IN
#undef SEAM
}

extern "C" void kernel_launch(void* const* d_in, const int* in_sizes, int n_in, void* d_out, int out_size, void* d_ws, size_t ws_size, hipStream_t stream) {
    static int grid = 0;
    if (grid == 0) {
        if (n_in != N_IN || ws_size < WS_END || out_size != 27852800) { fprintf(stderr, "kernel_launch: unexpected shapes: n_in %d ws %zu out %d\n", n_in, ws_size, out_size); grid = -1; return; }
        int dev = 0, cus = 0, per_cu = 0;
        if (hipGetDevice(&dev) != hipSuccess || hipDeviceGetAttribute(&cus, hipDeviceAttributeMultiprocessorCount, dev) != hipSuccess) { grid = -1; return; }
        if (hipFuncSetAttribute((const void*)mk_fwd, hipFuncAttributeMaxDynamicSharedMemorySize, LDS_BYTES) != hipSuccess) { fprintf(stderr, "kernel_launch: hipFuncSetAttribute failed\n"); grid = -1; return; }
        if (hipOccupancyMaxActiveBlocksPerMultiprocessor(&per_cu, (const void*)mk_fwd, 512, LDS_BYTES) != hipSuccess || per_cu < 1) { fprintf(stderr, "kernel_launch: occupancy query says %d\n", per_cu); per_cu = 1; }
        (void)hipGetLastError();
        grid = cus;
    }
    if (grid < 0) return;
    if (hipMemsetAsync((char*)d_ws + WS_CTL, 0, CTL_ZERO_BYTES, stream) != hipSuccess) return;
    Args a{};
    for (int i = 0; i < N_IN; ++i) a.in[i] = (const float*)d_in[i];
    a.out = (float*)d_out; a.ws = (unsigned char*)d_ws;
#if MK_MULTI
    for (int p = 0; p < MK_PH_HI; ++p) { a.ph_lo = p; a.ph_hi = p + 1; hipLaunchKernelGGL(mk_fwd, dim3(grid), dim3(512), LDS_BYTES, stream, a); }
#else
    a.ph_lo = 0; a.ph_hi = MK_PH_HI;
    void* kargs[] = {&a};
    hipError_t e = hipLaunchCooperativeKernel((const void*)mk_fwd, dim3(grid), dim3(512), kargs, LDS_BYTES, stream);
    if (e != hipSuccess) { (void)hipGetLastError(); fprintf(stderr, "kernel_launch: cooperative launch failed (%s), plain launch instead\n", hipGetErrorString(e));
        hipLaunchKernelGGL(mk_fwd, dim3(grid), dim3(512), LDS_BYTES, stream, a); }
#endif
}
```

```cpp
#include <hip/hip_runtime.h>
#include <cstdio>
#include <cstdint>

#define GAS __attribute__((address_space(1)))
#define LAS __attribute__((address_space(3)))
typedef _Float16 f16;
typedef _Float16 f16x2 __attribute__((ext_vector_type(2)));
typedef _Float16 f16x4 __attribute__((ext_vector_type(4)));
typedef _Float16 f16x8 __attribute__((ext_vector_type(8)));
typedef float f32x2 __attribute__((ext_vector_type(2)));
typedef float f32x4 __attribute__((ext_vector_type(4)));
typedef float f32x16 __attribute__((ext_vector_type(16)));
typedef unsigned u32x2 __attribute__((ext_vector_type(2)));
typedef unsigned u32x4 __attribute__((ext_vector_type(4)));
typedef GAS unsigned gu32;

#ifndef MK_PH_HI
#define MK_PH_HI 18
#endif
#ifndef REP_Q
#define REP_Q -2
#endif
#ifndef REP_N
#define REP_N 1
#endif
#ifndef REP_MODE
#define REP_MODE 0
#endif
#ifndef MK_MULTI
#define MK_MULTI 0
#endif

constexpr int DM = 1024, NBP = 32, TP = 256, NBS = 4, TS = 2048, PAST = 512, DEPTH = 2;
constexpr int MP = NBP * TP, MS = NBS * TS, M = MP + MS;
constexpr int DFF = 2816, NFF2 = 5632, DIN = 2144, DINP = 2304, NMODV = 9216;
constexpr int TKS = PAST + TS;
constexpr float EPS = 1e-6f;
constexpr float LOG2E = 1.4426950408889634f;
constexpr int PC_QA = 0, PC_KA = 256, PC_VA = 512, PC_XB = 768, PC_GB = 1280, PC_CQ = 1792, PC_CKV = 1984, PC_KR = 2112;
constexpr size_t OUT_YP = 0, OUT_YS = 8388608, OUT_DK = 16777216, OUT_DV = 20971520, OUT_CKV = 25165824, OUT_KR = 27262976, OUT_ST = 27787264;
enum { I_XP = 0, I_XS, I_CDK, I_CDV, I_CCKV, I_CKR, I_ST, I_C, I_CCTX, I_NG, I_WADA, I_BADA, I_WFI, I_WFO, I_WIN, I_WOUT, I_DQKN, I_DLAM, I_DSUB,
       I_CONVW, I_CONVB, I_WGATE, I_BGATE, I_LLAM, I_CQN, I_CKVN, I_WUQ, I_WUKV, I_QKN, N_IN };

constexpr size_t MiB = 1u << 20;
constexpr size_t WS_CTL = 0, CTL_ZERO_BYTES = 1 * MiB;
constexpr size_t WS_MOD = 1 * MiB;
constexpr size_t WS_WUQ = 2 * MiB;
constexpr size_t WS_WUKV = 2 * MiB + 512 * 1024;
constexpr size_t WS_WUKV0 = 3 * MiB + 512 * 1024;
constexpr size_t WS_IDN = 3 * MiB + 768 * 1024;
constexpr size_t WS_WG = 3 * MiB;
constexpr size_t WS_SUM = 4 * MiB;
constexpr size_t WS_XBUF = 4 * MiB + 2 * MiB + 512 * 1024;
constexpr size_t WS_WFI = 8 * MiB;
constexpr size_t WS_WFO = 52 * MiB;
constexpr size_t WS_WIN = 74 * MiB;
constexpr size_t WS_WOUT = 83 * MiB;
constexpr size_t WS_H = 88 * MiB;
constexpr size_t WS_OCAT = 120 * MiB;
constexpr size_t WS_ACT = 152 * MiB;
constexpr size_t WS_XC = 224 * MiB;
constexpr size_t WS_QA = 240 * MiB;
constexpr size_t WS_QC = 248 * MiB;
constexpr size_t WS_KAS = 260 * MiB;
constexpr size_t WS_KAP = 265 * MiB;
constexpr size_t WS_VATS = 269 * MiB;
constexpr size_t WS_VATP = 274 * MiB;
constexpr size_t WS_KCS = 278 * MiB;
constexpr size_t WS_KCP = 286 * MiB;
constexpr size_t WS_VCTS = 292 * MiB;
constexpr size_t WS_VCTP = 297 * MiB;
constexpr size_t WS_XH = 301 * MiB;
constexpr size_t WS_END = 333 * MiB;
constexpr int CW_BAR = 4096;
constexpr int CW_Q = 16384;
constexpr int CW_PAN = 65536;

constexpr int RING_BYTES = 131072;
constexpr int LDSCTL_OFF = RING_BYTES, MISC_OFF = LDSCTL_OFF + 320;
constexpr int LDS_BYTES = 147456;

__device__ __forceinline__ int crow(int r, int hi) { return (r & 3) + 8 * (r >> 2) + 4 * hi; }
__device__ __forceinline__ int swap23(int x) { return (x & ~12) | ((x & 4) << 1) | ((x & 8) >> 1); }
__device__ __forceinline__ f16x2 cvt2(float a, float b) { f32x2 v = {a, b}; return __builtin_convertvector(v, f16x2); }
__device__ __forceinline__ f16x4 cvt4(float a, float b, float c, float d) { f32x4 v = {a, b, c, d}; return __builtin_convertvector(v, f16x4); }
__device__ __forceinline__ f16x4 cvt4v(f32x4 v) { return __builtin_convertvector(v, f16x4); }
__device__ __forceinline__ f32x4 tof32(f16x4 v) { return __builtin_convertvector(v, f32x4); }
__device__ __forceinline__ f16x8 pack8(f16x4 a, f16x4 b) { return __builtin_shufflevector(a, b, 0, 1, 2, 3, 4, 5, 6, 7); }
__device__ __forceinline__ float fexp2(float x) { return __builtin_amdgcn_exp2f(x); }
__device__ __forceinline__ float frcp(float x) { return __builtin_amdgcn_rcpf(x); }
__device__ __forceinline__ float sigmoidf_(float x) { return frcp(1.0f + fexp2(-x * LOG2E)); }
__device__ __forceinline__ float wave_sum(float v) {
#pragma unroll
    for (int o = 1; o < 64; o <<= 1) v += __shfl_xor(v, o);
    return v;
}
#define FENCE() asm volatile("" ::: "memory")
__device__ __forceinline__ int lane_id_fresh() { int l; asm volatile("v_mbcnt_lo_u32_b32 %0, -1, 0\n\tv_mbcnt_hi_u32_b32 %0, -1, %0" : "=v"(l)); return l; }
#define MFMA32(a, b, c) __builtin_amdgcn_mfma_f32_32x32x16_f16((a), (b), (c), 0, 0, 0)

namespace pg8 {
#define PG8_LAS __attribute__((address_space(3)))
constexpr int BM = 256, BK = 64, HALF = 128, HTB = HALF * BK * 2, STAGE_BYTES = 8 * HTB, NXCD = 8, WGM = 8;
__host__ __device__ __forceinline__ int lds_byte(int r, int c) { const int st = (r >> 4) * 2 + (c >> 5), rr = r & 15, cc = c & 31, ob = rr * 64 + cc * 2; return st * 1024 + (ob ^ (((ob >> 9) & 1) << 5)); }
__host__ __device__ __forceinline__ void stage_rc(int b, int& R, int& C) { const int st = b / 1024, sb = b % 1024, swz = sb ^ (((sb >> 9) & 1) << 5); R = (st >> 1) * 16 + swz / 64; C = (st & 1) * 32 + (swz % 64) / 2; }
__host__ __device__ __forceinline__ int perm32(int rho) { const int n = rho >> 4, i = rho & 15; return 8 * (i >> 2) + 4 * n + (i & 3); }
struct Unit { int pm, pn; };
struct Gemm { const f16* A; const f16* Bt; int M, N, K; };
struct StaticOrder {
    int nM, nN, nwg, G, c;
    __host__ __device__ void init(int M_, int N_, int G_, int c_) { nM = M_ / BM; nN = N_ / BM; nwg = nM * nN; G = G_; c = c_; }
    __host__ __device__ bool next(int i, Unit& u) const {
        const long L = (long)i * G + c; if (L >= nwg) return false;
        int wgid = (int)L; { const int q = nwg / NXCD, r = nwg % NXCD, xcd = wgid % NXCD, off = wgid / NXCD; wgid = (xcd < r ? xcd * (q + 1) : r * (q + 1) + (xcd - r) * q) + off; }
        const int nig = WGM * nN, gid = wgid / nig, fm = gid * WGM, gsz = (nM - fm) < WGM ? (nM - fm) : WGM;
        u.pm = fm + ((wgid % nig) % gsz); u.pn = (wgid % nig) / gsz; return true;
    }
};
struct EpiSwiglu {
    static constexpr bool PERM = true, AFTER_DRAIN = false;
    f16* O;
    __device__ __forceinline__ void operator()(const f32x4 (&acc)[2][2][4][2], const Unit& u, int wr, int wc, int fr, int fq) const {
        const int row0 = u.pm * BM + wr * 64 + fr, col0 = u.pn * 128 + wc * 32 + 8 * fq;
#pragma unroll
        for (int ai = 0; ai < 2; ++ai)
#pragma unroll
            for (int m = 0; m < 4; ++m) {
                f16* rowp = O + (size_t)(row0 + ai * HALF + m * 16) * DFF + col0;
                f32x4 a0, a1;
#pragma unroll
                for (int e = 0; e < 4; ++e) {
                    const float g0 = acc[ai][0][m][0][e], g1 = acc[ai][0][m][1][e];
                    a0[e] = g0 * sigmoidf_(g0) * acc[ai][1][m][0][e];
                    a1[e] = g1 * sigmoidf_(g1) * acc[ai][1][m][1][e];
                }
                *(f16x8*)rowp = pack8(cvt4v(a0), cvt4v(a1));
            }
    }
};
struct EpiStore {
    static constexpr bool PERM = true, AFTER_DRAIN = false;
    f16* O; int ldc;
    __device__ __forceinline__ void operator()(const f32x4 (&acc)[2][2][4][2], const Unit& u, int wr, int wc, int fr, int fq) const {
        const int row0 = u.pm * BM + wr * 64 + fr, col0 = u.pn * BM + wc * 32 + 8 * fq;
#pragma unroll
        for (int ai = 0; ai < 2; ++ai)
#pragma unroll
            for (int m = 0; m < 4; ++m) {
                f16* rowp = O + (size_t)(row0 + ai * HALF + m * 16) * ldc + col0;
#pragma unroll
                for (int bj = 0; bj < 2; ++bj) *(f16x8*)(rowp + bj * HALF) = pack8(cvt4v(acc[ai][bj][m][0]), cvt4v(acc[ai][bj][m][1]));
            }
    }
};
struct EpiResidNorm {
    static constexpr bool PERM = false, AFTER_DRAIN = true;
    float* X; f16* XH; const float* modl; int gidx; float coef;
    int donorm; f16* H; const float* gn; const float* shn;
    float* xbuf; unsigned* cnt;
    __device__ __forceinline__ void fused(f32x4 (&acc)[2][2][4][2], const Unit& u, int wr, int wc, int fr, int fq, PG8_LAS unsigned char* lds, int wid, int lane) const {
        const int cond = (u.pm < 32) ? 4 : ((u.pm - 32) >> 3);
        const int col0 = u.pn * BM + wc * 32 + 4 * fq;
        {
            const float* gp = modl + (size_t)cond * NMODV + gidx * DM + col0;
            f32x4 gv[2][2];
#pragma unroll
            for (int bj = 0; bj < 2; ++bj)
#pragma unroll
                for (int n = 0; n < 2; ++n) gv[bj][n] = *(const f32x4*)(gp + bj * HALF + n * 16) * coef;
#pragma unroll
            for (int ai = 0; ai < 2; ++ai)
#pragma unroll
                for (int m = 0; m < 4; ++m) {
                    const f16* rowp = XH + (size_t)(u.pm * BM + ai * HALF + wr * 64 + m * 16 + fr) * DM + col0;
                    f32x4 xv[2][2];
#pragma unroll
                    for (int bj = 0; bj < 2; ++bj)
#pragma unroll
                        for (int n = 0; n < 2; ++n) xv[bj][n] = tof32(*(const f16x4*)(rowp + bj * HALF + n * 16));
#pragma unroll
                    for (int bj = 0; bj < 2; ++bj)
#pragma unroll
                        for (int n = 0; n < 2; ++n) { const f32x4 v = xv[bj][n] + gv[bj][n] * acc[ai][bj][m][n]; acc[ai][bj][m][n] = v; }
                    asm volatile("" : "+v"(acc[ai][0][m][0]), "+v"(acc[ai][0][m][1]), "+v"(acc[ai][1][m][0]), "+v"(acc[ai][1][m][1]));
                    if (m & 1) asm volatile("" ::: "memory");
                }
        }
        if (!donorm) {
#pragma unroll
            for (int ai = 0; ai < 2; ++ai)
#pragma unroll
                for (int m = 0; m < 4; ++m) {
                    float* rowp = X + (size_t)(u.pm * BM + ai * HALF + wr * 64 + m * 16 + fr) * DM + col0;
#pragma unroll
                    for (int bj = 0; bj < 2; ++bj)
#pragma unroll
                        for (int n = 0; n < 2; ++n) *(f32x4*)(rowp + bj * HALF + n * 16) = acc[ai][bj][m][n];
                }
            return;
        }
        PG8_LAS float* P = (PG8_LAS float*)lds;
        PG8_LAS float* S = (PG8_LAS float*)(lds + 4096);
#pragma unroll
        for (int ai = 0; ai < 2; ++ai)
#pragma unroll
            for (int m = 0; m < 4; ++m) {
                float q = 0.f;
#pragma unroll
                for (int bj = 0; bj < 2; ++bj)
#pragma unroll
                    for (int n = 0; n < 2; ++n) { const f32x4 x = acc[ai][bj][m][n]; q += (x[0] * x[0] + x[1] * x[1]) + (x[2] * x[2] + x[3] * x[3]); }
                q += __shfl_xor(q, 16); q += __shfl_xor(q, 32);
                if (fq == 0) P[(ai * HALF + wr * 64 + m * 16 + fr) * 4 + wc] = q;
            }
        asm volatile("s_waitcnt lgkmcnt(0)" ::: "memory"); __builtin_amdgcn_s_barrier(); asm volatile("" ::: "memory");
        const int row = wid * 32 + (lane & 31);
        if (lane < 32) {
            const float tot = (P[row * 4 + 0] + P[row * 4 + 1]) + (P[row * 4 + 2] + P[row * 4 + 3]);
            __hip_atomic_store(xbuf + ((size_t)(u.pm * BM + row) * 4 + u.pn), tot, __ATOMIC_RELAXED, __HIP_MEMORY_SCOPE_AGENT);
        }
        asm volatile("s_waitcnt vmcnt(0)" ::: "memory");
        if (lane == 0) __hip_atomic_fetch_add(cnt + 64 * u.pm, 1u, __ATOMIC_RELAXED, __HIP_MEMORY_SCOPE_AGENT);
#pragma unroll
        for (int ai = 0; ai < 2; ++ai)
#pragma unroll
            for (int m = 0; m < 4; ++m) {
                f16* rowp = XH + (size_t)(u.pm * BM + ai * HALF + wr * 64 + m * 16 + fr) * DM + col0;
#pragma unroll
                for (int bj = 0; bj < 2; ++bj)
#pragma unroll
                    for (int n = 0; n < 2; ++n) *(f16x4*)(rowp + bj * HALF + n * 16) = cvt4v(acc[ai][bj][m][n]);
            }
        if (wid == 0) {
            unsigned spins = 0;
            for (;;) {
                if ((unsigned)__builtin_amdgcn_readfirstlane(__hip_atomic_load(cnt + 64 * u.pm, __ATOMIC_RELAXED, __HIP_MEMORY_SCOPE_AGENT)) >= 32u) break;
                if (++spins > (1u << 20)) break;
                __builtin_amdgcn_s_sleep(2);
            }
            __builtin_amdgcn_fence(__ATOMIC_ACQUIRE, "agent");
        }
        asm volatile("s_waitcnt vmcnt(0) lgkmcnt(0)" ::: "memory"); __builtin_amdgcn_s_barrier(); asm volatile("" ::: "memory");
        if (lane < 32) {
            const float* slot = xbuf + (size_t)(u.pm * BM + row) * 4;
            const float t0 = __hip_atomic_load(slot + 0, __ATOMIC_RELAXED, __HIP_MEMORY_SCOPE_AGENT), t1 = __hip_atomic_load(slot + 1, __ATOMIC_RELAXED, __HIP_MEMORY_SCOPE_AGENT);
            const float t2 = __hip_atomic_load(slot + 2, __ATOMIC_RELAXED, __HIP_MEMORY_SCOPE_AGENT), t3 = __hip_atomic_load(slot + 3, __ATOMIC_RELAXED, __HIP_MEMORY_SCOPE_AGENT);
            S[row] = 1.0f / sqrtf(((t0 + t1) + (t2 + t3)) * (1.0f / DM) + EPS);
        }
        asm volatile("s_waitcnt lgkmcnt(0)" ::: "memory"); __builtin_amdgcn_s_barrier(); asm volatile("" ::: "memory");
        const float* shp = shn + (size_t)cond * NMODV + col0;
        f32x4 gsv[2][2], shv[2][2];
#pragma unroll
        for (int bj = 0; bj < 2; ++bj)
#pragma unroll
            for (int n = 0; n < 2; ++n) { const int co = bj * HALF + n * 16;
                gsv[bj][n] = *(const f32x4*)(gn + col0 + co) * (*(const f32x4*)(shp + DM + co) + 1.0f); shv[bj][n] = *(const f32x4*)(shp + co); }
#pragma unroll
        for (int ai = 0; ai < 2; ++ai)
#pragma unroll
            for (int m = 0; m < 4; ++m) { const int r = ai * HALF + wr * 64 + m * 16 + fr; const float sr = S[r];
#pragma unroll
                for (int bj = 0; bj < 2; ++bj)
#pragma unroll
                    for (int n = 0; n < 2; ++n) *(f16x4*)(H + (size_t)(u.pm * BM + r) * DM + col0 + bj * HALF + n * 16) = cvt4v(acc[ai][bj][m][n] * sr * gsv[bj][n] + shv[bj][n]); }
    }
};

template <class Epi, class Sched, bool ALIGN_EPI, bool SP2>
__device__ __forceinline__ void gemm_phase(PG8_LAS unsigned char* lds, const Gemm g, const Sched& S, const Epi& E, int wave_id) {
    const int lane = lane_id_fresh(), wid = wave_id, tid = wid * 64 + lane, wr = wid >> 2, wc = wid & 3, fr = lane & 15, fq = lane >> 4;
    const int K = g.K, nt = K / BK;
    unsigned voffA[2], voffB[2];
#pragma unroll
    for (int i = 0; i < 2; ++i) { int R, C; stage_rc(tid * 16 + i * 8192, R, C); const int Rb = Epi::PERM ? ((R & ~31) + perm32(R & 31)) : R;
        voffA[i] = (unsigned)(R * K + C) * 2u; voffB[i] = (unsigned)(Rb * K + C) * 2u; }
    const size_t kstep = (size_t)(BK * 2);
    const size_t hstep = (size_t)HALF * K * 2;
    const size_t tstep = 2 * hstep;
    const unsigned ldsw = (unsigned)wid * 1024u;
    const int aoff = lds_byte(wr * 64 + fr, fq * 8), boff = lds_byte(wc * 32 + fr, fq * 8);
#define PG8_SA(b, h) (((b) * 2 + (h)) * HTB)
#define PG8_SB(b, h) ((4 + (b) * 2 + (h)) * HTB)
#define PG8_STAGE(bufoff, gbase, voff) do { _Pragma("unroll") for (int _i = 0; _i < 2; ++_i) \
        __builtin_amdgcn_global_load_lds((const unsigned*)((const char*)(gbase) + (voff)[_i]), (PG8_LAS unsigned*)(lds + (bufoff) + ldsw + _i * 8192), 16, 0, 0); } while (0)
#define PG8_LDA(dst, b, h) do { _Pragma("unroll") for (int m = 0; m < 4; ++m) _Pragma("unroll") for (int k = 0; k < 2; ++k) dst[m][k] = *(const PG8_LAS f16x8*)(lds + PG8_SA(b, h) + aoff + m * 2048 + k * 1024); } while (0)
#define PG8_LDB(dst, b, h) do { _Pragma("unroll") for (int n = 0; n < 2; ++n) _Pragma("unroll") for (int k = 0; k < 2; ++k) dst[n][k] = *(const PG8_LAS f16x8*)(lds + PG8_SB(b, h) + boff + n * 2048 + k * 1024); } while (0)
#define PG8_MMA(ai, bj, At, Bt) do { __builtin_amdgcn_s_setprio(1); _Pragma("unroll") for (int m = 0; m < 4; ++m) _Pragma("unroll") for (int n = 0; n < 2; ++n) _Pragma("unroll") for (int k = 0; k < 2; ++k) \
        acc[ai][bj][m][n] = __builtin_amdgcn_mfma_f32_16x16x32_f16(Bt[n][k], At[m][k], acc[ai][bj][m][n], 0, 0, 0); __builtin_amdgcn_s_setprio(0); } while (0)
#define PG8_WAIT_V(n) asm volatile("s_waitcnt vmcnt(" #n ")" ::: "memory")
#define PG8_WAIT_L(n) asm volatile("s_waitcnt lgkmcnt(" #n ")" ::: "memory")
#define PG8_BAR __builtin_amdgcn_s_barrier()
#define PG8_SCHED __builtin_amdgcn_sched_barrier(0)
    Unit cur, nxt; int ui = 0;
    if (!S.next(0, cur)) return;
    f32x4 acc[2][2][4][2];
#pragma unroll
    for (int a = 0; a < 2; ++a)
#pragma unroll
        for (int b = 0; b < 2; ++b)
#pragma unroll
            for (int m = 0; m < 4; ++m)
#pragma unroll
                for (int n = 0; n < 2; ++n) acc[a][b][m][n] = (f32x4){0.f, 0.f, 0.f, 0.f};
    f16x8 At[4][2], B0[2][2], B1[2][2];
    const char* cA = (const char*)g.A + (size_t)cur.pm * tstep; const char* cB = (const char*)g.Bt + (size_t)cur.pn * tstep;
    if constexpr (SP2) {
        PG8_STAGE(PG8_SB(0, 0), cB, voffB); PG8_STAGE(PG8_SB(0, 1), cB + hstep, voffB); PG8_STAGE(PG8_SA(0, 0), cA, voffA); PG8_STAGE(PG8_SA(0, 1), cA + hstep, voffA);
        if (wr == 1) PG8_BAR;
        PG8_WAIT_V(2); PG8_BAR;
        PG8_STAGE(PG8_SB(1, 0), cB + kstep, voffB); PG8_STAGE(PG8_SA(1, 0), cA + kstep, voffA); PG8_STAGE(PG8_SB(1, 1), cB + hstep + kstep, voffB);
        PG8_WAIT_V(6); PG8_BAR;
    } else {
        PG8_STAGE(PG8_SB(0, 0), cB, voffB); PG8_STAGE(PG8_SA(0, 0), cA, voffA); PG8_STAGE(PG8_SB(0, 1), cB + hstep, voffB); PG8_STAGE(PG8_SA(0, 1), cA + hstep, voffA);
        if (wr == 1) PG8_BAR;
        PG8_WAIT_V(4); PG8_BAR;
        PG8_STAGE(PG8_SB(1, 0), cB + kstep, voffB); PG8_STAGE(PG8_SA(1, 0), cA + kstep, voffA); PG8_STAGE(PG8_SB(1, 1), cB + hstep + kstep, voffB);
        PG8_WAIT_V(6); PG8_BAR;
    }
    for (;;) {
        const bool has_next = S.next(ui + 1, nxt);
        const char* nA = has_next ? (const char*)g.A + (size_t)nxt.pm * tstep : cA; const char* nB = has_next ? (const char*)g.Bt + (size_t)nxt.pn * tstep : cB;
        for (int t = 0; t < nt; t += 2) {
            const bool last = (t == nt - 2);
            const char* a1 = cA + (size_t)(t + 1) * kstep;
            const char* a2 = last ? nA : cA + (size_t)(t + 2) * kstep; const char* b2 = last ? nB : cB + (size_t)(t + 2) * kstep;
            const char* a3 = a2 + kstep; const char* b3 = b2 + kstep;
            if constexpr (SP2) {
            PG8_LDB(B0, 0, 0); PG8_LDB(B1, 0, 1); PG8_SCHED; PG8_LDA(At, 0, 0); PG8_STAGE(PG8_SA(1, 1), a1 + hstep, voffA);
            PG8_WAIT_V(8); PG8_WAIT_L(0); PG8_BAR; PG8_MMA(0, 0, At, B0); PG8_MMA(0, 1, At, B1); PG8_BAR; PG8_SCHED;
            PG8_LDA(At, 0, 1); PG8_STAGE(PG8_SB(0, 0), b2, voffB); PG8_STAGE(PG8_SB(0, 1), b2 + hstep, voffB); PG8_STAGE(PG8_SA(0, 0), a2, voffA);
            PG8_WAIT_V(8); PG8_WAIT_L(0); PG8_BAR; PG8_MMA(1, 0, At, B0); PG8_MMA(1, 1, At, B1); PG8_BAR; PG8_SCHED;
            PG8_LDB(B0, 1, 0); PG8_LDB(B1, 1, 1); PG8_SCHED; PG8_LDA(At, 1, 0); PG8_STAGE(PG8_SA(0, 1), a2 + hstep, voffA);
            PG8_WAIT_V(8); PG8_WAIT_L(0); PG8_BAR; PG8_MMA(0, 0, At, B0); PG8_MMA(0, 1, At, B1); PG8_BAR; PG8_SCHED;
            PG8_LDA(At, 1, 1); PG8_STAGE(PG8_SB(1, 0), b3, voffB); PG8_STAGE(PG8_SB(1, 1), b3 + hstep, voffB); PG8_STAGE(PG8_SA(1, 0), a3, voffA);
            PG8_WAIT_V(8); PG8_WAIT_L(0); PG8_BAR; PG8_MMA(1, 0, At, B0); PG8_MMA(1, 1, At, B1); PG8_BAR; PG8_SCHED;
            } else {
            PG8_LDB(B0, 0, 0); PG8_SCHED; PG8_LDA(At, 0, 0); PG8_STAGE(PG8_SA(1, 1), a1 + hstep, voffA);
            PG8_WAIT_L(8); PG8_BAR; PG8_WAIT_L(0); PG8_MMA(0, 0, At, B0); PG8_BAR; PG8_SCHED;
            PG8_LDB(B1, 0, 1); PG8_STAGE(PG8_SB(0, 0), b2, voffB);
            PG8_BAR; PG8_WAIT_L(0); PG8_MMA(0, 1, At, B1); PG8_BAR;
            PG8_LDA(At, 0, 1); PG8_STAGE(PG8_SA(0, 0), a2, voffA);
            PG8_BAR; PG8_WAIT_L(0); PG8_MMA(1, 0, At, B0); PG8_BAR; PG8_SCHED;
            PG8_STAGE(PG8_SB(0, 1), b2 + hstep, voffB);
            PG8_WAIT_V(6); PG8_BAR; PG8_MMA(1, 1, At, B1); PG8_BAR;
            PG8_LDB(B0, 1, 0); PG8_SCHED; PG8_LDA(At, 1, 0); PG8_STAGE(PG8_SA(0, 1), a2 + hstep, voffA);
            PG8_WAIT_L(8); PG8_BAR; PG8_WAIT_L(0); PG8_MMA(0, 0, At, B0); PG8_BAR; PG8_SCHED;
            PG8_LDB(B1, 1, 1); PG8_STAGE(PG8_SB(1, 0), b3, voffB);
            PG8_BAR; PG8_WAIT_L(0); PG8_MMA(0, 1, At, B1); PG8_BAR;
            PG8_LDA(At, 1, 1); PG8_STAGE(PG8_SA(1, 0), a3, voffA);
            PG8_BAR; PG8_WAIT_L(0); PG8_MMA(1, 0, At, B0); PG8_BAR; PG8_SCHED;
            PG8_STAGE(PG8_SB(1, 1), b3 + hstep, voffB);
            PG8_WAIT_V(6); PG8_BAR; PG8_MMA(1, 1, At, B1); PG8_BAR;
            }
        }
        if constexpr (ALIGN_EPI) { if (wr == 0) PG8_BAR; }
        if constexpr (!Epi::AFTER_DRAIN) E(acc, cur, wr, wc, fr, fq);
        if (!has_next) break;
#pragma unroll
        for (int a = 0; a < 2; ++a)
#pragma unroll
            for (int b = 0; b < 2; ++b)
#pragma unroll
                for (int m = 0; m < 4; ++m)
#pragma unroll
                    for (int n = 0; n < 2; ++n) acc[a][b][m][n] = (f32x4){0.f, 0.f, 0.f, 0.f};
        cur = nxt; cA = nA; cB = nB; ++ui;
        if constexpr (ALIGN_EPI) { if (wr == 1) PG8_BAR; }
    }
    PG8_WAIT_V(0);
    if constexpr (!ALIGN_EPI) { if (wr == 0) PG8_BAR; }
    PG8_BAR;
    if constexpr (Epi::AFTER_DRAIN) E.fused(acc, cur, wr, wc, fr, fq, lds, wid, lane);
#undef PG8_SA
#undef PG8_SB
#undef PG8_STAGE
#undef PG8_LDA
#undef PG8_LDB
#undef PG8_MMA
#undef PG8_WAIT_V
#undef PG8_WAIT_L
#undef PG8_BAR
#undef PG8_SCHED
}
}

#define XB_TMO      128
#define XB_XCNT(j)  (256  + 64 * (j))
#define XB_XSUB(j)  (1280 + 64 * (j))
#define XB_XGEN(j)  (2304 + 64 * (j))
#define XB_TOP      3328
#define XB_TOPGEN   3392
#define XCD_BAR_WORDS 3456
#define XB_SPIN_CAP (1u << 18)
__device__ __forceinline__ unsigned xb_ld(unsigned* p)              { return __hip_atomic_load(p, __ATOMIC_RELAXED, __HIP_MEMORY_SCOPE_AGENT); }
__device__ __forceinline__ unsigned xb_add(unsigned* p, unsigned v) { return __hip_atomic_fetch_add(p, v, __ATOMIC_RELAXED, __HIP_MEMORY_SCOPE_AGENT); }
__device__ __forceinline__ unsigned xb_xcc_id() { return (unsigned)__builtin_amdgcn_s_getreg((3 << 11) | 20) & 0xFu; }
#define XB_SPIN(cond, bar) do { unsigned _sp = 0; while (cond) { __builtin_amdgcn_s_sleep(1); \
    if ((++_sp & 255u) == 0u) { if (xb_ld(&(bar)[XB_TMO])) break; if (_sp > XB_SPIN_CAP) { atomicAdd(&(bar)[XB_TMO], 1u); break; } } } } while (0)
struct XcdBarrier { unsigned* bar; unsigned x; volatile LAS unsigned* st; };
__device__ __forceinline__ XcdBarrier xcd_barrier_post(unsigned* bar, volatile LAS unsigned* st) {
    XcdBarrier b; b.bar = bar; b.x = xb_xcc_id(); b.st = st;
    if (threadIdx.x == 0) (void)xb_add(&bar[XB_XCNT(b.x)], 1u);
    return b;
}
__device__ __forceinline__ void xcd_barrier_complete(unsigned* bar, unsigned x, unsigned& nloc, unsigned& nx) {
    const unsigned G = gridDim.x * gridDim.y * gridDim.z;
    unsigned sum, cnt, mine, sp = 0u;
    for (;;) {
        sum = 0u; cnt = 0u; mine = 0u;
#pragma unroll
        for (unsigned j = 0; j < 16; ++j) { const unsigned c = xb_ld(&bar[XB_XCNT(j)]); sum += c; cnt += (c > 0u) ? 1u : 0u; mine = (j == x) ? c : mine; }
        if (sum == G) break;
        __builtin_amdgcn_s_sleep(1);
        if ((++sp & 255u) == 0u) { if (xb_ld(&bar[XB_TMO])) break; if (sp > XB_SPIN_CAP) { atomicAdd(&bar[XB_TMO], 1u); break; } }
    }
    nloc = mine > 0u ? mine : 1u; nx = cnt > 0u ? cnt : 1u;
}
__device__ __forceinline__ void xcd_barrier(const XcdBarrier& b, int wave_id) {
    asm volatile("s_waitcnt vmcnt(0)" ::: "memory");
    __syncthreads();
    if (wave_id == 0 && lane_id_fresh() == 0) {
        unsigned* bar = b.bar;
        __builtin_amdgcn_s_waitcnt(0);
        unsigned nloc = b.st[0], nx = b.st[1];
        if (nloc == 0u) { xcd_barrier_complete(bar, b.x, nloc, nx); b.st[0] = nloc; b.st[1] = nx; }
        const unsigned old = xb_add(&bar[XB_XSUB(b.x)], 1u);
        const unsigned gen = old / nloc;
        if (old + 1u == (gen + 1u) * nloc) {
            __builtin_amdgcn_fence(__ATOMIC_RELEASE, "agent");
            asm volatile("s_waitcnt vmcnt(0)" ::: "memory");
            const unsigned og = xb_add(&bar[XB_TOP], 1u);
            const unsigned tg = og / nx;
            if (og + 1u == (tg + 1u) * nx) xb_add(&bar[XB_TOPGEN], 1u);
            else XB_SPIN(xb_ld(&bar[XB_TOPGEN]) == tg, bar);
            __builtin_amdgcn_fence(__ATOMIC_ACQUIRE, "agent");
            xb_add(&bar[XB_XGEN(b.x)], 1u);
            asm volatile("s_waitcnt vmcnt(0)" ::: "memory");
        } else {
            XB_SPIN(xb_ld(&bar[XB_XGEN(b.x)]) == gen, bar);
            __builtin_amdgcn_fence(__ATOMIC_ACQUIRE, "agent");
            asm volatile("s_waitcnt vmcnt(0)" ::: "memory");
        }
    }
    __syncthreads();
}

struct Args { const float* in[N_IN]; float* out; unsigned char* ws; int ph_lo, ph_hi; };
static_assert(sizeof(Args) == N_IN * 8 + 8 + 8 + 8, "Args has no padding");

struct Ctx {
    const float* const* in; float* out; unsigned char* ws;
    LAS unsigned char* lds;
    int tid, lane, wave, gw, ngw, bid, G;
};
#define WSP(T, off) ((T*)(C.ws + (off)))
__device__ __forceinline__ Ctx ctx_fresh(const Ctx& C0) {
    Ctx C = C0; C.lane = lane_id_fresh(); C.tid = C.wave * 64 + C.lane;
    int bid = blockIdx.x, G = gridDim.x; asm volatile("" : "+s"(bid), "+s"(G));
    C.bid = bid; C.G = G; C.gw = bid * 8 + C.wave; C.ngw = G * 8;
    return C;
}

__device__ __forceinline__ int wq_next(unsigned* ctr, int lane) {
    unsigned v = 0;
    if (lane == 0) v = __hip_atomic_fetch_add(ctr, 1u, __ATOMIC_RELAXED, __HIP_MEMORY_SCOPE_AGENT);
    return (int)__builtin_amdgcn_readfirstlane(v);
}

__device__ __forceinline__ void transpose_item(const float* W, int ldw, f16* WT, int ldt, int dst_row0, int k0, int n0, LAS float* scr, int lane) {
    f32x4 wv[8];
#pragma unroll
    for (int i = 0; i < 8; ++i) wv[i] = __builtin_nontemporal_load((const f32x4*)(W + (size_t)(k0 + 8 * i + (lane >> 3)) * ldw + n0 + 4 * (lane & 7)));
#pragma unroll
    for (int i = 0; i < 8; ++i) { LAS float* d = scr + (8 * i + (lane >> 3)) * 33 + 4 * (lane & 7); d[0] = wv[i][0]; d[1] = wv[i][1]; d[2] = wv[i][2]; d[3] = wv[i][3]; }
    asm volatile("s_waitcnt lgkmcnt(0)" ::: "memory");
    const int c = lane & 7;
#pragma unroll
    for (int j = 0; j < 4; ++j) { const int n = (lane >> 3) + 8 * j; const LAS float* s = scr + (8 * c) * 33 + n;
        const f16x8 o = pack8(cvt4(s[0 * 33], s[1 * 33], s[2 * 33], s[3 * 33]), cvt4(s[4 * 33], s[5 * 33], s[6 * 33], s[7 * 33]));
        *(f16x8*)(WT + (size_t)(dst_row0 + n) * ldt + k0 + 8 * c) = o; }
    asm volatile("s_waitcnt lgkmcnt(0)" ::: "memory");
}
__device__ __forceinline__ void phase_prep(const Ctx& C0) {
    const Ctx C = ctx_fresh(C0);
    {
        LAS float* sc = (LAS float*)C.lds;
        LAS float* red = (LAS float*)(C.lds + 20480);
        const float* cv = C.in[I_C]; const float* cctx = C.in[I_CCTX];
        for (int i = C.tid; i < 5 * 1024; i += 512) { const int c = i >> 10, k = i & 1023; const float v = (c < 4) ? cv[c * 1024 + k] : cctx[k]; sc[i] = v / (1.0f + __expf(-v)); }
        __syncthreads();
        float* mod = WSP(float, WS_MOD);
        for (int item = C.bid; item < 2 * 144; item += C.G) {
            const int l = item / 144, j0 = (item % 144) * 64, k0 = C.wave * 128;
            const float* wp = C.in[I_WADA] + ((size_t)l * 1024 + k0) * NMODV + j0 + C.lane;
            float a0 = 0.f, a1 = 0.f, a2 = 0.f, a3 = 0.f, a4 = 0.f;
#pragma unroll 16
            for (int kk = 0; kk < 128; ++kk) {
                const float w = __builtin_nontemporal_load(&wp[(size_t)kk * NMODV]);
                a0 += sc[0 * 1024 + k0 + kk] * w; a1 += sc[1 * 1024 + k0 + kk] * w; a2 += sc[2 * 1024 + k0 + kk] * w; a3 += sc[3 * 1024 + k0 + kk] * w; a4 += sc[4 * 1024 + k0 + kk] * w;
            }
            red[(C.wave * 5 + 0) * 64 + C.lane] = a0; red[(C.wave * 5 + 1) * 64 + C.lane] = a1; red[(C.wave * 5 + 2) * 64 + C.lane] = a2;
            red[(C.wave * 5 + 3) * 64 + C.lane] = a3; red[(C.wave * 5 + 4) * 64 + C.lane] = a4;
            __syncthreads();
            if (C.tid < 320) { const int c = C.tid >> 6, ln = C.tid & 63; float s = 0.f;
#pragma unroll
                for (int w = 0; w < 8; ++w) s += red[(w * 5 + c) * 64 + ln];
                mod[((size_t)l * 5 + c) * NMODV + j0 + ln] = s + C.in[I_BADA][(size_t)l * NMODV + j0 + ln]; }
            __syncthreads();
        }
    }
    __syncthreads();
    {
        LAS float* scr = (LAS float*)(C.lds + C.wave * 16384);
        constexpr int IFI = 16 * 176, IFO = 44 * 32, IIN = 16 * 67, IOUT = 16 * 32;
        constexpr int NIT = 4 * IFI + 4 * IFO + 2 * IIN + 2 * IOUT;
        for (int it = C.gw; it < NIT; it += C.ngw) {
            int r = it;
            if (r < 4 * IFI) { const int mat = r / IFI, rr = r % IFI, kb = rr / 176, n0 = (rr % 176) * 32;
                const int drow = (n0 < DFF) ? ((n0 >> 7) * 256 + (n0 & 127)) : (((n0 - DFF) >> 7) * 256 + 128 + ((n0 - DFF) & 127));
                transpose_item(C.in[I_WFI] + (size_t)mat * 1024 * NFF2, NFF2, WSP(f16, WS_WFI) + (size_t)mat * NFF2 * 1024, 1024, drow, kb * 64, n0, scr, C.lane); continue; }
            r -= 4 * IFI;
            if (r < 4 * IFO) { const int mat = r / IFO, rr = r % IFO, kb = rr / 32, n0 = (rr % 32) * 32;
                transpose_item(C.in[I_WFO] + (size_t)mat * DFF * 1024, 1024, WSP(f16, WS_WFO) + (size_t)mat * 1024 * DFF, DFF, n0, kb * 64, n0, scr, C.lane); continue; }
            r -= 4 * IFO;
            if (r < 2 * IIN) { const int l = r / IIN, rr = r % IIN, kb = rr / 67, n0 = (rr % 67) * 32;
                transpose_item(C.in[I_WIN] + (size_t)l * 1024 * DIN, DIN, WSP(f16, WS_WIN) + (size_t)l * DINP * 1024, 1024, n0, kb * 64, n0, scr, C.lane); continue; }
            r -= 2 * IIN;
            { const int l = r / IOUT, rr = r % IOUT, kb = rr / 32, n0 = (rr % 32) * 32;
                transpose_item(C.in[I_WOUT] + (size_t)l * 1024 * 1024, 1024, WSP(f16, WS_WOUT) + (size_t)l * 1024 * 1024, 1024, n0, kb * 64, n0, scr, C.lane); }
        }
    }
    {
        const int gt = C.bid * 512 + C.tid, ngt = C.G * 512;
        for (int i = gt; i < 2 * 160 * 128; i += ngt) { const int l = i / (160 * 128), rr = i % (160 * 128);
            unsigned z = 0u; asm volatile("" : "+v"(z));
            *(u32x4*)(WSP(f16, WS_WIN) + ((size_t)l * DINP + DIN) * 1024 + (size_t)rr * 8) = (u32x4){z, z, z, z}; }
        f16* wuq = WSP(f16, WS_WUQ);
        for (int i = gt; i < 2 * 384 * 192; i += ngt) { const int e = i & 7, r = (i >> 3) & 31, rest = i >> 8, c = rest % 24, rest2 = rest / 24, t3 = rest2 % 3, lh = rest2 / 3, l = lh >> 2, hd = lh & 3;
            wuq[i] = (f16)(C.in[I_CQN][l * 192 + 8 * c + e] * C.in[I_WUQ][(size_t)l * 192 * 384 + (size_t)(8 * c + e) * 384 + hd * 96 + 32 * t3 + r]); }
        f16* wukv = WSP(f16, WS_WUKV);
        for (int i = gt; i < 2 * 512 * 128; i += ngt) { const int e = i & 7, r = (i >> 3) & 31, rest = i >> 8, c = rest & 15, rest2 = rest >> 4, t4 = rest2 & 3, lh = rest2 >> 2, l = lh >> 2, hd = lh & 3;
            const float w = C.in[I_WUKV][(size_t)l * 128 * 512 + (size_t)(8 * c + e) * 512 + hd * 128 + 32 * t4 + r];
            wukv[i] = (f16)(C.in[I_CKVN][l * 128 + 8 * c + e] * w); WSP(f16, WS_WUKV0)[i] = (f16)w; }
        for (int i = gt; i < 4096; i += ngt) WSP(f16, WS_IDN)[i] = ((i >> 6) == (i & 63)) ? (f16)1.0f : (f16)0.0f;
        f16* wg = WSP(f16, WS_WG);
        for (int i = gt; i < 64 * 4096; i += ngt) { const int m = i >> 12, d = (i >> 6) & 63, c = i & 63; wg[i] = (f16)C.in[I_WGATE][(size_t)m * 4096 + c * 64 + d]; }
    }
}

template <bool FIRST>
__device__ __forceinline__ void phase_norm(const Ctx& C0, int l, int sub) {
    const Ctx C = ctx_fresh(C0);
    const float* gvec = C.in[I_NG] + ((size_t)l * 3 + sub) * DM;
    const float* modl = WSP(float, WS_MOD) + (size_t)l * 5 * NMODV;
    f16* H = WSP(f16, WS_H);
    for (int row = C.gw; row < M; row += C.ngw) {
        const float* src = FIRST ? ((row < MP) ? C.in[I_XP] + (size_t)row * DM : C.in[I_XS] + (size_t)(row - MP) * DM) : C.out + (size_t)row * DM;
        const int cond = (row < MP) ? 4 : ((row - MP) >> 11);
        const float* shp = modl + (size_t)cond * NMODV + (3 * sub) * DM; const float* scp = shp + DM;
        f32x4 v[4]; float ss = 0.f;
#pragma unroll
        for (int j = 0; j < 4; ++j) { v[j] = FIRST ? __builtin_nontemporal_load((const f32x4*)(src + 256 * j + 4 * C.lane)) : *(const f32x4*)(src + 256 * j + 4 * C.lane); ss += (v[j].x * v[j].x + v[j].y * v[j].y) + (v[j].z * v[j].z + v[j].w * v[j].w); }
        const float rstd = 1.0f / sqrtf(wave_sum(ss) * (1.0f / DM) + EPS);
        f32x4 gs[4], shv[4];
#pragma unroll
        for (int j = 0; j < 4; ++j) { const int k = 256 * j + 4 * C.lane; gs[j] = *(const f32x4*)(gvec + k) * (*(const f32x4*)(scp + k) + 1.0f); shv[j] = *(const f32x4*)(shp + k); }
#pragma unroll
        for (int j = 0; j < 4; ++j) {
            const int k = 256 * j + 4 * C.lane;
            *(f16x4*)(H + (size_t)row * DM + k) = cvt4v(v[j] * rstd * gs[j] + shv[j]);
            if (FIRST) *(f16x4*)(WSP(f16, WS_XH) + (size_t)row * DM + k) = cvt4v(v[j]);
        }
    }
}

__device__ __forceinline__ void glds16(const void* gsrc, unsigned lds_dst) { unsigned keep;
    asm volatile("s_mov_b32 %0, m0\n\ts_mov_b32 m0, %2\n\ts_nop 0\n\tglobal_load_lds_dwordx4 %1, off\n\ts_mov_b32 m0, %0" : "=&s"(keep) : "v"(gsrc), "s"(lds_dst) : "memory"); }
#define ATT_GLDS(g, l) glds16((const void*)(g), (unsigned)__builtin_amdgcn_readfirstlane((unsigned)(uintptr_t)(l)))
#define ATT_WAITBAR(N) asm volatile("s_waitcnt vmcnt(" #N ") lgkmcnt(0)\n\ts_barrier" ::: "memory")
#define ATT_LBAR() asm volatile("s_waitcnt lgkmcnt(0)\n\ts_barrier" ::: "memory")
struct MxTok { int b, t, key, ktile, kin; size_t row, ob; };
template <int KIND>
__device__ __forceinline__ MxTok mx_decode(int wt, int tok, int l) {
    MxTok m; m.row = 0;
    if (KIND == 0) { m.row = (size_t)wt * 32 + tok; m.b = (int)(m.row >> 8); m.t = (int)(m.row & 255); m.key = m.t; }
    else if (KIND == 1) { m.row = (size_t)wt * 32 + tok; const int rs = (int)m.row - MP; m.b = rs >> 11; m.t = rs & 2047; m.key = PAST + m.t; }
    else { const int idx = (wt - 512) * 32 + tok; m.b = idx >> 9; m.t = idx & 511; m.key = m.t; }
    m.ktile = m.key >> 6; m.kin = m.key & 63; m.ob = ((size_t)m.b * 2 + l) * TP + m.t;
    return m;
}
template <int KIND>
__device__ __forceinline__ void mx_rope(int t, int hi, float (&cr)[4], float (&sr)[4], float (&cc)[4], float (&scn)[4]) {
#pragma unroll
    for (int e = 0; e < 4; ++e) { cr[e] = 1.f; sr[e] = 0.f; cc[e] = 1.f; scn[e] = 0.f; }
    if (KIND == 1) {
        const float gr = (float)(t >> 6), gc = (float)(t & 63);
#pragma unroll
        for (int e = 0; e < 4; ++e) { const float inv = exp2f(-(float)(4 * hi + e) * (13.287712379549449f / 8.0f));
            const float fr = gr * inv * 0.15915494309189535f, fc = gc * inv * 0.15915494309189535f;
            sr[e] = __builtin_amdgcn_sinf(fr); cr[e] = __builtin_amdgcn_cosf(fr); scn[e] = __builtin_amdgcn_sinf(fc); cc[e] = __builtin_amdgcn_cosf(fc); }
    }
}
template <int KIND, int SUB>
__device__ __forceinline__ void mx_a(const Ctx& C, int l, int wt) {
    const int lane = lane_id_fresh(), tok = lane & 31, hi = lane >> 5;
    constexpr int Tk = (KIND == 0) ? TP : TKS, NT = Tk / 64;
    const MxTok m = mx_decode<KIND>(wt, tok, l);
    const f16* prow = WSP(f16, WS_ACT) + m.row * DINP;
    f16* KA = (KIND == 0) ? WSP(f16, WS_KAP) : WSP(f16, WS_KAS);
    f16* VA = (KIND == 0) ? WSP(f16, WS_VATP) : WSP(f16, WS_VATS);
    if (SUB < 2) {
        if (KIND != 2) {
            constexpr int qk = SUB;
            float cr[4], sr[4], cc[4], scn[4];
            mx_rope<KIND>(m.t, hi, cr, sr, cc, scn);
            f32x4 gain[4];
#pragma unroll
            for (int g = 0; g < 4; ++g) gain[g] = *(const f32x4*)(C.in[I_DQKN] + ((size_t)l * 2 + qk) * 32 + 8 * g + 4 * hi);
            f16x4 raw[8][4];
#pragma unroll
            for (int hc = 0; hc < 8; ++hc)
#pragma unroll
                for (int g = 0; g < 4; ++g) raw[hc][g] = *(const f16x4*)(prow + (qk ? PC_KA : PC_QA) + hc * 32 + 4 * hi + 8 * g);
#pragma unroll
            for (int hc = 0; hc < 8; ++hc) {
                f32x4 x[4]; float ss = 0.f;
#pragma unroll
                for (int g = 0; g < 4; ++g) { x[g] = tof32(raw[hc][g]); ss += (x[g].x * x[g].x + x[g].y * x[g].y) + (x[g].z * x[g].z + x[g].w * x[g].w); }
                ss += __shfl_xor(ss, 32);
                const float rstd = 1.0f / sqrtf(ss * (1.0f / 32.0f) + EPS);
#pragma unroll
                for (int g = 0; g < 4; ++g) x[g] = x[g] * rstd * gain[g];
                if (qk == 1 && KIND == 0) {
                    float* o = C.out + OUT_DK + m.ob * 256 + hc * 32 + 4 * hi;
#pragma unroll
                    for (int g = 0; g < 4; ++g) *(f32x4*)(o + 8 * g) = x[g];
                }
                if (KIND == 1) {
#pragma unroll
                    for (int e = 0; e < 4; ++e) {
                        const float a1 = x[0][e], a2 = x[2][e]; x[0][e] = a1 * cr[e] - a2 * sr[e]; x[2][e] = a2 * cr[e] + a1 * sr[e];
                        const float b1 = x[1][e], b2 = x[3][e]; x[1][e] = b1 * cc[e] - b2 * scn[e]; x[3][e] = b2 * cc[e] + b1 * scn[e];
                    }
                }
                if (qk == 0) {
                    const float sc = 0.17677669529663687f * LOG2E;
                    f16* o = WSP(f16, WS_QA) + m.row * 256 + hc * 32 + 4 * hi;
#pragma unroll
                    for (int g = 0; g < 4; ++g) *(f16x4*)(o + 8 * g) = cvt4v(x[g] * sc);
                } else {
                    f16* o = KA + ((((size_t)m.b * 4 + (hc >> 1)) * NT + m.ktile) * 8 + (hc & 1) * 4) * 512 + m.kin * 8 + 4 * hi;
#pragma unroll
                    for (int g = 0; g < 4; ++g) *(f16x4*)(o + g * 512) = cvt4v(x[g]);
                }
            }
        } else if (SUB == 1) {
            const float* ck = C.in[I_CDK] + (((size_t)m.b * 2 + l) * PAST + m.t) * 256;
            f32x4 raw[8][4];
#pragma unroll
            for (int hc = 0; hc < 8; ++hc)
#pragma unroll
                for (int g = 0; g < 4; ++g) raw[hc][g] = *(const f32x4*)(ck + hc * 32 + 4 * hi + 8 * g);
#pragma unroll
            for (int hc = 0; hc < 8; ++hc) {
                f16* o = KA + ((((size_t)m.b * 4 + (hc >> 1)) * NT + m.ktile) * 8 + (hc & 1) * 4) * 512 + m.kin * 8 + 4 * hi;
#pragma unroll
                for (int g = 0; g < 4; ++g) *(f16x4*)(o + g * 512) = cvt4v(raw[hc][g]);
            }
        }
    } else {
        if (KIND != 2) {
            f16x8 rawv[4][4];
#pragma unroll
            for (int hd = 0; hd < 4; ++hd)
#pragma unroll
                for (int j = 0; j < 4; ++j) rawv[hd][j] = *(const f16x8*)(prow + PC_VA + hd * 64 + 32 * hi + 8 * j);
#pragma unroll
            for (int hd = 0; hd < 4; ++hd) {
                f16* vt = VA + ((((size_t)m.b * 4 + hd) * NT + m.ktile) * 2 + hi) * 2048 + m.kin * 32;
#pragma unroll
                for (int j = 0; j < 4; ++j) {
                    const f16x8 v = rawv[hd][j];
                    if (KIND == 0) {
                        float* o = C.out + OUT_DV + m.ob * 256 + hd * 64 + 32 * hi + 8 * j;
                        *(f32x4*)o = (f32x4){(float)v[0], (float)v[1], (float)v[2], (float)v[3]}; *(f32x4*)(o + 4) = (f32x4){(float)v[4], (float)v[5], (float)v[6], (float)v[7]};
                    }
                    *(f16x8*)(vt + 8 * j) = v;
                }
            }
        } else {
            const float* cvp = C.in[I_CDV] + (((size_t)m.b * 2 + l) * PAST + m.t) * 256;
#pragma unroll
            for (int hd = 0; hd < 4; ++hd) {
                f16* vt = VA + ((((size_t)m.b * 4 + hd) * NT + m.ktile) * 2 + hi) * 2048 + m.kin * 32;
                f32x4 rawc[8];
#pragma unroll
                for (int j = 0; j < 8; ++j) rawc[j] = *(const f32x4*)(cvp + hd * 64 + 32 * hi + 4 * j);
#pragma unroll
                for (int j = 0; j < 8; ++j) *(f16x4*)(vt + 4 * j) = cvt4v(rawc[j]);
            }
        }
    }
}
template <int KIND>
__device__ __forceinline__ void mx_q(const Ctx& C, int l, int wt, int hd, LAS unsigned char* wl) {
    const int lane = lane_id_fresh(), tok = lane & 31, hi = lane >> 5;
    const MxTok m = mx_decode<KIND>(wt, tok, l);
    const f16* prow = WSP(f16, WS_ACT) + m.row * DINP;
    float cr[4], sr[4], cc[4], scn[4];
    mx_rope<KIND>(m.t, hi, cr, sr, cc, scn);
    f16x8 bq[12]; float ss = 0.f;
#pragma unroll
    for (int ks = 0; ks < 12; ++ks) { bq[ks] = *(const f16x8*)(prow + PC_CQ + 16 * ks + 8 * hi);
#pragma unroll
        for (int e = 0; e < 8; ++e) { const float f = (float)bq[ks][e]; ss += f * f; } }
    ss += __shfl_xor(ss, 32);
    const float rstd = 1.0f / sqrtf(ss * (1.0f / 192.0f) + EPS);
    const float* gq = C.in[I_QKN] + ((size_t)l * 2 + 0) * 96;
    f32x4 gqv[3][4];
#pragma unroll
    for (int t3 = 0; t3 < 3; ++t3)
#pragma unroll
        for (int g = 0; g < 4; ++g) gqv[t3][g] = *(const f32x4*)(gq + 32 * t3 + 8 * g + 4 * hi);
    ATT_WAITBAR(0);
    LAS unsigned char* wp = wl + hi * 512 + tok * 16;
    f32x16 acc[3];
#pragma unroll
    for (int t3 = 0; t3 < 3; ++t3) { acc[t3] = (f32x16){};
#pragma unroll
        for (int ks = 0; ks < 12; ++ks) acc[t3] = MFMA32(*(const LAS f16x8*)(wp + (t3 * 24 + 2 * ks) * 512), bq[ks], acc[t3]); }
    float s2 = 0.f;
#pragma unroll
    for (int t3 = 0; t3 < 3; ++t3)
#pragma unroll
        for (int r = 0; r < 16; ++r) s2 += acc[t3][r] * acc[t3][r];
    s2 += __shfl_xor(s2, 32);
    const float rs = rstd / sqrtf(s2 * (rstd * rstd) * (1.0f / 96.0f) + EPS);
#pragma unroll
    for (int t3 = 0; t3 < 3; ++t3)
#pragma unroll
        for (int g = 0; g < 4; ++g) { const f32x4 gg = gqv[t3][g];
#pragma unroll
            for (int e = 0; e < 4; ++e) acc[t3][4 * g + e] *= rs * gg[e]; }
    if (KIND == 1) {
#pragma unroll
        for (int e = 0; e < 4; ++e) {
            const float a1 = acc[2][e], a2 = acc[2][8 + e]; acc[2][e] = a1 * cr[e] - a2 * sr[e]; acc[2][8 + e] = a2 * cr[e] + a1 * sr[e];
            const float b1 = acc[2][4 + e], b2 = acc[2][12 + e]; acc[2][4 + e] = b1 * cc[e] - b2 * scn[e]; acc[2][12 + e] = b2 * cc[e] + b1 * scn[e];
        }
    }
    const float sc = 0.10206207261596575f * LOG2E;
    f16* o = WSP(f16, WS_QC) + m.row * 384 + hd * 96 + 4 * hi;
#pragma unroll
    for (int t3 = 0; t3 < 3; ++t3)
#pragma unroll
        for (int g = 0; g < 4; ++g) *(f16x4*)(o + 32 * t3 + 8 * g) = cvt4(acc[t3][4 * g] * sc, acc[t3][4 * g + 1] * sc, acc[t3][4 * g + 2] * sc, acc[t3][4 * g + 3] * sc);
}
template <int KIND>
__device__ __forceinline__ void mx_kv(const Ctx& C, int l, int wt, int hd, LAS unsigned char* wl) {
    const int lane = lane_id_fresh(), tok = lane & 31, hi = lane >> 5;
    constexpr int Tk = (KIND == 0) ? TP : TKS, NT = Tk / 64;
    const MxTok m = mx_decode<KIND>(wt, tok, l);
    const f16* prow = WSP(f16, WS_ACT) + m.row * DINP;
    f16* KC = (KIND == 0) ? WSP(f16, WS_KCP) : WSP(f16, WS_KCS);
    f16* VC = (KIND == 0) ? WSP(f16, WS_VCTP) : WSP(f16, WS_VCTS);
    float cr[4], sr[4], cc[4], scn[4];
    mx_rope<KIND>(m.t, hi, cr, sr, cc, scn);
    f16x8 bk[8]; f32x4 kr[4]; float rstd = 1.0f;
    if (KIND != 2) {
        float ss = 0.f;
#pragma unroll
        for (int ks = 0; ks < 8; ++ks) { bk[ks] = *(const f16x8*)(prow + PC_CKV + 16 * ks + 8 * hi);
#pragma unroll
            for (int e = 0; e < 8; ++e) { const float f = (float)bk[ks][e]; ss += f * f; } }
        ss += __shfl_xor(ss, 32);
        rstd = 1.0f / sqrtf(ss * (1.0f / 128.0f) + EPS);
        if (KIND == 0 && hd == 0) {
            f32x4 gv0[8], gv1[8];
#pragma unroll
            for (int ks = 0; ks < 8; ++ks) { gv0[ks] = *(const f32x4*)(C.in[I_CKVN] + (size_t)l * 128 + 16 * ks + 8 * hi); gv1[ks] = *(const f32x4*)(C.in[I_CKVN] + (size_t)l * 128 + 16 * ks + 8 * hi + 4); }
#pragma unroll
            for (int ks = 0; ks < 8; ++ks) {
                const f32x4 g0 = gv0[ks], g1 = gv1[ks];
                const f16x8 v = bk[ks];
                float* o = C.out + OUT_CKV + m.ob * 128 + 16 * ks + 8 * hi;
                *(f32x4*)o = (f32x4){(float)v[0] * rstd * g0[0], (float)v[1] * rstd * g0[1], (float)v[2] * rstd * g0[2], (float)v[3] * rstd * g0[3]};
                *(f32x4*)(o + 4) = (f32x4){(float)v[4] * rstd * g1[0], (float)v[5] * rstd * g1[1], (float)v[6] * rstd * g1[2], (float)v[7] * rstd * g1[3]};
            }
        }
#pragma unroll
        for (int g = 0; g < 4; ++g) kr[g] = tof32(*(const f16x4*)(prow + PC_KR + 8 * g + 4 * hi));
        if (KIND == 0 && hd == 0) { float* o = C.out + OUT_KR + m.ob * 32 + 4 * hi;
#pragma unroll
            for (int g = 0; g < 4; ++g) *(f32x4*)(o + 8 * g) = kr[g]; }
    } else {
        const float* cp = C.in[I_CCKV] + (((size_t)m.b * 2 + l) * PAST + m.t) * 128;
#pragma unroll
        for (int ks = 0; ks < 8; ++ks) bk[ks] = pack8(cvt4v(*(const f32x4*)(cp + 16 * ks + 8 * hi)), cvt4v(*(const f32x4*)(cp + 16 * ks + 8 * hi + 4)));
        const float* kp = C.in[I_CKR] + (((size_t)m.b * 2 + l) * PAST + m.t) * 32;
#pragma unroll
        for (int g = 0; g < 4; ++g) kr[g] = *(const f32x4*)(kp + 8 * g + 4 * hi);
    }
    float skr = 0.f;
#pragma unroll
    for (int g = 0; g < 4; ++g) skr += (kr[g].x * kr[g].x + kr[g].y * kr[g].y) + (kr[g].z * kr[g].z + kr[g].w * kr[g].w);
    const float* gk = C.in[I_QKN] + ((size_t)l * 2 + 1) * 96;
    f32x4 gkv[3][4];
#pragma unroll
    for (int t3 = 0; t3 < 3; ++t3)
#pragma unroll
        for (int g = 0; g < 4; ++g) gkv[t3][g] = *(const f32x4*)(gk + 32 * t3 + 8 * g + 4 * hi);
    ATT_WAITBAR(0);
    LAS unsigned char* wp = wl + hi * 512 + tok * 16;
    f32x16 acc[2];
#pragma unroll
    for (int t4 = 0; t4 < 2; ++t4) { acc[t4] = (f32x16){};
#pragma unroll
        for (int ks = 0; ks < 8; ++ks) acc[t4] = MFMA32(*(const LAS f16x8*)(wp + (t4 * 16 + 2 * ks) * 512), bk[ks], acc[t4]); }
    float s2 = 0.f;
#pragma unroll
    for (int t4 = 0; t4 < 2; ++t4)
#pragma unroll
        for (int r = 0; r < 16; ++r) s2 += acc[t4][r] * acc[t4][r];
    s2 = s2 * (rstd * rstd) + skr;
    s2 += __shfl_xor(s2, 32);
    const float rs = 1.0f / sqrtf(s2 * (1.0f / 96.0f) + EPS), rsn = rs * rstd;
    f16* ko = KC + ((((size_t)m.b * 4 + hd) * NT + m.ktile) * 12) * 512 + m.kin * 8 + 4 * hi;
#pragma unroll
    for (int t4 = 0; t4 < 2; ++t4)
#pragma unroll
        for (int g = 0; g < 4; ++g) { const f32x4 gg = gkv[t4][g];
            *(f16x4*)(ko + (4 * t4 + g) * 512) = cvt4(acc[t4][4 * g] * rsn * gg[0], acc[t4][4 * g + 1] * rsn * gg[1], acc[t4][4 * g + 2] * rsn * gg[2], acc[t4][4 * g + 3] * rsn * gg[3]); }
    f32x4 kn[4];
#pragma unroll
    for (int g = 0; g < 4; ++g) kn[g] = kr[g] * rs * gkv[2][g];
    if (KIND == 1) {
#pragma unroll
        for (int e = 0; e < 4; ++e) {
            const float a1 = kn[0][e], a2 = kn[2][e]; kn[0][e] = a1 * cr[e] - a2 * sr[e]; kn[2][e] = a2 * cr[e] + a1 * sr[e];
            const float b1 = kn[1][e], b2 = kn[3][e]; kn[1][e] = b1 * cc[e] - b2 * scn[e]; kn[3][e] = b2 * cc[e] + b1 * scn[e];
        }
    }
#pragma unroll
    for (int g = 0; g < 4; ++g) *(f16x4*)(ko + (8 + g) * 512) = cvt4v(kn[g]);
    f16* vo = VC + ((((size_t)m.b * 4 + hd) * NT + m.ktile) * 2) * 2048 + m.kin * 32 + 4 * hi;
#pragma unroll
    for (int t4 = 2; t4 < 4; ++t4) {
        f32x16 av = (f32x16){};
#pragma unroll
        for (int ks = 0; ks < 8; ++ks) av = MFMA32(*(const LAS f16x8*)(wp + (t4 * 16 + 2 * ks) * 512), bk[ks], av);
#pragma unroll
        for (int g = 0; g < 4; ++g) *(f16x4*)(vo + (t4 - 2) * 2048 + 8 * g) = cvt4(av[4 * g] * rstd, av[4 * g + 1] * rstd, av[4 * g + 2] * rstd, av[4 * g + 3] * rstd);
    }
}

template <int DIR, bool PASS2>
__device__ __forceinline__ void lru_dir(const Ctx& C, int l, int ch, int n, const f16x8 (&bx)[2][4], int b, int T, int cidx, int seqch0, bool prompt, int row0, int lane) {
    const int l31 = lane & 31, hi = lane >> 5;
    const f16* wg = WSP(f16, WS_WG);
    const f16* PROJ = WSP(f16, WS_ACT);
    float* SUM = WSP(float, WS_SUM);
    f16* OC = WSP(f16, WS_OCAT);
    const int nch = T >> 6;
    float bg0[2], bg1[2], spl[2], hc[2], At[2], Bt[2];
#pragma unroll
    for (int t2 = 0; t2 < 2; ++t2) {
        const int chn = 64 * n + 32 * t2 + l31;
        bg0[t2] = C.in[I_BGATE][((size_t)(l * 2 + DIR) * 2 + 0) * 512 + chn]; bg1[t2] = C.in[I_BGATE][((size_t)(l * 2 + DIR) * 2 + 1) * 512 + chn];
        spl[t2] = -8.0f * LOG2E * log1pf(__expf(-C.in[I_LLAM][(size_t)(l * 2 + DIR) * 512 + chn]));
        At[t2] = 1.0f; Bt[t2] = 0.0f; hc[t2] = 0.0f;
    }
    if (PASS2) {
        const int cnt = (DIR == 0) ? cidx : (nch - 1 - cidx), m = (cnt + 1) >> 1;
        const int lo = hi ? m : 0, up = hi ? cnt : m;
        float A0 = 1.f, B0 = 0.f, A1 = 1.f, B1 = 0.f;
#pragma unroll 1
        for (int ib = lo; ib < up; ib += 8) {
            float a0[8], b0[8], a1[8], b1[8];
#pragma unroll
            for (int k = 0; k < 8; ++k) {
                const int i = (ib + k < up) ? ib + k : up - 1, j = (DIR == 0) ? i : (nch - 1 - i);
                const float* p = SUM + ((((size_t)(seqch0 + j)) * 8 + n) * 2 + DIR) * 128 + l31;
                a0[k] = p[0]; b0[k] = p[64]; a1[k] = p[32]; b1[k] = p[96];
            }
#pragma unroll
            for (int k = 0; k < 8; ++k) if (ib + k < up) { B0 = a0[k] * B0 + b0[k]; A0 *= a0[k]; B1 = a1[k] * B1 + b1[k]; A1 *= a1[k]; }
        }
        {
            const float pa0 = __shfl_xor(A0, 32), pb0 = __shfl_xor(B0, 32), pa1 = __shfl_xor(A1, 32), pb1 = __shfl_xor(B1, 32);
            const float fa0 = hi ? pa0 : A0, fb0 = hi ? pb0 : B0, sa0 = hi ? A0 : pa0, sb0 = hi ? B0 : pb0;
            const float fa1 = hi ? pa1 : A1, fb1 = hi ? pb1 : B1, sa1 = hi ? A1 : pa1, sb1 = hi ? B1 : pb1;
            float h00 = 0.f, h01 = 0.f;
            if (!prompt) { const float* st = C.in[I_ST] + (((size_t)b * 2 + l) * 2 + DIR) * 512 + 64 * n + l31; h00 = st[0]; h01 = st[32]; }
            hc[0] = sa0 * (fa0 * h00 + fb0) + sb0; hc[1] = sa1 * (fa1 * h01 + fb1) + sb1;
        }
    }
    const f16* idp = WSP(f16, WS_IDN);
    __builtin_amdgcn_sched_barrier(0);
#pragma unroll
    for (int t2 = 0; t2 < 2; ++t2) {
        f16x8 w0[4], w1[4], idn[4];
#pragma unroll
        for (int ks = 0; ks < 4; ++ks) {
            w0[ks] = *(const f16x8*)(wg + ((((size_t)(l * 2 + DIR) * 2 + 0) * 8 + n) * 64 + 32 * t2 + l31) * 64 + 16 * ks + 8 * hi);
            w1[ks] = *(const f16x8*)(wg + ((((size_t)(l * 2 + DIR) * 2 + 1) * 8 + n) * 64 + 32 * t2 + l31) * 64 + 16 * ks + 8 * hi);
            idn[ks] = *(const f16x8*)(idp + (32 * t2 + l31) * 64 + 16 * ks + 8 * hi);
        }
#pragma unroll
        for (int sci = 0; sci < 2; ++sci) {
            const int sc = DIR ? 1 - sci : sci;
            f32x16 g0 = (f32x16){}, g1 = (f32x16){}, X = (f32x16){};
#pragma unroll
            for (int ks = 0; ks < 4; ++ks) { g0 = MFMA32(bx[sc][ks], w0[ks], g0); g1 = MFMA32(bx[sc][ks], w1[ks], g1); X = MFMA32(bx[sc][ks], idn[ks], X); }
#pragma unroll
            for (int r = 0; r < 16; ++r) {
                const float rr = sigmoidf_(g0[r] + bg0[t2]), ii = sigmoidf_(g1[r] + bg1[t2]);
                const float a = fexp2(rr * spl[t2]);
                g0[r] = a; g1[r] = __builtin_amdgcn_sqrtf(fmaxf(1.0f - a * a, 0.f)) * (ii * X[r]);
            }
            float As[4], Bs[4], Ap[4], Bp[4];
#pragma unroll
            for (int g = 0; g < 4; ++g) {
                float pa = 1.f, pb = 0.f;
#pragma unroll
                for (int ee = 0; ee < 4; ++ee) { const int e = DIR ? 3 - ee : ee; pb = g0[4 * g + e] * pb + g1[4 * g + e]; pa *= g0[4 * g + e]; }
                As[g] = pa; Bs[g] = pb; Ap[g] = __shfl_xor(pa, 32); Bp[g] = __shfl_xor(pb, 32);
            }
            float h = hc[t2];
#pragma unroll
            for (int gi = 0; gi < 4; ++gi) {
                const int g = DIR ? 3 - gi : gi;
                const bool mine_first = DIR ? (hi == 1) : (hi == 0);
                const float fa = mine_first ? As[g] : Ap[g], fb = mine_first ? Bs[g] : Bp[g], sa = mine_first ? Ap[g] : As[g], sb = mine_first ? Bp[g] : Bs[g];
                const float mid = fa * h + fb;
                float hh = mine_first ? h : mid;
                if (PASS2) {
#pragma unroll
                    for (int ee = 0; ee < 4; ++ee) { const int e = DIR ? 3 - ee : ee; hh = g0[4 * g + e] * hh + g1[4 * g + e]; g1[4 * g + e] = hh; }
                }
                h = sa * mid + sb;
                if (!PASS2) { Bt[t2] = sa * (fa * Bt[t2] + fb) + sb; At[t2] *= fa * sa; }
            }
            hc[t2] = h;
            if (PASS2) {
                f16* op = OC + (size_t)(row0 + 32 * sc + 4 * hi) * DM + 256 + 64 * n + 32 * t2 + l31;
                if (DIR == 0) {
#pragma unroll
                    for (int r = 0; r < 16; ++r) op[(size_t)((r & 3) + 8 * (r >> 2)) * DM] = (f16)g1[r];
                } else {
                    f32x16 G = (f32x16){};
#pragma unroll
                    for (int ks = 0; ks < 4; ++ks) {
                        const f16x8 gbf = *(const f16x8*)(PROJ + (size_t)(row0 + 32 * sc + l31) * DINP + PC_GB + 64 * n + 16 * ks + 8 * hi);
                        G = MFMA32(gbf, idn[ks], G);
                    }
                    float hfv[16];
#pragma unroll
                    for (int r = 0; r < 16; ++r) hfv[r] = (float)op[(size_t)((r & 3) + 8 * (r >> 2)) * DM];
#pragma unroll
                    for (int r = 0; r < 16; ++r) {
                        f16* q = op + (size_t)((r & 3) + 8 * (r >> 2)) * DM;
                        const float hf = hfv[r];
                        const float x = G[r], u = 0.7978845608028654f * (x + 0.044715f * x * x * x);
                        const float th = 1.0f - 2.0f * frcp(1.0f + fexp2(2.0f * u * LOG2E));
                        *q = (f16)((hf + g1[r]) * (0.5f * x * (1.0f + th)));
                    }
                }
            }
            FENCE(); __builtin_amdgcn_sched_barrier(0);
        }
    }
    if (!PASS2) {
        if (hi == 0) { float* sa = SUM + ((((size_t)ch) * 8 + n) * 2 + DIR) * 128 + l31; sa[0] = At[0]; sa[64] = Bt[0]; sa[32] = At[1]; sa[96] = Bt[1]; }
    } else if (prompt) {
        const bool fin = (DIR == 0) ? (cidx == nch - 1) : (cidx == 0);
        if (fin && hi == 0) { float* o = C.out + OUT_ST + (((size_t)b * 2 + l) * 2 + DIR) * 512 + 64 * n + l31; o[0] = hc[0]; o[32] = hc[1]; }
    }
}
template <bool PASS2>
__device__ __forceinline__ void lru_item(const Ctx& C, int l, int ch, int n) {
    const int lane = lane_id_fresh(), l31 = lane & 31, hi = lane >> 5;
    const f16* PROJ = WSP(f16, WS_ACT);
    const int row0 = ch * 64;
    const bool prompt = row0 < MP;
    int b, t0, T, seqrow0;
    if (prompt) { b = row0 >> 8; t0 = row0 & 255; T = TP; seqrow0 = b * TP; } else { const int rs = row0 - MP; b = rs >> 11; t0 = rs & 2047; T = TS; seqrow0 = MP + b * TS; }
    const int cidx = t0 >> 6, seqch0 = seqrow0 >> 6;
    f16x8 bx[2][4];
    f16x8* xcbuf = WSP(f16x8, WS_XC) + ((size_t)(ch * 8 + n) * 8) * 64 + lane;
    if (PASS2) {
#pragma unroll
        for (int sc = 0; sc < 2; ++sc)
#pragma unroll
            for (int ks = 0; ks < 4; ++ks) bx[sc][ks] = xcbuf[(sc * 4 + ks) * 64];
    } else
#pragma unroll
    for (int ks = 0; ks < 4; ++ks) {
        int chn = 64 * n + 16 * ks + 8 * hi; asm volatile("" : "+v"(chn));
        f32x4 w0[4], w1[4];
#pragma unroll
        for (int j = 0; j < 4; ++j) { w0[j] = *(const f32x4*)(C.in[I_CONVW] + ((size_t)l * 4 + j) * 512 + chn); w1[j] = *(const f32x4*)(C.in[I_CONVW] + ((size_t)l * 4 + j) * 512 + chn + 4); }
        const f32x4 c0 = *(const f32x4*)(C.in[I_CONVB] + (size_t)l * 512 + chn), c1 = *(const f32x4*)(C.in[I_CONVB] + (size_t)l * 512 + chn + 4);
#pragma unroll
        for (int sc = 0; sc < 2; ++sc) {
            const int t = t0 + 32 * sc + l31;
            f16x8 v[4]; float wm[4];
#pragma unroll
            for (int j = 0; j < 4; ++j) { const int tt = t + j - 2; const bool ok = (tt >= 0 && tt < T); wm[j] = ok ? 1.0f : 0.0f;
                v[j] = *(const f16x8*)(PROJ + (size_t)(seqrow0 + (ok ? tt : t)) * DINP + PC_XB + chn); }
            f32x4 a0 = c0, a1 = c1;
#pragma unroll
            for (int j = 0; j < 4; ++j) { a0 += (w0[j] * wm[j]) * (f32x4){(float)v[j][0], (float)v[j][1], (float)v[j][2], (float)v[j][3]}; a1 += (w1[j] * wm[j]) * (f32x4){(float)v[j][4], (float)v[j][5], (float)v[j][6], (float)v[j][7]}; }
            bx[sc][ks] = pack8(cvt4v(a0), cvt4v(a1));
            xcbuf[(sc * 4 + ks) * 64] = bx[sc][ks];
        }
        FENCE(); __builtin_amdgcn_sched_barrier(0);
    }
    __builtin_amdgcn_sched_barrier(0);
    lru_dir<0, PASS2>(C, l, ch, n, bx, b, T, cidx, seqch0, prompt, row0, lane);
    FENCE(); __builtin_amdgcn_sched_barrier(0);
    lru_dir<1, PASS2>(C, l, ch, n, bx, b, T, cidx, seqch0, prompt, row0, lane);
}

constexpr int ATT_SLOT = 20480, ATT_VOFF = 12288;
constexpr float ATT_THR = 8.0f;
typedef short v4i16_t __attribute__((ext_vector_type(4)));
__device__ __forceinline__ f16x4 lds_tr(LAS unsigned char* p) { return __builtin_bit_cast(f16x4, __builtin_amdgcn_ds_read_tr16_b64_v4i16((LAS v4i16_t*)p)); }
template <int TYPE>
__device__ __forceinline__ void attn_unit(const Ctx& C, int l, int kind, int b, int hd, int qblk) {
    const int lane = lane_id_fresh(), tok = lane & 31, hi = lane >> 5, wid = C.wave;
    constexpr int NC = TYPE ? 12 : 8, KTILE = NC * 512;
    const int Tk = kind ? TKS : TP, NT = Tk >> 6;
    const size_t row = (kind ? (size_t)MP + (size_t)b * TS : (size_t)b * TP) + 256 * qblk + 32 * wid + tok;
    const f16* Kimg = (TYPE ? (kind ? WSP(f16, WS_KCS) : WSP(f16, WS_KCP)) : (kind ? WSP(f16, WS_KAS) : WSP(f16, WS_KAP))) + ((size_t)b * 4 + hd) * NT * KTILE + lane * 8;
    const f16* Vimg = (TYPE ? (kind ? WSP(f16, WS_VCTS) : WSP(f16, WS_VCTP)) : (kind ? WSP(f16, WS_VATS) : WSP(f16, WS_VATP))) + ((size_t)b * 4 + hd) * NT * 4096 + wid * 512 + lane * 8;
    LAS unsigned char* lds = C.lds;
    const bool two = (TYPE == 1) && (wid < 4);
#define ATT_DMA(t, sl) do { const f16* kt_ = Kimg + (size_t)(t) * KTILE; LAS unsigned char* ls_ = lds + (sl) * ATT_SLOT; \
        ATT_GLDS(kt_ + wid * 512, ls_ + wid * 1024); if (two) ATT_GLDS(kt_ + (8 + wid) * 512, ls_ + (8 + wid) * 1024); \
        ATT_GLDS(Vimg + (size_t)(t) * 4096, ls_ + ATT_VOFF + wid * 1024); } while (0)
    f16x8 bq[TYPE ? 6 : 4];
    if (TYPE) {
#pragma unroll
        for (int ks = 0; ks < 6; ++ks) bq[ks] = *(const f16x8*)(WSP(f16, WS_QC) + row * 384 + hd * 96 + 16 * ks + 8 * hi);
    } else {
#pragma unroll
        for (int i = 0; i < 4; ++i) bq[i] = *(const f16x8*)(WSP(f16, WS_QA) + row * 256 + hd * 64 + 16 * i + 8 * hi);
    }
    float lam = 0.f, lam_init = 0.f;
    if (TYPE == 0) {
        const float* lp = C.in[I_DLAM] + (size_t)l * 128;
        float s1 = (lane < 32) ? lp[lane] * lp[32 + lane] : 0.f, s2 = (lane < 32) ? lp[64 + lane] * lp[96 + lane] : 0.f;
        s1 = wave_sum(s1); s2 = wave_sum(s2);
        lam_init = 0.8f - 0.6f * expf(-0.3f * (float)l);
        lam = expf(s1) - expf(s2) + lam_init;
    }
#pragma unroll
    for (int i = 0; i < (TYPE ? 6 : 4); ++i) asm volatile("" : "+v"(bq[i]));
    asm volatile("" : "+v"(lam), "+v"(lam_init));
    ATT_DMA(0, 0); ATT_DMA(1, 1);
    if (two) { ATT_WAITBAR(3); } else { ATT_WAITBAR(2); }
    float m0 = 0.f, m1 = 0.f;
    f32x16 O0[2], O1[2], L0 = (f32x16){}, L1 = (f32x16){}; O0[0] = (f32x16){}; O0[1] = (f32x16){}; O1[0] = (f32x16){}; O1[1] = (f32x16){};
    const f16x8 ones = {(f16)1.0f, (f16)1.0f, (f16)1.0f, (f16)1.0f, (f16)1.0f, (f16)1.0f, (f16)1.0f, (f16)1.0f};
    int s_cur = 0, s_nx2 = 2;
    LAS unsigned char* vb0 = lds + ATT_VOFF + (4 * hi + ((lane & 15) >> 2)) * 64 + ((lane >> 4) & 1) * 32 + (lane & 3) * 8;
    LAS unsigned char* kb0 = lds + hi * 1024 + tok * 16;
#pragma unroll 1
    for (int t = 0; t < NT; ++t) {
        if (t + 2 < NT) ATT_DMA(t + 2, s_nx2);
        LAS unsigned char* kb = kb0 + s_cur * ATT_SLOT; LAS unsigned char* vb = vb0 + s_cur * ATT_SLOT;
        f16x8 pf[TYPE ? 1 : 2][2][2];
#pragma unroll
        for (int c = 0; c < (TYPE ? 1 : 2); ++c) {
            f32x16 S[2];
            {
                f16x8 kf[2][TYPE ? 6 : 2];
#pragma unroll
                for (int sub = 0; sub < 2; ++sub)
#pragma unroll
                    for (int ks = 0; ks < (TYPE ? 6 : 2); ++ks) kf[sub][ks] = *(const LAS f16x8*)(kb + c * 4096 + ks * 2048 + sub * 512);
                __builtin_amdgcn_sched_barrier(0);
#pragma unroll
                for (int sub = 0; sub < 2; ++sub) { S[sub] = (f32x16){};
#pragma unroll
                    for (int ks = 0; ks < (TYPE ? 6 : 2); ++ks) S[sub] = MFMA32(kf[sub][ks], bq[c * 2 + ks], S[sub]); }
                __builtin_amdgcn_sched_barrier(0);
            }
            float ma = fmaxf(fmaxf(S[0][0], S[0][1]), S[1][0]), mb = fmaxf(fmaxf(S[0][2], S[0][3]), S[1][1]);
            ma = fmaxf(fmaxf(ma, S[1][2]), S[1][3]);
#pragma unroll
            for (int r = 4; r < 16; r += 4) { ma = fmaxf(fmaxf(ma, S[0][r]), S[0][r + 1]); mb = fmaxf(fmaxf(mb, S[0][r + 2]), S[0][r + 3]); ma = fmaxf(fmaxf(ma, S[1][r]), S[1][r + 1]); mb = fmaxf(fmaxf(mb, S[1][r + 2]), S[1][r + 3]); }
            float rm = fmaxf(ma, mb); rm = fmaxf(rm, __shfl_xor(rm, 32));
            float mref = c ? m1 : m0;
            if (t == 0) mref = rm;
            else if (__any(rm - mref > ATT_THR)) {
                const float dl = fmaxf(rm - mref, 0.f), f = fexp2(-dl); mref += dl;
                if (c == 0) {
#pragma unroll
                    for (int r = 0; r < 16; ++r) { O0[0][r] *= f; O0[1][r] *= f; L0[r] *= f; }
                } else {
#pragma unroll
                    for (int r = 0; r < 16; ++r) { O1[0][r] *= f; O1[1][r] *= f; L1[r] *= f; }
                }
            }
            if (c == 0) m0 = mref; else m1 = mref;
#pragma unroll
            for (int sub = 0; sub < 2; ++sub)
#pragma unroll
                for (int r = 0; r < 16; ++r) S[sub][r] = fexp2(S[sub][r] - mref);
#pragma unroll
            for (int sub = 0; sub < 2; ++sub)
#pragma unroll
                for (int sp = 0; sp < 2; ++sp) pf[c][sub][sp] = pack8(cvt4(S[sub][8 * sp], S[sub][8 * sp + 1], S[sub][8 * sp + 2], S[sub][8 * sp + 3]), cvt4(S[sub][8 * sp + 4], S[sub][8 * sp + 5], S[sub][8 * sp + 6], S[sub][8 * sp + 7]));
        }
#pragma unroll
        for (int vt = 0; vt < 2; ++vt) {
            f16x4 vlo[4], vhi[4];
#pragma unroll
            for (int k4 = 0; k4 < 4; ++k4) { vlo[k4] = lds_tr(vb + vt * 4096 + k4 * 1024); vhi[k4] = lds_tr(vb + vt * 4096 + k4 * 1024 + 512); }
            __builtin_amdgcn_sched_barrier(0);
#pragma unroll
            for (int k4 = 0; k4 < 4; ++k4) {
                const f16x8 vf = pack8(vlo[k4], vhi[k4]);
                O0[vt] = MFMA32(vf, pf[0][k4 >> 1][k4 & 1], O0[vt]);
                if (TYPE == 0) O1[vt] = MFMA32(vf, pf[TYPE ? 0 : 1][k4 >> 1][k4 & 1], O1[vt]);
            }
            __builtin_amdgcn_sched_barrier(0);
        }
#pragma unroll
        for (int k4 = 0; k4 < 4; ++k4) { L0 = MFMA32(ones, pf[0][k4 >> 1][k4 & 1], L0); if (TYPE == 0) L1 = MFMA32(ones, pf[TYPE ? 0 : 1][k4 >> 1][k4 & 1], L1); }
        if (t + 1 < NT) {
            if (t + 2 < NT) { if (two) { ATT_WAITBAR(3); } else { ATT_WAITBAR(2); } } else { ATT_WAITBAR(0); }
        }
        s_nx2 = s_cur; s_cur = (s_cur == 2) ? 0 : s_cur + 1;
    }
#undef ATT_DMA
    f16* o = WSP(f16, WS_OCAT) + row * DM + (TYPE ? 768 : 0) + hd * 64 + 4 * hi;
    if (TYPE) {
        const float inv = 1.0f / L0[0];
#pragma unroll
        for (int vt = 0; vt < 2; ++vt)
#pragma unroll
            for (int g = 0; g < 4; ++g) *(f16x4*)(o + 32 * vt + 8 * g) = cvt4(O0[vt][4 * g] * inv, O0[vt][4 * g + 1] * inv, O0[vt][4 * g + 2] * inv, O0[vt][4 * g + 3] * inv);
    } else {
        const float i0 = 1.0f / L0[0], i1 = lam / L1[0];
        float ss = 0.f;
#pragma unroll
        for (int vt = 0; vt < 2; ++vt)
#pragma unroll
            for (int r = 0; r < 16; ++r) { const float v = O0[vt][r] * i0 - O1[vt][r] * i1; O0[vt][r] = v; ss += v * v; }
        ss += __shfl_xor(ss, 32);
        const float rs = (1.0f / sqrtf(ss * (1.0f / 64.0f) + EPS)) * (1.0f - lam_init);
        const float* sg = C.in[I_DSUB] + (size_t)l * 64 + 4 * hi;
        f32x4 sgv[2][4];
#pragma unroll
        for (int vt = 0; vt < 2; ++vt)
#pragma unroll
            for (int g = 0; g < 4; ++g) sgv[vt][g] = *(const f32x4*)(sg + 32 * vt + 8 * g);
#pragma unroll
        for (int vt = 0; vt < 2; ++vt)
#pragma unroll
            for (int g = 0; g < 4; ++g) { const f32x4 gg = sgv[vt][g];
                *(f16x4*)(o + 32 * vt + 8 * g) = cvt4(O0[vt][4 * g] * rs * gg[0], O0[vt][4 * g + 1] * rs * gg[1], O0[vt][4 * g + 2] * rs * gg[2], O0[vt][4 * g + 3] * rs * gg[3]); }
    }
    ATT_LBAR();
}

template <int mode>
__device__ __forceinline__ void phase_mx(const Ctx& C0, int l, unsigned* ctr) {
    const Ctx C = ctx_fresh(C0);
#pragma unroll 1
    for (int u = C.bid; u < 544; u += C.G) {
        ATT_LBAR();
        if (mode == 1 || mode == 4) continue;
#ifndef NO_MXT
        const int lane = lane_id_fresh();
        if (u < 288) {
            const int g = u >> 2, hd = u & 3;
            const f16* wsrc = ((g < 64) ? WSP(f16, WS_WUKV) : WSP(f16, WS_WUKV0)) + ((size_t)(l * 4 + hd) * 32) * 512 + lane * 8;
#pragma unroll
            for (int i = 0; i < 4; ++i) ATT_GLDS(wsrc + (C.wave + 8 * i) * 512, C.lds + (C.wave + 8 * i) * 1024);
            if (g < 32) mx_kv<0>(C, l, g * 8 + C.wave, hd, C.lds); else if (g < 64) mx_kv<1>(C, l, g * 8 + C.wave, hd, C.lds); else mx_kv<2>(C, l, 512 + (g - 64) * 8 + C.wave, hd, C.lds);
        } else {
            const int v = u - 288, g = v >> 2, hd = v & 3;
            const f16* wsrc = WSP(f16, WS_WUQ) + ((size_t)(l * 4 + hd) * 36) * 512 + lane * 8;
#pragma unroll
            for (int i = 0; i < 5; ++i) if (C.wave + 8 * i < 36) ATT_GLDS(wsrc + (C.wave + 8 * i) * 512, C.lds + (C.wave + 8 * i) * 1024);
            if (g < 32) mx_q<0>(C, l, g * 8 + C.wave, hd, C.lds); else mx_q<1>(C, l, g * 8 + C.wave, hd, C.lds);
        }
#endif
    }
    constexpr int NA = 512 + 576 + 576;
#ifndef NO_LRU1
    if (mode != 2 && mode != 3 && mode != 4)
#pragma unroll 1
        for (int i = C.gw; i < 2048; i += C.ngw) lru_item<false>(C, l, i >> 3, i & 7);
#endif
#ifndef NO_MXT
    if (mode != 1 && mode != 3)
#pragma unroll 1
        for (int it = C.ngw - 1 - C.gw; it < NA; it += C.ngw) {
            if (it < 512) { if (it < 256) mx_a<0, 0>(C, l, it); else mx_a<1, 0>(C, l, it); }
            else if (it < 1088) { const int w = it - 512; if (w < 256) mx_a<0, 1>(C, l, w); else if (w < 512) mx_a<1, 1>(C, l, w); else mx_a<2, 1>(C, l, w); }
            else { const int w = it - 1088; if (w < 256) mx_a<0, 2>(C, l, w); else if (w < 512) mx_a<1, 2>(C, l, w); else mx_a<2, 2>(C, l, w); }
        }
#endif
}

template <int mode>
__device__ __forceinline__ void phase_att(const Ctx& C0, int l, unsigned* ctr) {
    const Ctx C = ctx_fresh(C0);
    const int half = C.G >> 1;
    if (mode != 1) {
#pragma unroll 1
        for (int u = C.bid; u < 128; u += half) { if (C.bid >= half) break;
#ifndef NO_ATTA
            if (mode == 0 || mode == 2 || mode == 5) { const int pr = (u & 7) * 2 + ((u >> 3) >> 3), qb = (u >> 3) & 7;
                attn_unit<0>(C, l, 1, pr >> 2, pr & 3, qb); }
#endif
        }
        if (C.bid >= half) {
#pragma unroll 1
            for (int u = C.bid - half; u < 128; u += half) {
#ifndef NO_ATTC
                if (mode == 0 || mode == 2 || mode == 6) { const int pr = (u & 7) * 2 + ((u >> 3) >> 3), qb = (u >> 3) & 7;
                    attn_unit<1>(C, l, 1, pr >> 2, pr & 3, qb); }
#endif
            }
#pragma unroll 1
            for (int u = C.bid - half; u < 128; u += half) {
#ifndef NO_ATTA
                if (mode == 0 || mode == 2 || mode == 7) attn_unit<0>(C, l, 0, u >> 2, u & 3, 0);
#endif
#ifndef NO_ATTC
                if (mode == 0 || mode == 2 || mode == 7) attn_unit<1>(C, l, 0, u >> 2, u & 3, 0);
#endif
            }
        }
    }
#ifndef NO_LRU2
    if (mode == 0 || mode == 1) {
#pragma unroll 1
        for (int it = C.gw; it < 2048; it += C.ngw) lru_item<true>(C, l, it >> 3, it & 7);
    }
#endif
}

__global__ void __launch_bounds__(512, 2) mk_fwd(Args args) {
    extern __shared__ __attribute__((aligned(16))) unsigned char lds_raw[];
    Ctx C;
    C.in = args.in; C.out = args.out; C.ws = args.ws;
    C.lds = (LAS unsigned char*)lds_raw;
    C.tid = threadIdx.x; C.lane = C.tid & 63; C.wave = __builtin_amdgcn_readfirstlane(C.tid >> 6);
    C.gw = 0; C.ngw = 0; C.bid = 0; C.G = 0;
    volatile LAS unsigned* MISC = (volatile LAS unsigned*)(C.lds + MISC_OFF);
    for (int u = C.tid; u < (LDS_BYTES - LDSCTL_OFF) / 4; u += 512) ((LAS unsigned*)(C.lds + LDSCTL_OFF))[u] = 0u;
    __syncthreads();
    unsigned* ctl = (unsigned*)(args.ws + WS_CTL);
    XcdBarrier bar = xcd_barrier_post(ctl + CW_BAR, MISC + 8);
    const int lo = args.ph_lo, hi = args.ph_hi;
#define IN(k) (lo <= (k) && (k) < hi)
#define SEAM(k) do { if (IN(k) && IN((k) + 1)) xcd_barrier(bar); } while (0)

    int rep = 0;
#pragma unroll 1
    for (int p = lo; p < hi; ++p) {
        const int l = (p >= 10) ? 1 : 0, q = (p < 2) ? -1 - p : (p - 2 - 8 * l);
        int bid = blockIdx.x, G = gridDim.x; asm volatile("" : "+s"(bid), "+s"(G));
        const float* modl = WSP(float, WS_MOD) + (size_t)l * 5 * NMODV;
        if (q == -1) {
#ifndef NO_PREP
            phase_prep(C);
#endif
        } else if (q == -2) phase_norm<true>(C, 0, 0);
        else if (q == 0 || q == 6) {
            const int s = (q == 6);
            pg8::Gemm g{WSP(f16, WS_H), WSP(f16, WS_WFI) + (size_t)(l * 2 + s) * NFF2 * 1024, M, NFF2, 1024}; pg8::StaticOrder S; S.init(M, NFF2, G, bid);
            pg8::EpiSwiglu E{WSP(f16, WS_ACT)};
            pg8::gemm_phase<pg8::EpiSwiglu, pg8::StaticOrder, true, true>(C.lds, g, S, E, C.wave);
        } else if (q == 1 || q == 7 || q == 5) {
            const int s = (q == 7);
            const f16* A = (q == 5) ? WSP(f16, WS_OCAT) : WSP(f16, WS_ACT);
            const f16* B = (q == 5) ? WSP(f16, WS_WOUT) + (size_t)l * 1024 * 1024 : WSP(f16, WS_WFO) + (size_t)(l * 2 + s) * 1024 * DFF;
            pg8::Gemm g{A, B, M, 1024, (q == 5) ? 1024 : DFF}; pg8::StaticOrder S; S.init(M, 1024, G, bid);
            const int nl = (q == 7) ? l + 1 : l, nsub = (q == 1) ? 1 : ((q == 5) ? 2 : 0), donorm = (nl < DEPTH) ? 1 : 0, nlc = donorm ? nl : l;
            pg8::EpiResidNorm E{C.out, WSP(f16, WS_XH), modl, (q == 5) ? 5 : (s ? 8 : 2), (rep > 0) ? 0.0f : ((q == 5) ? 1.0f : 0.5f),
                                donorm, WSP(f16, WS_H), C.in[I_NG] + ((size_t)nlc * 3 + nsub) * DM, WSP(float, WS_MOD) + (size_t)nlc * 5 * NMODV + (3 * nsub) * DM,
                                WSP(float, WS_XBUF), ctl + CW_PAN + (p + 18 * rep) * 4096};
            pg8::gemm_phase<pg8::EpiResidNorm, pg8::StaticOrder, false, true>(C.lds, g, S, E, C.wave);
        } else if (q == 2) {
            pg8::Gemm g{WSP(f16, WS_H), WSP(f16, WS_WIN) + (size_t)l * DINP * 1024, M, DINP, 1024}; pg8::StaticOrder S; S.init(M, DINP, G, bid);
            pg8::EpiStore E{WSP(f16, WS_ACT), DINP};
            pg8::gemm_phase<pg8::EpiStore, pg8::StaticOrder, true, true>(C.lds, g, S, E, C.wave);
        } else if (q == 3) { if (REP_MODE != 0 && rep) phase_mx<REP_MODE>(C, l, ctl + CW_Q + 64 * (p + 32 * rep)); else phase_mx<0>(C, l, ctl + CW_Q + 64 * (p + 32 * rep)); }
        else if (q == 4) { if (REP_MODE != 0 && rep) phase_att<REP_MODE>(C, l, ctl + CW_Q + 64 * (p + 32 * rep)); else phase_att<0>(C, l, ctl + CW_Q + 64 * (p + 32 * rep)); }
        if (REP_Q == 99 && p == 1) { for (int k = 0; k < 10; ++k) xcd_barrier(bar, C.wave); }
        if (q == REP_Q && rep < REP_N) { ++rep; --p; xcd_barrier(bar, C.wave); continue; }
        rep = 0;
        if (p + 1 < hi) xcd_barrier(bar, C.wave);
    }
#undef IN
#undef SEAM
}

extern "C" void kernel_launch(void* const* d_in, const int* in_sizes, int n_in, void* d_out, int out_size, void* d_ws, size_t ws_size, hipStream_t stream) {
    static int grid = 0;
    if (grid == 0) {
        if (n_in != N_IN || ws_size < WS_END || out_size != 27852800) { fprintf(stderr, "kernel_launch: unexpected shapes: n_in %d ws %zu out %d\n", n_in, ws_size, out_size); grid = -1; return; }
        int dev = 0, cus = 0, per_cu = 0;
        if (hipGetDevice(&dev) != hipSuccess || hipDeviceGetAttribute(&cus, hipDeviceAttributeMultiprocessorCount, dev) != hipSuccess) { grid = -1; return; }
        if (hipFuncSetAttribute((const void*)mk_fwd, hipFuncAttributeMaxDynamicSharedMemorySize, LDS_BYTES) != hipSuccess) { fprintf(stderr, "kernel_launch: hipFuncSetAttribute failed\n"); grid = -1; return; }
        if (hipOccupancyMaxActiveBlocksPerMultiprocessor(&per_cu, (const void*)mk_fwd, 512, LDS_BYTES) != hipSuccess || per_cu < 1) { fprintf(stderr, "kernel_launch: occupancy query says %d\n", per_cu); per_cu = 1; }
        (void)hipGetLastError();
        grid = cus;
    }
    if (grid < 0) return;
    if (hipMemsetAsync((char*)d_ws + WS_CTL, 0, CTL_ZERO_BYTES, stream) != hipSuccess) return;
    Args a{};
    for (int i = 0; i < N_IN; ++i) a.in[i] = (const float*)d_in[i];
    a.out = (float*)d_out; a.ws = (unsigned char*)d_ws;
#if MK_MULTI
    for (int p = 0; p < MK_PH_HI; ++p) { a.ph_lo = p; a.ph_hi = p + 1; hipLaunchKernelGGL(mk_fwd, dim3(grid), dim3(512), LDS_BYTES, stream, a); }
#else
    a.ph_lo = 0; a.ph_hi = MK_PH_HI;
    void* kargs[] = {&a};
    hipError_t e = hipLaunchCooperativeKernel((const void*)mk_fwd, dim3(grid), dim3(512), kargs, LDS_BYTES, stream);
    if (e != hipSuccess) { (void)hipGetLastError(); fprintf(stderr, "kernel_launch: cooperative launch failed (%s), plain launch instead\n", hipGetErrorString(e));
        hipLaunchKernelGGL(mk_fwd, dim3(grid), dim3(512), LDS_BYTES, stream, a); }
#endif
}
```

```cpp
#include <hip/hip_runtime.h>
#include <cstdio>
#include <cstdint>

#define GAS __attribute__((address_space(1)))
#define LAS __attribute__((address_space(3)))
typedef _Float16 f16;
typedef _Float16 f16x2 __attribute__((ext_vector_type(2)));
typedef _Float16 f16x4 __attribute__((ext_vector_type(4)));
typedef _Float16 f16x8 __attribute__((ext_vector_type(8)));
typedef float f32x2 __attribute__((ext_vector_type(2)));
typedef float f32x4 __attribute__((ext_vector_type(4)));
typedef float f32x16 __attribute__((ext_vector_type(16)));
typedef unsigned u32x2 __attribute__((ext_vector_type(2)));
typedef unsigned u32x4 __attribute__((ext_vector_type(4)));
typedef GAS unsigned gu32;

#ifndef MK_PH_HI
#define MK_PH_HI 18
#endif
#ifndef REP_Q
#define REP_Q -2
#endif
#ifndef REP_N
#define REP_N 1
#endif
#ifndef REP_MODE
#define REP_MODE 0
#endif
#ifndef MK_MULTI
#define MK_MULTI 0
#endif

constexpr int DM = 1024, NBP = 32, TP = 256, NBS = 4, TS = 2048, PAST = 512, DEPTH = 2;
constexpr int MP = NBP * TP, MS = NBS * TS, M = MP + MS;
constexpr int DFF = 2816, NFF2 = 5632, DIN = 2144, DINP = 2304, NMODV = 9216;
constexpr int TKS = PAST + TS;
constexpr float EPS = 1e-6f;
constexpr float LOG2E = 1.4426950408889634f;
constexpr int PC_QA = 0, PC_KA = 256, PC_VA = 512, PC_XB = 768, PC_GB = 1280, PC_CQ = 1792, PC_CKV = 1984, PC_KR = 2112;
constexpr size_t OUT_YP = 0, OUT_YS = 8388608, OUT_DK = 16777216, OUT_DV = 20971520, OUT_CKV = 25165824, OUT_KR = 27262976, OUT_ST = 27787264;
enum { I_XP = 0, I_XS, I_CDK, I_CDV, I_CCKV, I_CKR, I_ST, I_C, I_CCTX, I_NG, I_WADA, I_BADA, I_WFI, I_WFO, I_WIN, I_WOUT, I_DQKN, I_DLAM, I_DSUB,
       I_CONVW, I_CONVB, I_WGATE, I_BGATE, I_LLAM, I_CQN, I_CKVN, I_WUQ, I_WUKV, I_QKN, N_IN };

constexpr size_t MiB = 1u << 20;
constexpr size_t WS_CTL = 0, CTL_ZERO_BYTES = 1 * MiB;
constexpr size_t WS_MOD = 1 * MiB;
constexpr size_t WS_WUQ = 2 * MiB;
constexpr size_t WS_WUKV = 2 * MiB + 512 * 1024;
constexpr size_t WS_WUKV0 = 3 * MiB + 512 * 1024;
constexpr size_t WS_IDN = 3 * MiB + 768 * 1024;
constexpr size_t WS_WG = 3 * MiB;
constexpr size_t WS_SUM = 4 * MiB;
constexpr size_t WS_XBUF = 4 * MiB + 2 * MiB + 512 * 1024;
constexpr size_t WS_WFI = 8 * MiB;
constexpr size_t WS_WFO = 52 * MiB;
constexpr size_t WS_WIN = 74 * MiB;
constexpr size_t WS_WOUT = 83 * MiB;
constexpr size_t WS_H = 88 * MiB;
constexpr size_t WS_OCAT = 120 * MiB;
constexpr size_t WS_ACT = 152 * MiB;
constexpr size_t WS_XC = 224 * MiB;
constexpr size_t WS_QA = 240 * MiB;
constexpr size_t WS_QC = 248 * MiB;
constexpr size_t WS_KAS = 260 * MiB;
constexpr size_t WS_KAP = 265 * MiB;
constexpr size_t WS_VATS = 269 * MiB;
constexpr size_t WS_VATP = 274 * MiB;
constexpr size_t WS_KCS = 278 * MiB;
constexpr size_t WS_KCP = 286 * MiB;
constexpr size_t WS_VCTS = 292 * MiB;
constexpr size_t WS_VCTP = 297 * MiB;
constexpr size_t WS_XH = 301 * MiB;
constexpr size_t WS_END = 333 * MiB;
constexpr int CW_BAR = 4096;
constexpr int CW_Q = 16384;
constexpr int CW_PAN = 65536;

constexpr int RING_BYTES = 131072;
constexpr int LDSCTL_OFF = RING_BYTES, MISC_OFF = LDSCTL_OFF + 320;
constexpr int LDS_BYTES = 147456;

__device__ __forceinline__ int crow(int r, int hi) { return (r & 3) + 8 * (r >> 2) + 4 * hi; }
__device__ __forceinline__ int swap23(int x) { return (x & ~12) | ((x & 4) << 1) | ((x & 8) >> 1); }
__device__ __forceinline__ f16x2 cvt2(float a, float b) { f32x2 v = {a, b}; return __builtin_convertvector(v, f16x2); }
__device__ __forceinline__ f16x4 cvt4(float a, float b, float c, float d) { f32x4 v = {a, b, c, d}; return __builtin_convertvector(v, f16x4); }
__device__ __forceinline__ f16x4 cvt4v(f32x4 v) { return __builtin_convertvector(v, f16x4); }
__device__ __forceinline__ f32x4 tof32(f16x4 v) { return __builtin_convertvector(v, f32x4); }
__device__ __forceinline__ f16x8 pack8(f16x4 a, f16x4 b) { return __builtin_shufflevector(a, b, 0, 1, 2, 3, 4, 5, 6, 7); }
__device__ __forceinline__ float fexp2(float x) { return __builtin_amdgcn_exp2f(x); }
__device__ __forceinline__ float frcp(float x) { return __builtin_amdgcn_rcpf(x); }
__device__ __forceinline__ float sigmoidf_(float x) { return frcp(1.0f + fexp2(-x * LOG2E)); }
__device__ __forceinline__ float wave_sum(float v) {
#pragma unroll
    for (int o = 1; o < 64; o <<= 1) v += __shfl_xor(v, o);
    return v;
}
#define FENCE() asm volatile("" ::: "memory")
__device__ __forceinline__ int lane_id_fresh() { int l; asm volatile("v_mbcnt_lo_u32_b32 %0, -1, 0\n\tv_mbcnt_hi_u32_b32 %0, -1, %0" : "=v"(l)); return l; }
#define MFMA32(a, b, c) __builtin_amdgcn_mfma_f32_32x32x16_f16((a), (b), (c), 0, 0, 0)

namespace pg8 {
#define PG8_LAS __attribute__((address_space(3)))
constexpr int BM = 256, BK = 64, HALF = 128, HTB = HALF * BK * 2, STAGE_BYTES = 8 * HTB, NXCD = 8, WGM = 8;
__host__ __device__ __forceinline__ int lds_byte(int r, int c) { const int st = (r >> 4) * 2 + (c >> 5), rr = r & 15, cc = c & 31, ob = rr * 64 + cc * 2; return st * 1024 + (ob ^ (((ob >> 9) & 1) << 5)); }
__host__ __device__ __forceinline__ void stage_rc(int b, int& R, int& C) { const int st = b / 1024, sb = b % 1024, swz = sb ^ (((sb >> 9) & 1) << 5); R = (st >> 1) * 16 + swz / 64; C = (st & 1) * 32 + (swz % 64) / 2; }
__host__ __device__ __forceinline__ int perm32(int rho) { const int n = rho >> 4, i = rho & 15; return 8 * (i >> 2) + 4 * n + (i & 3); }
struct Unit { int pm, pn; };
struct Gemm { const f16* A; const f16* Bt; int M, N, K; };
struct StaticOrder {
    int nM, nN, nwg, G, c;
    __host__ __device__ void init(int M_, int N_, int G_, int c_) { nM = M_ / BM; nN = N_ / BM; nwg = nM * nN; G = G_; c = c_; }
    __host__ __device__ bool next(int i, Unit& u) const {
        const long L = (long)i * G + c; if (L >= nwg) return false;
        int wgid = (int)L; { const int q = nwg / NXCD, r = nwg % NXCD, xcd = wgid % NXCD, off = wgid / NXCD; wgid = (xcd < r ? xcd * (q + 1) : r * (q + 1) + (xcd - r) * q) + off; }
        const int nig = WGM * nN, gid = wgid / nig, fm = gid * WGM, gsz = (nM - fm) < WGM ? (nM - fm) : WGM;
        u.pm = fm + ((wgid % nig) % gsz); u.pn = (wgid % nig) / gsz; return true;
    }
};
struct EpiSwiglu {
    static constexpr bool PERM = true, AFTER_DRAIN = false;
    f16* O;
    __device__ __forceinline__ void operator()(const f32x4 (&acc)[2][2][4][2], const Unit& u, int wr, int wc, int fr, int fq) const {
        const int row0 = u.pm * BM + wr * 64 + fr, col0 = u.pn * 128 + wc * 32 + 8 * fq;
#pragma unroll
        for (int ai = 0; ai < 2; ++ai)
#pragma unroll
            for (int m = 0; m < 4; ++m) {
                f16* rowp = O + (size_t)(row0 + ai * HALF + m * 16) * DFF + col0;
                f32x4 a0, a1;
#pragma unroll
                for (int e = 0; e < 4; ++e) {
                    const float g0 = acc[ai][0][m][0][e], g1 = acc[ai][0][m][1][e];
                    a0[e] = g0 * sigmoidf_(g0) * acc[ai][1][m][0][e];
                    a1[e] = g1 * sigmoidf_(g1) * acc[ai][1][m][1][e];
                }
                *(f16x8*)rowp = pack8(cvt4v(a0), cvt4v(a1));
            }
    }
};
struct EpiStore {
    static constexpr bool PERM = true, AFTER_DRAIN = false;
    f16* O; int ldc;
    __device__ __forceinline__ void operator()(const f32x4 (&acc)[2][2][4][2], const Unit& u, int wr, int wc, int fr, int fq) const {
        const int row0 = u.pm * BM + wr * 64 + fr, col0 = u.pn * BM + wc * 32 + 8 * fq;
#pragma unroll
        for (int ai = 0; ai < 2; ++ai)
#pragma unroll
            for (int m = 0; m < 4; ++m) {
                f16* rowp = O + (size_t)(row0 + ai * HALF + m * 16) * ldc + col0;
#pragma unroll
                for (int bj = 0; bj < 2; ++bj) *(f16x8*)(rowp + bj * HALF) = pack8(cvt4v(acc[ai][bj][m][0]), cvt4v(acc[ai][bj][m][1]));
            }
    }
};
struct EpiResidNorm {
    static constexpr bool PERM = true, AFTER_DRAIN = true;
    float* X; f16* XH; const float* modl; int gidx; float coef;
    int donorm; f16* H; const float* gn; const float* shn;
    float* xbuf; unsigned* cnt;
    __device__ __forceinline__ void fused(f32x4 (&acc)[2][2][4][2], const Unit& u, int wr, int wc, int fr, int fq, PG8_LAS unsigned char* lds, int wid, int lane) const {
        const int cond = (u.pm < 32) ? 4 : ((u.pm - 32) >> 3);
        const int col0 = u.pn * BM + wc * 32 + 8 * fq;
        {
            const float* gp = modl + (size_t)cond * NMODV + gidx * DM + col0;
            f32x4 gv[2][2];
#pragma unroll
            for (int bj = 0; bj < 2; ++bj)
#pragma unroll
                for (int n = 0; n < 2; ++n) gv[bj][n] = *(const f32x4*)(gp + bj * HALF + n * 4) * coef;
#pragma unroll
            for (int ai = 0; ai < 2; ++ai)
#pragma unroll
                for (int m = 0; m < 4; ++m) {
                    const f16* rowp = XH + (size_t)(u.pm * BM + ai * HALF + wr * 64 + m * 16 + fr) * DM + col0;
                    f32x4 xv[2][2];
#pragma unroll
                    for (int bj = 0; bj < 2; ++bj) { const f16x8 xh = *(const f16x8*)(rowp + bj * HALF);
                        xv[bj][0] = (f32x4){(float)xh[0], (float)xh[1], (float)xh[2], (float)xh[3]}; xv[bj][1] = (f32x4){(float)xh[4], (float)xh[5], (float)xh[6], (float)xh[7]}; }
#pragma unroll
                    for (int bj = 0; bj < 2; ++bj)
#pragma unroll
                        for (int n = 0; n < 2; ++n) { const f32x4 v = xv[bj][n] + gv[bj][n] * acc[ai][bj][m][n]; acc[ai][bj][m][n] = v; }
                    asm volatile("" : "+v"(acc[ai][0][m][0]), "+v"(acc[ai][0][m][1]), "+v"(acc[ai][1][m][0]), "+v"(acc[ai][1][m][1]));
                    if (m & 1) asm volatile("" ::: "memory");
                }
        }
        if (!donorm) {
#pragma unroll
            for (int ai = 0; ai < 2; ++ai)
#pragma unroll
                for (int m = 0; m < 4; ++m) {
                    float* rowp = X + (size_t)(u.pm * BM + ai * HALF + wr * 64 + m * 16 + fr) * DM + col0;
#pragma unroll
                    for (int bj = 0; bj < 2; ++bj)
#pragma unroll
                        for (int n = 0; n < 2; ++n) *(f32x4*)(rowp + bj * HALF + n * 4) = acc[ai][bj][m][n];
                }
            return;
        }
        PG8_LAS float* P = (PG8_LAS float*)lds;
        PG8_LAS float* S = (PG8_LAS float*)(lds + 4096);
#pragma unroll
        for (int ai = 0; ai < 2; ++ai)
#pragma unroll
            for (int m = 0; m < 4; ++m) {
                float q = 0.f;
#pragma unroll
                for (int bj = 0; bj < 2; ++bj)
#pragma unroll
                    for (int n = 0; n < 2; ++n) { const f32x4 x = acc[ai][bj][m][n]; q += (x[0] * x[0] + x[1] * x[1]) + (x[2] * x[2] + x[3] * x[3]); }
                q += __shfl_xor(q, 16); q += __shfl_xor(q, 32);
                if (fq == 0) P[(ai * HALF + wr * 64 + m * 16 + fr) * 4 + wc] = q;
            }
        asm volatile("s_waitcnt lgkmcnt(0)" ::: "memory"); __builtin_amdgcn_s_barrier(); asm volatile("" ::: "memory");
        const int row = wid * 32 + (lane & 31);
        if (lane < 32) {
            const float tot = (P[row * 4 + 0] + P[row * 4 + 1]) + (P[row * 4 + 2] + P[row * 4 + 3]);
            __hip_atomic_store(xbuf + ((size_t)(u.pm * BM + row) * 4 + u.pn), tot, __ATOMIC_RELAXED, __HIP_MEMORY_SCOPE_AGENT);
        }
        asm volatile("s_waitcnt vmcnt(0)" ::: "memory");
        if (lane == 0) __hip_atomic_fetch_add(cnt + 64 * u.pm, 1u, __ATOMIC_RELAXED, __HIP_MEMORY_SCOPE_AGENT);
#pragma unroll
        for (int ai = 0; ai < 2; ++ai)
#pragma unroll
            for (int m = 0; m < 4; ++m) {
                f16* rowp = XH + (size_t)(u.pm * BM + ai * HALF + wr * 64 + m * 16 + fr) * DM + col0;
#pragma unroll
                for (int bj = 0; bj < 2; ++bj) *(f16x8*)(rowp + bj * HALF) = pack8(cvt4v(acc[ai][bj][m][0]), cvt4v(acc[ai][bj][m][1]));
            }
        if (wid == 0) {
            unsigned spins = 0;
            for (;;) {
                if ((unsigned)__builtin_amdgcn_readfirstlane(__hip_atomic_load(cnt + 64 * u.pm, __ATOMIC_RELAXED, __HIP_MEMORY_SCOPE_AGENT)) >= 32u) break;
                if (++spins > (1u << 20)) break;
                __builtin_amdgcn_s_sleep(2);
            }
            __builtin_amdgcn_fence(__ATOMIC_ACQUIRE, "agent");
        }
        asm volatile("s_waitcnt vmcnt(0) lgkmcnt(0)" ::: "memory"); __builtin_amdgcn_s_barrier(); asm volatile("" ::: "memory");
        if (lane < 32) {
            const float* slot = xbuf + (size_t)(u.pm * BM + row) * 4;
            const float t0 = __hip_atomic_load(slot + 0, __ATOMIC_RELAXED, __HIP_MEMORY_SCOPE_AGENT), t1 = __hip_atomic_load(slot + 1, __ATOMIC_RELAXED, __HIP_MEMORY_SCOPE_AGENT);
            const float t2 = __hip_atomic_load(slot + 2, __ATOMIC_RELAXED, __HIP_MEMORY_SCOPE_AGENT), t3 = __hip_atomic_load(slot + 3, __ATOMIC_RELAXED, __HIP_MEMORY_SCOPE_AGENT);
            S[row] = 1.0f / sqrtf(((t0 + t1) + (t2 + t3)) * (1.0f / DM) + EPS);
        }
        asm volatile("s_waitcnt lgkmcnt(0)" ::: "memory"); __builtin_amdgcn_s_barrier(); asm volatile("" ::: "memory");
        const float* shp = shn + (size_t)cond * NMODV + col0;
        f32x4 gsv[2][2], shv[2][2];
#pragma unroll
        for (int bj = 0; bj < 2; ++bj)
#pragma unroll
            for (int n = 0; n < 2; ++n) { const int co = bj * HALF + n * 4;
                gsv[bj][n] = *(const f32x4*)(gn + col0 + co) * (*(const f32x4*)(shp + DM + co) + 1.0f); shv[bj][n] = *(const f32x4*)(shp + co); }
#pragma unroll
        for (int ai = 0; ai < 2; ++ai)
#pragma unroll
            for (int m = 0; m < 4; ++m) { const int r = ai * HALF + wr * 64 + m * 16 + fr; const float sr = S[r];
#pragma unroll
                for (int bj = 0; bj < 2; ++bj) *(f16x8*)(H + (size_t)(u.pm * BM + r) * DM + col0 + bj * HALF) = pack8(cvt4v(acc[ai][bj][m][0] * sr * gsv[bj][0] + shv[bj][0]), cvt4v(acc[ai][bj][m][1] * sr * gsv[bj][1] + shv[bj][1])); }
    }
};

template <class Epi, class Sched, bool ALIGN_EPI, bool SP2>
__device__ __forceinline__ void gemm_phase(PG8_LAS unsigned char* lds, const Gemm g, const Sched& S, const Epi& E, int wave_id) {
    const int lane = lane_id_fresh(), wid = wave_id, tid = wid * 64 + lane, wr = wid >> 2, wc = wid & 3, fr = lane & 15, fq = lane >> 4;
    const int K = g.K, nt = K / BK;
    unsigned voffA[2], voffB[2];
#pragma unroll
    for (int i = 0; i < 2; ++i) { int R, C; stage_rc(tid * 16 + i * 8192, R, C); const int Rb = Epi::PERM ? ((R & ~31) + perm32(R & 31)) : R;
        voffA[i] = (unsigned)(R * K + C) * 2u; voffB[i] = (unsigned)(Rb * K + C) * 2u; }
    const size_t kstep = (size_t)(BK * 2);
    const size_t hstep = (size_t)HALF * K * 2;
    const size_t tstep = 2 * hstep;
    const unsigned ldsw = (unsigned)wid * 1024u;
    const int aoff = lds_byte(wr * 64 + fr, fq * 8), boff = lds_byte(wc * 32 + fr, fq * 8);
#define PG8_SA(b, h) (((b) * 2 + (h)) * HTB)
#define PG8_SB(b, h) ((4 + (b) * 2 + (h)) * HTB)
#define PG8_STAGE(bufoff, gbase, voff) do { _Pragma("unroll") for (int _i = 0; _i < 2; ++_i) \
        __builtin_amdgcn_global_load_lds((const unsigned*)((const char*)(gbase) + (voff)[_i]), (PG8_LAS unsigned*)(lds + (bufoff) + ldsw + _i * 8192), 16, 0, 0); } while (0)
#define PG8_LDA(dst, b, h) do { _Pragma("unroll") for (int m = 0; m < 4; ++m) _Pragma("unroll") for (int k = 0; k < 2; ++k) dst[m][k] = *(const PG8_LAS f16x8*)(lds + PG8_SA(b, h) + aoff + m * 2048 + k * 1024); } while (0)
#define PG8_LDB(dst, b, h) do { _Pragma("unroll") for (int n = 0; n < 2; ++n) _Pragma("unroll") for (int k = 0; k < 2; ++k) dst[n][k] = *(const PG8_LAS f16x8*)(lds + PG8_SB(b, h) + boff + n * 2048 + k * 1024); } while (0)
#define PG8_MMA(ai, bj, At, Bt) do { __builtin_amdgcn_s_setprio(1); _Pragma("unroll") for (int m = 0; m < 4; ++m) _Pragma("unroll") for (int n = 0; n < 2; ++n) _Pragma("unroll") for (int k = 0; k < 2; ++k) \
        acc[ai][bj][m][n] = __builtin_amdgcn_mfma_f32_16x16x32_f16(Bt[n][k], At[m][k], acc[ai][bj][m][n], 0, 0, 0); __builtin_amdgcn_s_setprio(0); } while (0)
#define PG8_WAIT_V(n) asm volatile("s_waitcnt vmcnt(" #n ")" ::: "memory")
#define PG8_WAIT_L(n) asm volatile("s_waitcnt lgkmcnt(" #n ")" ::: "memory")
#define PG8_BAR __builtin_amdgcn_s_barrier()
#define PG8_SCHED __builtin_amdgcn_sched_barrier(0)
    Unit cur, nxt; int ui = 0;
    if (!S.next(0, cur)) return;
    f32x4 acc[2][2][4][2];
#pragma unroll
    for (int a = 0; a < 2; ++a)
#pragma unroll
        for (int b = 0; b < 2; ++b)
#pragma unroll
            for (int m = 0; m < 4; ++m)
#pragma unroll
                for (int n = 0; n < 2; ++n) acc[a][b][m][n] = (f32x4){0.f, 0.f, 0.f, 0.f};
    f16x8 At[4][2], B0[2][2], B1[2][2];
    const char* cA = (const char*)g.A + (size_t)cur.pm * tstep; const char* cB = (const char*)g.Bt + (size_t)cur.pn * tstep;
    if constexpr (SP2) {
        PG8_STAGE(PG8_SB(0, 0), cB, voffB); PG8_STAGE(PG8_SB(0, 1), cB + hstep, voffB); PG8_STAGE(PG8_SA(0, 0), cA, voffA); PG8_STAGE(PG8_SA(0, 1), cA + hstep, voffA);
        if (wr == 1) PG8_BAR;
        PG8_WAIT_V(2); PG8_BAR;
        PG8_STAGE(PG8_SB(1, 0), cB + kstep, voffB); PG8_STAGE(PG8_SA(1, 0), cA + kstep, voffA); PG8_STAGE(PG8_SB(1, 1), cB + hstep + kstep, voffB);
        PG8_WAIT_V(6); PG8_BAR;
    } else {
        PG8_STAGE(PG8_SB(0, 0), cB, voffB); PG8_STAGE(PG8_SA(0, 0), cA, voffA); PG8_STAGE(PG8_SB(0, 1), cB + hstep, voffB); PG8_STAGE(PG8_SA(0, 1), cA + hstep, voffA);
        if (wr == 1) PG8_BAR;
        PG8_WAIT_V(4); PG8_BAR;
        PG8_STAGE(PG8_SB(1, 0), cB + kstep, voffB); PG8_STAGE(PG8_SA(1, 0), cA + kstep, voffA); PG8_STAGE(PG8_SB(1, 1), cB + hstep + kstep, voffB);
        PG8_WAIT_V(6); PG8_BAR;
    }
    for (;;) {
        const bool has_next = S.next(ui + 1, nxt);
        const char* nA = has_next ? (const char*)g.A + (size_t)nxt.pm * tstep : cA; const char* nB = has_next ? (const char*)g.Bt + (size_t)nxt.pn * tstep : cB;
        for (int t = 0; t < nt; t += 2) {
            const bool last = (t == nt - 2);
            const char* a1 = cA + (size_t)(t + 1) * kstep;
            const char* a2 = last ? nA : cA + (size_t)(t + 2) * kstep; const char* b2 = last ? nB : cB + (size_t)(t + 2) * kstep;
            const char* a3 = a2 + kstep; const char* b3 = b2 + kstep;
            if constexpr (SP2) {
            PG8_LDB(B0, 0, 0); PG8_LDB(B1, 0, 1); PG8_SCHED; PG8_LDA(At, 0, 0); PG8_STAGE(PG8_SA(1, 1), a1 + hstep, voffA);
            PG8_WAIT_V(8); PG8_WAIT_L(0); PG8_BAR; PG8_MMA(0, 0, At, B0); PG8_MMA(0, 1, At, B1); PG8_BAR; PG8_SCHED;
            PG8_LDA(At, 0, 1); PG8_STAGE(PG8_SB(0, 0), b2, voffB); PG8_STAGE(PG8_SB(0, 1), b2 + hstep, voffB); PG8_STAGE(PG8_SA(0, 0), a2, voffA);
            PG8_WAIT_V(8); PG8_WAIT_L(0); PG8_BAR; PG8_MMA(1, 0, At, B0); PG8_MMA(1, 1, At, B1); PG8_BAR; PG8_SCHED;
            PG8_LDB(B0, 1, 0); PG8_LDB(B1, 1, 1); PG8_SCHED; PG8_LDA(At, 1, 0); PG8_STAGE(PG8_SA(0, 1), a2 + hstep, voffA);
            PG8_WAIT_V(8); PG8_WAIT_L(0); PG8_BAR; PG8_MMA(0, 0, At, B0); PG8_MMA(0, 1, At, B1); PG8_BAR; PG8_SCHED;
            PG8_LDA(At, 1, 1); PG8_STAGE(PG8_SB(1, 0), b3, voffB); PG8_STAGE(PG8_SB(1, 1), b3 + hstep, voffB); PG8_STAGE(PG8_SA(1, 0), a3, voffA);
            PG8_WAIT_V(8); PG8_WAIT_L(0); PG8_BAR; PG8_MMA(1, 0, At, B0); PG8_MMA(1, 1, At, B1); PG8_BAR; PG8_SCHED;
            } else {
            PG8_LDB(B0, 0, 0); PG8_SCHED; PG8_LDA(At, 0, 0); PG8_STAGE(PG8_SA(1, 1), a1 + hstep, voffA);
            PG8_WAIT_L(8); PG8_BAR; PG8_WAIT_L(0); PG8_MMA(0, 0, At, B0); PG8_BAR; PG8_SCHED;
            PG8_LDB(B1, 0, 1); PG8_STAGE(PG8_SB(0, 0), b2, voffB);
            PG8_BAR; PG8_WAIT_L(0); PG8_MMA(0, 1, At, B1); PG8_BAR;
            PG8_LDA(At, 0, 1); PG8_STAGE(PG8_SA(0, 0), a2, voffA);
            PG8_BAR; PG8_WAIT_L(0); PG8_MMA(1, 0, At, B0); PG8_BAR; PG8_SCHED;
            PG8_STAGE(PG8_SB(0, 1), b2 + hstep, voffB);
            PG8_WAIT_V(6); PG8_BAR; PG8_MMA(1, 1, At, B1); PG8_BAR;
            PG8_LDB(B0, 1, 0); PG8_SCHED; PG8_LDA(At, 1, 0); PG8_STAGE(PG8_SA(0, 1), a2 + hstep, voffA);
            PG8_WAIT_L(8); PG8_BAR; PG8_WAIT_L(0); PG8_MMA(0, 0, At, B0); PG8_BAR; PG8_SCHED;
            PG8_LDB(B1, 1, 1); PG8_STAGE(PG8_SB(1, 0), b3, voffB);
            PG8_BAR; PG8_WAIT_L(0); PG8_MMA(0, 1, At, B1); PG8_BAR;
            PG8_LDA(At, 1, 1); PG8_STAGE(PG8_SA(1, 0), a3, voffA);
            PG8_BAR; PG8_WAIT_L(0); PG8_MMA(1, 0, At, B0); PG8_BAR; PG8_SCHED;
            PG8_STAGE(PG8_SB(1, 1), b3 + hstep, voffB);
            PG8_WAIT_V(6); PG8_BAR; PG8_MMA(1, 1, At, B1); PG8_BAR;
            }
        }
        if constexpr (ALIGN_EPI) { if (wr == 0) PG8_BAR; }
        if constexpr (!Epi::AFTER_DRAIN) E(acc, cur, wr, wc, fr, fq);
        if (!has_next) break;
#pragma unroll
        for (int a = 0; a < 2; ++a)
#pragma unroll
            for (int b = 0; b < 2; ++b)
#pragma unroll
                for (int m = 0; m < 4; ++m)
#pragma unroll
                    for (int n = 0; n < 2; ++n) acc[a][b][m][n] = (f32x4){0.f, 0.f, 0.f, 0.f};
        cur = nxt; cA = nA; cB = nB; ++ui;
        if constexpr (ALIGN_EPI) { if (wr == 1) PG8_BAR; }
    }
    PG8_WAIT_V(0);
    if constexpr (!ALIGN_EPI) { if (wr == 0) PG8_BAR; }
    PG8_BAR;
    if constexpr (Epi::AFTER_DRAIN) E.fused(acc, cur, wr, wc, fr, fq, lds, wid, lane);
#undef PG8_SA
#undef PG8_SB
#undef PG8_STAGE
#undef PG8_LDA
#undef PG8_LDB
#undef PG8_MMA
#undef PG8_WAIT_V
#undef PG8_WAIT_L
#undef PG8_BAR
#undef PG8_SCHED
}
}

#define XB_TMO      128
#define XB_XCNT(j)  (256  + 64 * (j))
#define XB_XSUB(j)  (1280 + 64 * (j))
#define XB_XGEN(j)  (2304 + 64 * (j))
#define XB_TOP      3328
#define XB_TOPGEN   3392
#define XCD_BAR_WORDS 3456
#define XB_SPIN_CAP (1u << 18)
__device__ __forceinline__ unsigned xb_ld(unsigned* p)              { return __hip_atomic_load(p, __ATOMIC_RELAXED, __HIP_MEMORY_SCOPE_AGENT); }
__device__ __forceinline__ unsigned xb_add(unsigned* p, unsigned v) { return __hip_atomic_fetch_add(p, v, __ATOMIC_RELAXED, __HIP_MEMORY_SCOPE_AGENT); }
__device__ __forceinline__ unsigned xb_xcc_id() { return (unsigned)__builtin_amdgcn_s_getreg((3 << 11) | 20) & 0xFu; }
#define XB_SPIN(cond, bar) do { unsigned _sp = 0; while (cond) { __builtin_amdgcn_s_sleep(1); \
    if ((++_sp & 255u) == 0u) { if (xb_ld(&(bar)[XB_TMO])) break; if (_sp > XB_SPIN_CAP) { atomicAdd(&(bar)[XB_TMO], 1u); break; } } } } while (0)
struct XcdBarrier { unsigned* bar; unsigned x; volatile LAS unsigned* st; };
__device__ __forceinline__ XcdBarrier xcd_barrier_post(unsigned* bar, volatile LAS unsigned* st) {
    XcdBarrier b; b.bar = bar; b.x = xb_xcc_id(); b.st = st;
    if (threadIdx.x == 0) (void)xb_add(&bar[XB_XCNT(b.x)], 1u);
    return b;
}
__device__ __forceinline__ void xcd_barrier_complete(unsigned* bar, unsigned x, unsigned& nloc, unsigned& nx) {
    const unsigned G = gridDim.x * gridDim.y * gridDim.z;
    unsigned sum, cnt, mine, sp = 0u;
    for (;;) {
        sum = 0u; cnt = 0u; mine = 0u;
#pragma unroll
        for (unsigned j = 0; j < 16; ++j) { const unsigned c = xb_ld(&bar[XB_XCNT(j)]); sum += c; cnt += (c > 0u) ? 1u : 0u; mine = (j == x) ? c : mine; }
        if (sum == G) break;
        __builtin_amdgcn_s_sleep(1);
        if ((++sp & 255u) == 0u) { if (xb_ld(&bar[XB_TMO])) break; if (sp > XB_SPIN_CAP) { atomicAdd(&bar[XB_TMO], 1u); break; } }
    }
    nloc = mine > 0u ? mine : 1u; nx = cnt > 0u ? cnt : 1u;
}
__device__ __forceinline__ void xcd_barrier(const XcdBarrier& b, int wave_id) {
    asm volatile("s_waitcnt vmcnt(0)" ::: "memory");
    __syncthreads();
    if (wave_id == 0 && lane_id_fresh() == 0) {
        unsigned* bar = b.bar;
        __builtin_amdgcn_s_waitcnt(0);
        unsigned nloc = b.st[0], nx = b.st[1];
        if (nloc == 0u) { xcd_barrier_complete(bar, b.x, nloc, nx); b.st[0] = nloc; b.st[1] = nx; }
        const unsigned old = xb_add(&bar[XB_XSUB(b.x)], 1u);
        const unsigned gen = old / nloc;
        if (old + 1u == (gen + 1u) * nloc) {
            __builtin_amdgcn_fence(__ATOMIC_RELEASE, "agent");
            asm volatile("s_waitcnt vmcnt(0)" ::: "memory");
            const unsigned og = xb_add(&bar[XB_TOP], 1u);
            const unsigned tg = og / nx;
            if (og + 1u == (tg + 1u) * nx) xb_add(&bar[XB_TOPGEN], 1u);
            else XB_SPIN(xb_ld(&bar[XB_TOPGEN]) == tg, bar);
            __builtin_amdgcn_fence(__ATOMIC_ACQUIRE, "agent");
            xb_add(&bar[XB_XGEN(b.x)], 1u);
            asm volatile("s_waitcnt vmcnt(0)" ::: "memory");
        } else {
            XB_SPIN(xb_ld(&bar[XB_XGEN(b.x)]) == gen, bar);
            __builtin_amdgcn_fence(__ATOMIC_ACQUIRE, "agent");
            asm volatile("s_waitcnt vmcnt(0)" ::: "memory");
        }
    }
    __syncthreads();
}

struct Args { const float* in[N_IN]; float* out; unsigned char* ws; int ph_lo, ph_hi; };
static_assert(sizeof(Args) == N_IN * 8 + 8 + 8 + 8, "Args has no padding");

struct Ctx {
    const float* const* in; float* out; unsigned char* ws;
    LAS unsigned char* lds;
    int tid, lane, wave, gw, ngw, bid, G;
};
#define WSP(T, off) ((T*)(C.ws + (off)))
__device__ __forceinline__ Ctx ctx_fresh(const Ctx& C0) {
    Ctx C = C0; C.lane = lane_id_fresh(); C.tid = C.wave * 64 + C.lane;
    int bid = blockIdx.x, G = gridDim.x; asm volatile("" : "+s"(bid), "+s"(G));
    C.bid = bid; C.G = G; C.gw = bid * 8 + C.wave; C.ngw = G * 8;
    return C;
}

__device__ __forceinline__ int wq_next(unsigned* ctr, int lane) {
    unsigned v = 0;
    if (lane == 0) v = __hip_atomic_fetch_add(ctr, 1u, __ATOMIC_RELAXED, __HIP_MEMORY_SCOPE_AGENT);
    return (int)__builtin_amdgcn_readfirstlane(v);
}

__device__ __forceinline__ void transpose_item(const float* W, int ldw, f16* WT, int ldt, int dst_row0, int k0, int n0, LAS float* scr, int lane) {
    f32x4 wv[8];
#pragma unroll
    for (int i = 0; i < 8; ++i) wv[i] = __builtin_nontemporal_load((const f32x4*)(W + (size_t)(k0 + 8 * i + (lane >> 3)) * ldw + n0 + 4 * (lane & 7)));
#pragma unroll
    for (int i = 0; i < 8; ++i) { LAS float* d = scr + (8 * i + (lane >> 3)) * 33 + 4 * (lane & 7); d[0] = wv[i][0]; d[1] = wv[i][1]; d[2] = wv[i][2]; d[3] = wv[i][3]; }
    asm volatile("s_waitcnt lgkmcnt(0)" ::: "memory");
    const int c = lane & 7;
#pragma unroll
    for (int j = 0; j < 4; ++j) { const int n = (lane >> 3) + 8 * j; const LAS float* s = scr + (8 * c) * 33 + n;
        const f16x8 o = pack8(cvt4(s[0 * 33], s[1 * 33], s[2 * 33], s[3 * 33]), cvt4(s[4 * 33], s[5 * 33], s[6 * 33], s[7 * 33]));
        *(f16x8*)(WT + (size_t)(dst_row0 + n) * ldt + k0 + 8 * c) = o; }
    asm volatile("s_waitcnt lgkmcnt(0)" ::: "memory");
}
__device__ __forceinline__ void phase_prep(const Ctx& C0) {
    const Ctx C = ctx_fresh(C0);
    {
        LAS float* sc = (LAS float*)C.lds;
        LAS float* red = (LAS float*)(C.lds + 20480);
        const float* cv = C.in[I_C]; const float* cctx = C.in[I_CCTX];
        for (int i = C.tid; i < 5 * 1024; i += 512) { const int c = i >> 10, k = i & 1023; const float v = (c < 4) ? cv[c * 1024 + k] : cctx[k]; sc[i] = v / (1.0f + __expf(-v)); }
        __syncthreads();
        float* mod = WSP(float, WS_MOD);
        for (int item = C.bid; item < 2 * 144; item += C.G) {
            const int l = item / 144, j0 = (item % 144) * 64, k0 = C.wave * 128;
            const float* wp = C.in[I_WADA] + ((size_t)l * 1024 + k0) * NMODV + j0 + C.lane;
            float a0 = 0.f, a1 = 0.f, a2 = 0.f, a3 = 0.f, a4 = 0.f;
#pragma unroll 16
            for (int kk = 0; kk < 128; ++kk) {
                const float w = __builtin_nontemporal_load(&wp[(size_t)kk * NMODV]);
                a0 += sc[0 * 1024 + k0 + kk] * w; a1 += sc[1 * 1024 + k0 + kk] * w; a2 += sc[2 * 1024 + k0 + kk] * w; a3 += sc[3 * 1024 + k0 + kk] * w; a4 += sc[4 * 1024 + k0 + kk] * w;
            }
            red[(C.wave * 5 + 0) * 64 + C.lane] = a0; red[(C.wave * 5 + 1) * 64 + C.lane] = a1; red[(C.wave * 5 + 2) * 64 + C.lane] = a2;
            red[(C.wave * 5 + 3) * 64 + C.lane] = a3; red[(C.wave * 5 + 4) * 64 + C.lane] = a4;
            __syncthreads();
            if (C.tid < 320) { const int c = C.tid >> 6, ln = C.tid & 63; float s = 0.f;
#pragma unroll
                for (int w = 0; w < 8; ++w) s += red[(w * 5 + c) * 64 + ln];
                mod[((size_t)l * 5 + c) * NMODV + j0 + ln] = s + C.in[I_BADA][(size_t)l * NMODV + j0 + ln]; }
            __syncthreads();
        }
    }
    __syncthreads();
    {
        LAS float* scr = (LAS float*)(C.lds + C.wave * 16384);
        constexpr int IFI = 16 * 176, IFO = 44 * 32, IIN = 16 * 67, IOUT = 16 * 32;
        constexpr int NIT = 4 * IFI + 4 * IFO + 2 * IIN + 2 * IOUT;
        for (int it = C.gw; it < NIT; it += C.ngw) {
            int r = it;
            if (r < 4 * IFI) { const int mat = r / IFI, rr = r % IFI, kb = rr / 176, n0 = (rr % 176) * 32;
                const int drow = (n0 < DFF) ? ((n0 >> 7) * 256 + (n0 & 127)) : (((n0 - DFF) >> 7) * 256 + 128 + ((n0 - DFF) & 127));
                transpose_item(C.in[I_WFI] + (size_t)mat * 1024 * NFF2, NFF2, WSP(f16, WS_WFI) + (size_t)mat * NFF2 * 1024, 1024, drow, kb * 64, n0, scr, C.lane); continue; }
            r -= 4 * IFI;
            if (r < 4 * IFO) { const int mat = r / IFO, rr = r % IFO, kb = rr / 32, n0 = (rr % 32) * 32;
                transpose_item(C.in[I_WFO] + (size_t)mat * DFF * 1024, 1024, WSP(f16, WS_WFO) + (size_t)mat * 1024 * DFF, DFF, n0, kb * 64, n0, scr, C.lane); continue; }
            r -= 4 * IFO;
            if (r < 2 * IIN) { const int l = r / IIN, rr = r % IIN, kb = rr / 67, n0 = (rr % 67) * 32;
                transpose_item(C.in[I_WIN] + (size_t)l * 1024 * DIN, DIN, WSP(f16, WS_WIN) + (size_t)l * DINP * 1024, 1024, n0, kb * 64, n0, scr, C.lane); continue; }
            r -= 2 * IIN;
            { const int l = r / IOUT, rr = r % IOUT, kb = rr / 32, n0 = (rr % 32) * 32;
                transpose_item(C.in[I_WOUT] + (size_t)l * 1024 * 1024, 1024, WSP(f16, WS_WOUT) + (size_t)l * 1024 * 1024, 1024, n0, kb * 64, n0, scr, C.lane); }
        }
    }
    {
        const int gt = C.bid * 512 + C.tid, ngt = C.G * 512;
        for (int i = gt; i < 2 * 160 * 128; i += ngt) { const int l = i / (160 * 128), rr = i % (160 * 128);
            unsigned z = 0u; asm volatile("" : "+v"(z));
            *(u32x4*)(WSP(f16, WS_WIN) + ((size_t)l * DINP + DIN) * 1024 + (size_t)rr * 8) = (u32x4){z, z, z, z}; }
        f16* wuq = WSP(f16, WS_WUQ);
        for (int i = gt; i < 2 * 384 * 192; i += ngt) { const int e = i & 7, r = (i >> 3) & 31, rest = i >> 8, c = rest % 24, rest2 = rest / 24, t3 = rest2 % 3, lh = rest2 / 3, l = lh >> 2, hd = lh & 3;
            wuq[i] = (f16)(C.in[I_CQN][l * 192 + 8 * c + e] * C.in[I_WUQ][(size_t)l * 192 * 384 + (size_t)(8 * c + e) * 384 + hd * 96 + 32 * t3 + r]); }
        f16* wukv = WSP(f16, WS_WUKV);
        for (int i = gt; i < 2 * 512 * 128; i += ngt) { const int e = i & 7, r = (i >> 3) & 31, rest = i >> 8, c = rest & 15, rest2 = rest >> 4, t4 = rest2 & 3, lh = rest2 >> 2, l = lh >> 2, hd = lh & 3;
            const float w = C.in[I_WUKV][(size_t)l * 128 * 512 + (size_t)(8 * c + e) * 512 + hd * 128 + 32 * t4 + r];
            wukv[i] = (f16)(C.in[I_CKVN][l * 128 + 8 * c + e] * w); WSP(f16, WS_WUKV0)[i] = (f16)w; }
        for (int i = gt; i < 4096; i += ngt) WSP(f16, WS_IDN)[i] = ((i >> 6) == (i & 63)) ? (f16)1.0f : (f16)0.0f;
        f16* wg = WSP(f16, WS_WG);
        for (int i = gt; i < 64 * 4096; i += ngt) { const int m = i >> 12, d = (i >> 6) & 63, c = i & 63; wg[i] = (f16)C.in[I_WGATE][(size_t)m * 4096 + c * 64 + d]; }
    }
}

template <bool FIRST>
__device__ __forceinline__ void phase_norm(const Ctx& C0, int l, int sub) {
    const Ctx C = ctx_fresh(C0);
    const float* gvec = C.in[I_NG] + ((size_t)l * 3 + sub) * DM;
    const float* modl = WSP(float, WS_MOD) + (size_t)l * 5 * NMODV;
    f16* H = WSP(f16, WS_H);
    for (int row = C.gw; row < M; row += C.ngw) {
        const float* src = FIRST ? ((row < MP) ? C.in[I_XP] + (size_t)row * DM : C.in[I_XS] + (size_t)(row - MP) * DM) : C.out + (size_t)row * DM;
        const int cond = (row < MP) ? 4 : ((row - MP) >> 11);
        const float* shp = modl + (size_t)cond * NMODV + (3 * sub) * DM; const float* scp = shp + DM;
        f32x4 v[4]; float ss = 0.f;
#pragma unroll
        for (int j = 0; j < 4; ++j) { v[j] = FIRST ? __builtin_nontemporal_load((const f32x4*)(src + 256 * j + 4 * C.lane)) : *(const f32x4*)(src + 256 * j + 4 * C.lane); ss += (v[j].x * v[j].x + v[j].y * v[j].y) + (v[j].z * v[j].z + v[j].w * v[j].w); }
        const float rstd = 1.0f / sqrtf(wave_sum(ss) * (1.0f / DM) + EPS);
        f32x4 gs[4], shv[4];
#pragma unroll
        for (int j = 0; j < 4; ++j) { const int k = 256 * j + 4 * C.lane; gs[j] = *(const f32x4*)(gvec + k) * (*(const f32x4*)(scp + k) + 1.0f); shv[j] = *(const f32x4*)(shp + k); }
#pragma unroll
        for (int j = 0; j < 4; ++j) {
            const int k = 256 * j + 4 * C.lane;
            *(f16x4*)(H + (size_t)row * DM + k) = cvt4v(v[j] * rstd * gs[j] + shv[j]);
            if (FIRST) *(f16x4*)(WSP(f16, WS_XH) + (size_t)row * DM + k) = cvt4v(v[j]);
        }
    }
}

__device__ __forceinline__ void glds16(const void* gsrc, unsigned lds_dst) { unsigned keep;
    asm volatile("s_mov_b32 %0, m0\n\ts_mov_b32 m0, %2\n\ts_nop 0\n\tglobal_load_lds_dwordx4 %1, off\n\ts_mov_b32 m0, %0" : "=&s"(keep) : "v"(gsrc), "s"(lds_dst) : "memory"); }
#define ATT_GLDS(g, l) glds16((const void*)(g), (unsigned)__builtin_amdgcn_readfirstlane((unsigned)(uintptr_t)(l)))
#define ATT_WAITBAR(N) asm volatile("s_waitcnt vmcnt(" #N ") lgkmcnt(0)\n\ts_barrier" ::: "memory")
#define ATT_LBAR() asm volatile("s_waitcnt lgkmcnt(0)\n\ts_barrier" ::: "memory")
struct MxTok { int b, t, key, ktile, kin; size_t row, ob; };
template <int KIND>
__device__ __forceinline__ MxTok mx_decode(int wt, int tok, int l) {
    MxTok m; m.row = 0;
    if (KIND == 0) { m.row = (size_t)wt * 32 + tok; m.b = (int)(m.row >> 8); m.t = (int)(m.row & 255); m.key = m.t; }
    else if (KIND == 1) { m.row = (size_t)wt * 32 + tok; const int rs = (int)m.row - MP; m.b = rs >> 11; m.t = rs & 2047; m.key = PAST + m.t; }
    else { const int idx = (wt - 512) * 32 + tok; m.b = idx >> 9; m.t = idx & 511; m.key = m.t; }
    m.ktile = m.key >> 6; m.kin = m.key & 63; m.ob = ((size_t)m.b * 2 + l) * TP + m.t;
    return m;
}
template <int KIND>
__device__ __forceinline__ void mx_rope(int t, int hi, float (&cr)[4], float (&sr)[4], float (&cc)[4], float (&scn)[4]) {
#pragma unroll
    for (int e = 0; e < 4; ++e) { cr[e] = 1.f; sr[e] = 0.f; cc[e] = 1.f; scn[e] = 0.f; }
    if (KIND == 1) {
        const float gr = (float)(t >> 6), gc = (float)(t & 63);
#pragma unroll
        for (int e = 0; e < 4; ++e) { const float inv = exp2f(-(float)(4 * hi + e) * (13.287712379549449f / 8.0f));
            const float fr = gr * inv * 0.15915494309189535f, fc = gc * inv * 0.15915494309189535f;
            sr[e] = __builtin_amdgcn_sinf(fr); cr[e] = __builtin_amdgcn_cosf(fr); scn[e] = __builtin_amdgcn_sinf(fc); cc[e] = __builtin_amdgcn_cosf(fc); }
    }
}
template <int KIND, int SUB>
__device__ __forceinline__ void mx_a(const Ctx& C, int l, int wt) {
    const int lane = lane_id_fresh(), tok = lane & 31, hi = lane >> 5;
    constexpr int Tk = (KIND == 0) ? TP : TKS, NT = Tk / 64;
    const MxTok m = mx_decode<KIND>(wt, tok, l);
    const f16* prow = WSP(f16, WS_ACT) + m.row * DINP;
    f16* KA = (KIND == 0) ? WSP(f16, WS_KAP) : WSP(f16, WS_KAS);
    f16* VA = (KIND == 0) ? WSP(f16, WS_VATP) : WSP(f16, WS_VATS);
    if (SUB < 2) {
        if (KIND != 2) {
            constexpr int qk = SUB;
            float cr[4], sr[4], cc[4], scn[4];
            mx_rope<KIND>(m.t, hi, cr, sr, cc, scn);
            f32x4 gain[4];
#pragma unroll
            for (int g = 0; g < 4; ++g) gain[g] = *(const f32x4*)(C.in[I_DQKN] + ((size_t)l * 2 + qk) * 32 + 8 * g + 4 * hi);
            f16x4 raw[8][4];
#pragma unroll
            for (int hc = 0; hc < 8; ++hc)
#pragma unroll
                for (int g = 0; g < 4; ++g) raw[hc][g] = *(const f16x4*)(prow + (qk ? PC_KA : PC_QA) + hc * 32 + 4 * hi + 8 * g);
#pragma unroll
            for (int hc = 0; hc < 8; ++hc) {
                f32x4 x[4]; float ss = 0.f;
#pragma unroll
                for (int g = 0; g < 4; ++g) { x[g] = tof32(raw[hc][g]); ss += (x[g].x * x[g].x + x[g].y * x[g].y) + (x[g].z * x[g].z + x[g].w * x[g].w); }
                ss += __shfl_xor(ss, 32);
                const float rstd = 1.0f / sqrtf(ss * (1.0f / 32.0f) + EPS);
#pragma unroll
                for (int g = 0; g < 4; ++g) x[g] = x[g] * rstd * gain[g];
                if (qk == 1 && KIND == 0) {
                    float* o = C.out + OUT_DK + m.ob * 256 + hc * 32 + 4 * hi;
#pragma unroll
                    for (int g = 0; g < 4; ++g) *(f32x4*)(o + 8 * g) = x[g];
                }
                if (KIND == 1) {
#pragma unroll
                    for (int e = 0; e < 4; ++e) {
                        const float a1 = x[0][e], a2 = x[2][e]; x[0][e] = a1 * cr[e] - a2 * sr[e]; x[2][e] = a2 * cr[e] + a1 * sr[e];
                        const float b1 = x[1][e], b2 = x[3][e]; x[1][e] = b1 * cc[e] - b2 * scn[e]; x[3][e] = b2 * cc[e] + b1 * scn[e];
                    }
                }
                if (qk == 0) {
                    const float sc = 0.17677669529663687f * LOG2E;
                    f16* o = WSP(f16, WS_QA) + m.row * 256 + hc * 32 + 4 * hi;
#pragma unroll
                    for (int g = 0; g < 4; ++g) *(f16x4*)(o + 8 * g) = cvt4v(x[g] * sc);
                } else {
                    f16* o = KA + ((((size_t)m.b * 4 + (hc >> 1)) * NT + m.ktile) * 8 + (hc & 1) * 4) * 512 + m.kin * 8 + 4 * hi;
#pragma unroll
                    for (int g = 0; g < 4; ++g) *(f16x4*)(o + g * 512) = cvt4v(x[g]);
                }
            }
        } else if (SUB == 1) {
            const float* ck = C.in[I_CDK] + (((size_t)m.b * 2 + l) * PAST + m.t) * 256;
            f32x4 raw[8][4];
#pragma unroll
            for (int hc = 0; hc < 8; ++hc)
#pragma unroll
                for (int g = 0; g < 4; ++g) raw[hc][g] = *(const f32x4*)(ck + hc * 32 + 4 * hi + 8 * g);
#pragma unroll
            for (int hc = 0; hc < 8; ++hc) {
                f16* o = KA + ((((size_t)m.b * 4 + (hc >> 1)) * NT + m.ktile) * 8 + (hc & 1) * 4) * 512 + m.kin * 8 + 4 * hi;
#pragma unroll
                for (int g = 0; g < 4; ++g) *(f16x4*)(o + g * 512) = cvt4v(raw[hc][g]);
            }
        }
    } else {
        if (KIND != 2) {
            f16x8 rawv[4][4];
#pragma unroll
            for (int hd = 0; hd < 4; ++hd)
#pragma unroll
                for (int j = 0; j < 4; ++j) rawv[hd][j] = *(const f16x8*)(prow + PC_VA + hd * 64 + 32 * hi + 8 * j);
#pragma unroll
            for (int hd = 0; hd < 4; ++hd) {
                f16* vt = VA + ((((size_t)m.b * 4 + hd) * NT + m.ktile) * 2 + hi) * 2048 + m.kin * 32;
#pragma unroll
                for (int j = 0; j < 4; ++j) {
                    const f16x8 v = rawv[hd][j];
                    if (KIND == 0) {
                        float* o = C.out + OUT_DV + m.ob * 256 + hd * 64 + 32 * hi + 8 * j;
                        *(f32x4*)o = (f32x4){(float)v[0], (float)v[1], (float)v[2], (float)v[3]}; *(f32x4*)(o + 4) = (f32x4){(float)v[4], (float)v[5], (float)v[6], (float)v[7]};
                    }
                    *(f16x8*)(vt + 8 * j) = v;
                }
            }
        } else {
            const float* cvp = C.in[I_CDV] + (((size_t)m.b * 2 + l) * PAST + m.t) * 256;
#pragma unroll
            for (int hd = 0; hd < 4; ++hd) {
                f16* vt = VA + ((((size_t)m.b * 4 + hd) * NT + m.ktile) * 2 + hi) * 2048 + m.kin * 32;
                f32x4 rawc[8];
#pragma unroll
                for (int j = 0; j < 8; ++j) rawc[j] = *(const f32x4*)(cvp + hd * 64 + 32 * hi + 4 * j);
#pragma unroll
                for (int j = 0; j < 8; ++j) *(f16x4*)(vt + 4 * j) = cvt4v(rawc[j]);
            }
        }
    }
}
template <int KIND>
__device__ __forceinline__ void mx_q(const Ctx& C, int l, int wt, int hd, LAS unsigned char* wl) {
    const int lane = lane_id_fresh(), tok = lane & 31, hi = lane >> 5;
    const MxTok m = mx_decode<KIND>(wt, tok, l);
    const f16* prow = WSP(f16, WS_ACT) + m.row * DINP;
    float cr[4], sr[4], cc[4], scn[4];
    mx_rope<KIND>(m.t, hi, cr, sr, cc, scn);
    f16x8 bq[12]; float ss = 0.f;
#pragma unroll
    for (int ks = 0; ks < 12; ++ks) { bq[ks] = *(const f16x8*)(prow + PC_CQ + 16 * ks + 8 * hi);
#pragma unroll
        for (int e = 0; e < 8; ++e) { const float f = (float)bq[ks][e]; ss += f * f; } }
    ss += __shfl_xor(ss, 32);
    const float rstd = 1.0f / sqrtf(ss * (1.0f / 192.0f) + EPS);
    const float* gq = C.in[I_QKN] + ((size_t)l * 2 + 0) * 96;
    f32x4 gqv[3][4];
#pragma unroll
    for (int t3 = 0; t3 < 3; ++t3)
#pragma unroll
        for (int g = 0; g < 4; ++g) gqv[t3][g] = *(const f32x4*)(gq + 32 * t3 + 8 * g + 4 * hi);
    ATT_WAITBAR(0);
    LAS unsigned char* wp = wl + hi * 512 + tok * 16;
    f32x16 acc[3];
#pragma unroll
    for (int t3 = 0; t3 < 3; ++t3) { acc[t3] = (f32x16){};
#pragma unroll
        for (int ks = 0; ks < 12; ++ks) acc[t3] = MFMA32(*(const LAS f16x8*)(wp + (t3 * 24 + 2 * ks) * 512), bq[ks], acc[t3]); }
    float s2 = 0.f;
#pragma unroll
    for (int t3 = 0; t3 < 3; ++t3)
#pragma unroll
        for (int r = 0; r < 16; ++r) s2 += acc[t3][r] * acc[t3][r];
    s2 += __shfl_xor(s2, 32);
    const float rs = rstd / sqrtf(s2 * (rstd * rstd) * (1.0f / 96.0f) + EPS);
#pragma unroll
    for (int t3 = 0; t3 < 3; ++t3)
#pragma unroll
        for (int g = 0; g < 4; ++g) { const f32x4 gg = gqv[t3][g];
#pragma unroll
            for (int e = 0; e < 4; ++e) acc[t3][4 * g + e] *= rs * gg[e]; }
    if (KIND == 1) {
#pragma unroll
        for (int e = 0; e < 4; ++e) {
            const float a1 = acc[2][e], a2 = acc[2][8 + e]; acc[2][e] = a1 * cr[e] - a2 * sr[e]; acc[2][8 + e] = a2 * cr[e] + a1 * sr[e];
            const float b1 = acc[2][4 + e], b2 = acc[2][12 + e]; acc[2][4 + e] = b1 * cc[e] - b2 * scn[e]; acc[2][12 + e] = b2 * cc[e] + b1 * scn[e];
        }
    }
    const float sc = 0.10206207261596575f * LOG2E;
    f16* o = WSP(f16, WS_QC) + m.row * 384 + hd * 96 + 4 * hi;
#pragma unroll
    for (int t3 = 0; t3 < 3; ++t3)
#pragma unroll
        for (int g = 0; g < 4; ++g) *(f16x4*)(o + 32 * t3 + 8 * g) = cvt4(acc[t3][4 * g] * sc, acc[t3][4 * g + 1] * sc, acc[t3][4 * g + 2] * sc, acc[t3][4 * g + 3] * sc);
}
template <int KIND>
__device__ __forceinline__ void mx_kv(const Ctx& C, int l, int wt, int hd, LAS unsigned char* wl) {
    const int lane = lane_id_fresh(), tok = lane & 31, hi = lane >> 5;
    constexpr int Tk = (KIND == 0) ? TP : TKS, NT = Tk / 64;
    const MxTok m = mx_decode<KIND>(wt, tok, l);
    const f16* prow = WSP(f16, WS_ACT) + m.row * DINP;
    f16* KC = (KIND == 0) ? WSP(f16, WS_KCP) : WSP(f16, WS_KCS);
    f16* VC = (KIND == 0) ? WSP(f16, WS_VCTP) : WSP(f16, WS_VCTS);
    float cr[4], sr[4], cc[4], scn[4];
    mx_rope<KIND>(m.t, hi, cr, sr, cc, scn);
    f16x8 bk[8]; f32x4 kr[4]; float rstd = 1.0f;
    if (KIND != 2) {
        float ss = 0.f;
#pragma unroll
        for (int ks = 0; ks < 8; ++ks) { bk[ks] = *(const f16x8*)(prow + PC_CKV + 16 * ks + 8 * hi);
#pragma unroll
            for (int e = 0; e < 8; ++e) { const float f = (float)bk[ks][e]; ss += f * f; } }
        ss += __shfl_xor(ss, 32);
        rstd = 1.0f / sqrtf(ss * (1.0f / 128.0f) + EPS);
        if (KIND == 0 && hd == 0) {
            f32x4 gv0[8], gv1[8];
#pragma unroll
            for (int ks = 0; ks < 8; ++ks) { gv0[ks] = *(const f32x4*)(C.in[I_CKVN] + (size_t)l * 128 + 16 * ks + 8 * hi); gv1[ks] = *(const f32x4*)(C.in[I_CKVN] + (size_t)l * 128 + 16 * ks + 8 * hi + 4); }
#pragma unroll
            for (int ks = 0; ks < 8; ++ks) {
                const f32x4 g0 = gv0[ks], g1 = gv1[ks];
                const f16x8 v = bk[ks];
                float* o = C.out + OUT_CKV + m.ob * 128 + 16 * ks + 8 * hi;
                *(f32x4*)o = (f32x4){(float)v[0] * rstd * g0[0], (float)v[1] * rstd * g0[1], (float)v[2] * rstd * g0[2], (float)v[3] * rstd * g0[3]};
                *(f32x4*)(o + 4) = (f32x4){(float)v[4] * rstd * g1[0], (float)v[5] * rstd * g1[1], (float)v[6] * rstd * g1[2], (float)v[7] * rstd * g1[3]};
            }
        }
#pragma unroll
        for (int g = 0; g < 4; ++g) kr[g] = tof32(*(const f16x4*)(prow + PC_KR + 8 * g + 4 * hi));
        if (KIND == 0 && hd == 0) { float* o = C.out + OUT_KR + m.ob * 32 + 4 * hi;
#pragma unroll
            for (int g = 0; g < 4; ++g) *(f32x4*)(o + 8 * g) = kr[g]; }
    } else {
        const float* cp = C.in[I_CCKV] + (((size_t)m.b * 2 + l) * PAST + m.t) * 128;
#pragma unroll
        for (int ks = 0; ks < 8; ++ks) bk[ks] = pack8(cvt4v(*(const f32x4*)(cp + 16 * ks + 8 * hi)), cvt4v(*(const f32x4*)(cp + 16 * ks + 8 * hi + 4)));
        const float* kp = C.in[I_CKR] + (((size_t)m.b * 2 + l) * PAST + m.t) * 32;
#pragma unroll
        for (int g = 0; g < 4; ++g) kr[g] = *(const f32x4*)(kp + 8 * g + 4 * hi);
    }
    float skr = 0.f;
#pragma unroll
    for (int g = 0; g < 4; ++g) skr += (kr[g].x * kr[g].x + kr[g].y * kr[g].y) + (kr[g].z * kr[g].z + kr[g].w * kr[g].w);
    const float* gk = C.in[I_QKN] + ((size_t)l * 2 + 1) * 96;
    f32x4 gkv[3][4];
#pragma unroll
    for (int t3 = 0; t3 < 3; ++t3)
#pragma unroll
        for (int g = 0; g < 4; ++g) gkv[t3][g] = *(const f32x4*)(gk + 32 * t3 + 8 * g + 4 * hi);
    ATT_WAITBAR(0);
    LAS unsigned char* wp = wl + hi * 512 + tok * 16;
    f32x16 acc[2];
#pragma unroll
    for (int t4 = 0; t4 < 2; ++t4) { acc[t4] = (f32x16){};
#pragma unroll
        for (int ks = 0; ks < 8; ++ks) acc[t4] = MFMA32(*(const LAS f16x8*)(wp + (t4 * 16 + 2 * ks) * 512), bk[ks], acc[t4]); }
    float s2 = 0.f;
#pragma unroll
    for (int t4 = 0; t4 < 2; ++t4)
#pragma unroll
        for (int r = 0; r < 16; ++r) s2 += acc[t4][r] * acc[t4][r];
    s2 = s2 * (rstd * rstd) + skr;
    s2 += __shfl_xor(s2, 32);
    const float rs = 1.0f / sqrtf(s2 * (1.0f / 96.0f) + EPS), rsn = rs * rstd;
    f16* ko = KC + ((((size_t)m.b * 4 + hd) * NT + m.ktile) * 12) * 512 + m.kin * 8 + 4 * hi;
#pragma unroll
    for (int t4 = 0; t4 < 2; ++t4)
#pragma unroll
        for (int g = 0; g < 4; ++g) { const f32x4 gg = gkv[t4][g];
            *(f16x4*)(ko + (4 * t4 + g) * 512) = cvt4(acc[t4][4 * g] * rsn * gg[0], acc[t4][4 * g + 1] * rsn * gg[1], acc[t4][4 * g + 2] * rsn * gg[2], acc[t4][4 * g + 3] * rsn * gg[3]); }
    f32x4 kn[4];
#pragma unroll
    for (int g = 0; g < 4; ++g) kn[g] = kr[g] * rs * gkv[2][g];
    if (KIND == 1) {
#pragma unroll
        for (int e = 0; e < 4; ++e) {
            const float a1 = kn[0][e], a2 = kn[2][e]; kn[0][e] = a1 * cr[e] - a2 * sr[e]; kn[2][e] = a2 * cr[e] + a1 * sr[e];
            const float b1 = kn[1][e], b2 = kn[3][e]; kn[1][e] = b1 * cc[e] - b2 * scn[e]; kn[3][e] = b2 * cc[e] + b1 * scn[e];
        }
    }
#pragma unroll
    for (int g = 0; g < 4; ++g) *(f16x4*)(ko + (8 + g) * 512) = cvt4v(kn[g]);
    f16* vo = VC + ((((size_t)m.b * 4 + hd) * NT + m.ktile) * 2) * 2048 + m.kin * 32 + 4 * hi;
#pragma unroll
    for (int t4 = 2; t4 < 4; ++t4) {
        f32x16 av = (f32x16){};
#pragma unroll
        for (int ks = 0; ks < 8; ++ks) av = MFMA32(*(const LAS f16x8*)(wp + (t4 * 16 + 2 * ks) * 512), bk[ks], av);
#pragma unroll
        for (int g = 0; g < 4; ++g) *(f16x4*)(vo + (t4 - 2) * 2048 + 8 * g) = cvt4(av[4 * g] * rstd, av[4 * g + 1] * rstd, av[4 * g + 2] * rstd, av[4 * g + 3] * rstd);
    }
}

template <int DIR, bool PASS2>
__device__ __forceinline__ void lru_dir(const Ctx& C, int l, int ch, int n, const f16x8 (&bx)[2][4], int b, int T, int cidx, int seqch0, bool prompt, int row0, int lane) {
    const int l31 = lane & 31, hi = lane >> 5;
    const f16* wg = WSP(f16, WS_WG);
    const f16* PROJ = WSP(f16, WS_ACT);
    float* SUM = WSP(float, WS_SUM);
    f16* OC = WSP(f16, WS_OCAT);
    const int nch = T >> 6;
    float bg0[2], bg1[2], spl[2], hc[2], At[2], Bt[2];
#pragma unroll
    for (int t2 = 0; t2 < 2; ++t2) {
        const int chn = 64 * n + 32 * t2 + l31;
        bg0[t2] = C.in[I_BGATE][((size_t)(l * 2 + DIR) * 2 + 0) * 512 + chn]; bg1[t2] = C.in[I_BGATE][((size_t)(l * 2 + DIR) * 2 + 1) * 512 + chn];
        spl[t2] = -8.0f * LOG2E * log1pf(__expf(-C.in[I_LLAM][(size_t)(l * 2 + DIR) * 512 + chn]));
        At[t2] = 1.0f; Bt[t2] = 0.0f; hc[t2] = 0.0f;
    }
    if (PASS2) {
        const int cnt = (DIR == 0) ? cidx : (nch - 1 - cidx), m = (cnt + 1) >> 1;
        const int lo = hi ? m : 0, up = hi ? cnt : m;
        float A0 = 1.f, B0 = 0.f, A1 = 1.f, B1 = 0.f;
#pragma unroll 1
        for (int ib = lo; ib < up; ib += 8) {
            float a0[8], b0[8], a1[8], b1[8];
#pragma unroll
            for (int k = 0; k < 8; ++k) {
                const int i = (ib + k < up) ? ib + k : up - 1, j = (DIR == 0) ? i : (nch - 1 - i);
                const float* p = SUM + ((((size_t)(seqch0 + j)) * 8 + n) * 2 + DIR) * 128 + l31;
                a0[k] = p[0]; b0[k] = p[64]; a1[k] = p[32]; b1[k] = p[96];
            }
#pragma unroll
            for (int k = 0; k < 8; ++k) if (ib + k < up) { B0 = a0[k] * B0 + b0[k]; A0 *= a0[k]; B1 = a1[k] * B1 + b1[k]; A1 *= a1[k]; }
        }
        {
            const float pa0 = __shfl_xor(A0, 32), pb0 = __shfl_xor(B0, 32), pa1 = __shfl_xor(A1, 32), pb1 = __shfl_xor(B1, 32);
            const float fa0 = hi ? pa0 : A0, fb0 = hi ? pb0 : B0, sa0 = hi ? A0 : pa0, sb0 = hi ? B0 : pb0;
            const float fa1 = hi ? pa1 : A1, fb1 = hi ? pb1 : B1, sa1 = hi ? A1 : pa1, sb1 = hi ? B1 : pb1;
            float h00 = 0.f, h01 = 0.f;
            if (!prompt) { const float* st = C.in[I_ST] + (((size_t)b * 2 + l) * 2 + DIR) * 512 + 64 * n + l31; h00 = st[0]; h01 = st[32]; }
            hc[0] = sa0 * (fa0 * h00 + fb0) + sb0; hc[1] = sa1 * (fa1 * h01 + fb1) + sb1;
        }
    }
    const f16* idp = WSP(f16, WS_IDN);
    __builtin_amdgcn_sched_barrier(0);
#pragma unroll
    for (int t2 = 0; t2 < 2; ++t2) {
        f16x8 w0[4], w1[4], idn[4];
#pragma unroll
        for (int ks = 0; ks < 4; ++ks) {
            w0[ks] = *(const f16x8*)(wg + ((((size_t)(l * 2 + DIR) * 2 + 0) * 8 + n) * 64 + 32 * t2 + l31) * 64 + 16 * ks + 8 * hi);
            w1[ks] = *(const f16x8*)(wg + ((((size_t)(l * 2 + DIR) * 2 + 1) * 8 + n) * 64 + 32 * t2 + l31) * 64 + 16 * ks + 8 * hi);
            idn[ks] = *(const f16x8*)(idp + (32 * t2 + l31) * 64 + 16 * ks + 8 * hi);
        }
#pragma unroll
        for (int sci = 0; sci < 2; ++sci) {
            const int sc = DIR ? 1 - sci : sci;
            f32x16 g0 = (f32x16){}, g1 = (f32x16){}, X = (f32x16){};
#pragma unroll
            for (int ks = 0; ks < 4; ++ks) { g0 = MFMA32(bx[sc][ks], w0[ks], g0); g1 = MFMA32(bx[sc][ks], w1[ks], g1); X = MFMA32(bx[sc][ks], idn[ks], X); }
#pragma unroll
            for (int r = 0; r < 16; ++r) {
                const float rr = sigmoidf_(g0[r] + bg0[t2]), ii = sigmoidf_(g1[r] + bg1[t2]);
                const float a = fexp2(rr * spl[t2]);
                g0[r] = a; g1[r] = __builtin_amdgcn_sqrtf(fmaxf(1.0f - a * a, 0.f)) * (ii * X[r]);
            }
            float As[4], Bs[4], Ap[4], Bp[4];
#pragma unroll
            for (int g = 0; g < 4; ++g) {
                float pa = 1.f, pb = 0.f;
#pragma unroll
                for (int ee = 0; ee < 4; ++ee) { const int e = DIR ? 3 - ee : ee; pb = g0[4 * g + e] * pb + g1[4 * g + e]; pa *= g0[4 * g + e]; }
                As[g] = pa; Bs[g] = pb; Ap[g] = __shfl_xor(pa, 32); Bp[g] = __shfl_xor(pb, 32);
            }
            float h = hc[t2];
#pragma unroll
            for (int gi = 0; gi < 4; ++gi) {
                const int g = DIR ? 3 - gi : gi;
                const bool mine_first = DIR ? (hi == 1) : (hi == 0);
                const float fa = mine_first ? As[g] : Ap[g], fb = mine_first ? Bs[g] : Bp[g], sa = mine_first ? Ap[g] : As[g], sb = mine_first ? Bp[g] : Bs[g];
                const float mid = fa * h + fb;
                float hh = mine_first ? h : mid;
                if (PASS2) {
#pragma unroll
                    for (int ee = 0; ee < 4; ++ee) { const int e = DIR ? 3 - ee : ee; hh = g0[4 * g + e] * hh + g1[4 * g + e]; g1[4 * g + e] = hh; }
                }
                h = sa * mid + sb;
                if (!PASS2) { Bt[t2] = sa * (fa * Bt[t2] + fb) + sb; At[t2] *= fa * sa; }
            }
            hc[t2] = h;
            if (PASS2) {
                f16* op = OC + (size_t)(row0 + 32 * sc + 4 * hi) * DM + 256 + 64 * n + 32 * t2 + l31;
                if (DIR == 0) {
#pragma unroll
                    for (int r = 0; r < 16; ++r) op[(size_t)((r & 3) + 8 * (r >> 2)) * DM] = (f16)g1[r];
                } else {
                    f32x16 G = (f32x16){};
#pragma unroll
                    for (int ks = 0; ks < 4; ++ks) {
                        const f16x8 gbf = *(const f16x8*)(PROJ + (size_t)(row0 + 32 * sc + l31) * DINP + PC_GB + 64 * n + 16 * ks + 8 * hi);
                        G = MFMA32(gbf, idn[ks], G);
                    }
                    float hfv[16];
#pragma unroll
                    for (int r = 0; r < 16; ++r) hfv[r] = (float)op[(size_t)((r & 3) + 8 * (r >> 2)) * DM];
#pragma unroll
                    for (int r = 0; r < 16; ++r) {
                        f16* q = op + (size_t)((r & 3) + 8 * (r >> 2)) * DM;
                        const float hf = hfv[r];
                        const float x = G[r], u = 0.7978845608028654f * (x + 0.044715f * x * x * x);
                        const float th = 1.0f - 2.0f * frcp(1.0f + fexp2(2.0f * u * LOG2E));
                        *q = (f16)((hf + g1[r]) * (0.5f * x * (1.0f + th)));
                    }
                }
            }
            FENCE(); __builtin_amdgcn_sched_barrier(0);
        }
    }
    if (!PASS2) {
        if (hi == 0) { float* sa = SUM + ((((size_t)ch) * 8 + n) * 2 + DIR) * 128 + l31; sa[0] = At[0]; sa[64] = Bt[0]; sa[32] = At[1]; sa[96] = Bt[1]; }
    } else if (prompt) {
        const bool fin = (DIR == 0) ? (cidx == nch - 1) : (cidx == 0);
        if (fin && hi == 0) { float* o = C.out + OUT_ST + (((size_t)b * 2 + l) * 2 + DIR) * 512 + 64 * n + l31; o[0] = hc[0]; o[32] = hc[1]; }
    }
}
template <bool PASS2>
__device__ __forceinline__ void lru_item(const Ctx& C, int l, int ch, int n) {
    const int lane = lane_id_fresh(), l31 = lane & 31, hi = lane >> 5;
    const f16* PROJ = WSP(f16, WS_ACT);
    const int row0 = ch * 64;
    const bool prompt = row0 < MP;
    int b, t0, T, seqrow0;
    if (prompt) { b = row0 >> 8; t0 = row0 & 255; T = TP; seqrow0 = b * TP; } else { const int rs = row0 - MP; b = rs >> 11; t0 = rs & 2047; T = TS; seqrow0 = MP + b * TS; }
    const int cidx = t0 >> 6, seqch0 = seqrow0 >> 6;
    f16x8 bx[2][4];
    f16x8* xcbuf = WSP(f16x8, WS_XC) + ((size_t)(ch * 8 + n) * 8) * 64 + lane;
    if (PASS2) {
#pragma unroll
        for (int sc = 0; sc < 2; ++sc)
#pragma unroll
            for (int ks = 0; ks < 4; ++ks) bx[sc][ks] = xcbuf[(sc * 4 + ks) * 64];
    } else
#pragma unroll
    for (int ks = 0; ks < 4; ++ks) {
        int chn = 64 * n + 16 * ks + 8 * hi; asm volatile("" : "+v"(chn));
        f32x4 w0[4], w1[4];
#pragma unroll
        for (int j = 0; j < 4; ++j) { w0[j] = *(const f32x4*)(C.in[I_CONVW] + ((size_t)l * 4 + j) * 512 + chn); w1[j] = *(const f32x4*)(C.in[I_CONVW] + ((size_t)l * 4 + j) * 512 + chn + 4); }
        const f32x4 c0 = *(const f32x4*)(C.in[I_CONVB] + (size_t)l * 512 + chn), c1 = *(const f32x4*)(C.in[I_CONVB] + (size_t)l * 512 + chn + 4);
#pragma unroll
        for (int sc = 0; sc < 2; ++sc) {
            const int t = t0 + 32 * sc + l31;
            f16x8 v[4]; float wm[4];
#pragma unroll
            for (int j = 0; j < 4; ++j) { const int tt = t + j - 2; const bool ok = (tt >= 0 && tt < T); wm[j] = ok ? 1.0f : 0.0f;
                v[j] = *(const f16x8*)(PROJ + (size_t)(seqrow0 + (ok ? tt : t)) * DINP + PC_XB + chn); }
            f32x4 a0 = c0, a1 = c1;
#pragma unroll
            for (int j = 0; j < 4; ++j) { a0 += (w0[j] * wm[j]) * (f32x4){(float)v[j][0], (float)v[j][1], (float)v[j][2], (float)v[j][3]}; a1 += (w1[j] * wm[j]) * (f32x4){(float)v[j][4], (float)v[j][5], (float)v[j][6], (float)v[j][7]}; }
            bx[sc][ks] = pack8(cvt4v(a0), cvt4v(a1));
            xcbuf[(sc * 4 + ks) * 64] = bx[sc][ks];
        }
        FENCE(); __builtin_amdgcn_sched_barrier(0);
    }
    __builtin_amdgcn_sched_barrier(0);
    lru_dir<0, PASS2>(C, l, ch, n, bx, b, T, cidx, seqch0, prompt, row0, lane);
    FENCE(); __builtin_amdgcn_sched_barrier(0);
    lru_dir<1, PASS2>(C, l, ch, n, bx, b, T, cidx, seqch0, prompt, row0, lane);
}

constexpr int ATT_SLOT = 20480, ATT_VOFF = 12288;
constexpr float ATT_THR = 8.0f;
typedef short v4i16_t __attribute__((ext_vector_type(4)));
__device__ __forceinline__ f16x4 lds_tr(LAS unsigned char* p) { return __builtin_bit_cast(f16x4, __builtin_amdgcn_ds_read_tr16_b64_v4i16((LAS v4i16_t*)p)); }
template <int TYPE>
__device__ __forceinline__ void attn_unit(const Ctx& C, int l, int kind, int b, int hd, int qblk) {
    const int lane = lane_id_fresh(), tok = lane & 31, hi = lane >> 5, wid = C.wave;
    constexpr int NC = TYPE ? 12 : 8, KTILE = NC * 512;
    const int Tk = kind ? TKS : TP, NT = Tk >> 6;
    const size_t row = (kind ? (size_t)MP + (size_t)b * TS : (size_t)b * TP) + 256 * qblk + 32 * wid + tok;
    const f16* Kimg = (TYPE ? (kind ? WSP(f16, WS_KCS) : WSP(f16, WS_KCP)) : (kind ? WSP(f16, WS_KAS) : WSP(f16, WS_KAP))) + ((size_t)b * 4 + hd) * NT * KTILE + lane * 8;
    const f16* Vimg = (TYPE ? (kind ? WSP(f16, WS_VCTS) : WSP(f16, WS_VCTP)) : (kind ? WSP(f16, WS_VATS) : WSP(f16, WS_VATP))) + ((size_t)b * 4 + hd) * NT * 4096 + wid * 512 + lane * 8;
    LAS unsigned char* lds = C.lds;
    const bool two = (TYPE == 1) && (wid < 4);
#define ATT_DMA(t, sl) do { const f16* kt_ = Kimg + (size_t)(t) * KTILE; LAS unsigned char* ls_ = lds + (sl) * ATT_SLOT; \
        ATT_GLDS(kt_ + wid * 512, ls_ + wid * 1024); if (two) ATT_GLDS(kt_ + (8 + wid) * 512, ls_ + (8 + wid) * 1024); \
        ATT_GLDS(Vimg + (size_t)(t) * 4096, ls_ + ATT_VOFF + wid * 1024); } while (0)
    f16x8 bq[TYPE ? 6 : 4];
    if (TYPE) {
#pragma unroll
        for (int ks = 0; ks < 6; ++ks) bq[ks] = *(const f16x8*)(WSP(f16, WS_QC) + row * 384 + hd * 96 + 16 * ks + 8 * hi);
    } else {
#pragma unroll
        for (int i = 0; i < 4; ++i) bq[i] = *(const f16x8*)(WSP(f16, WS_QA) + row * 256 + hd * 64 + 16 * i + 8 * hi);
    }
    float lam = 0.f, lam_init = 0.f;
    if (TYPE == 0) {
        const float* lp = C.in[I_DLAM] + (size_t)l * 128;
        float s1 = (lane < 32) ? lp[lane] * lp[32 + lane] : 0.f, s2 = (lane < 32) ? lp[64 + lane] * lp[96 + lane] : 0.f;
        s1 = wave_sum(s1); s2 = wave_sum(s2);
        lam_init = 0.8f - 0.6f * expf(-0.3f * (float)l);
        lam = expf(s1) - expf(s2) + lam_init;
    }
#pragma unroll
    for (int i = 0; i < (TYPE ? 6 : 4); ++i) asm volatile("" : "+v"(bq[i]));
    asm volatile("" : "+v"(lam), "+v"(lam_init));
    ATT_DMA(0, 0); ATT_DMA(1, 1);
    if (two) { ATT_WAITBAR(3); } else { ATT_WAITBAR(2); }
    float m0 = 0.f, m1 = 0.f;
    f32x16 O0[2], O1[2], L0 = (f32x16){}, L1 = (f32x16){}; O0[0] = (f32x16){}; O0[1] = (f32x16){}; O1[0] = (f32x16){}; O1[1] = (f32x16){};
    const f16x8 ones = {(f16)1.0f, (f16)1.0f, (f16)1.0f, (f16)1.0f, (f16)1.0f, (f16)1.0f, (f16)1.0f, (f16)1.0f};
    int s_cur = 0, s_nx2 = 2;
    LAS unsigned char* vb0 = lds + ATT_VOFF + (4 * hi + ((lane & 15) >> 2)) * 64 + ((lane >> 4) & 1) * 32 + (lane & 3) * 8;
    LAS unsigned char* kb0 = lds + hi * 1024 + tok * 16;
#pragma unroll 1
    for (int t = 0; t < NT; ++t) {
        if (t + 2 < NT) ATT_DMA(t + 2, s_nx2);
        LAS unsigned char* kb = kb0 + s_cur * ATT_SLOT; LAS unsigned char* vb = vb0 + s_cur * ATT_SLOT;
        f16x8 pf[TYPE ? 1 : 2][2][2];
#pragma unroll
        for (int c = 0; c < (TYPE ? 1 : 2); ++c) {
            f32x16 S[2];
            {
                f16x8 kf[2][TYPE ? 6 : 2];
#pragma unroll
                for (int sub = 0; sub < 2; ++sub)
#pragma unroll
                    for (int ks = 0; ks < (TYPE ? 6 : 2); ++ks) kf[sub][ks] = *(const LAS f16x8*)(kb + c * 4096 + ks * 2048 + sub * 512);
                __builtin_amdgcn_sched_barrier(0);
#pragma unroll
                for (int sub = 0; sub < 2; ++sub) { S[sub] = (f32x16){};
#pragma unroll
                    for (int ks = 0; ks < (TYPE ? 6 : 2); ++ks) S[sub] = MFMA32(kf[sub][ks], bq[c * 2 + ks], S[sub]); }
                __builtin_amdgcn_sched_barrier(0);
            }
            float ma = fmaxf(fmaxf(S[0][0], S[0][1]), S[1][0]), mb = fmaxf(fmaxf(S[0][2], S[0][3]), S[1][1]);
            ma = fmaxf(fmaxf(ma, S[1][2]), S[1][3]);
#pragma unroll
            for (int r = 4; r < 16; r += 4) { ma = fmaxf(fmaxf(ma, S[0][r]), S[0][r + 1]); mb = fmaxf(fmaxf(mb, S[0][r + 2]), S[0][r + 3]); ma = fmaxf(fmaxf(ma, S[1][r]), S[1][r + 1]); mb = fmaxf(fmaxf(mb, S[1][r + 2]), S[1][r + 3]); }
            float rm = fmaxf(ma, mb); rm = fmaxf(rm, __shfl_xor(rm, 32));
            float mref = c ? m1 : m0;
            if (t == 0) mref = rm;
            else if (__any(rm - mref > ATT_THR)) {
                const float dl = fmaxf(rm - mref, 0.f), f = fexp2(-dl); mref += dl;
                if (c == 0) {
#pragma unroll
                    for (int r = 0; r < 16; ++r) { O0[0][r] *= f; O0[1][r] *= f; L0[r] *= f; }
                } else {
#pragma unroll
                    for (int r = 0; r < 16; ++r) { O1[0][r] *= f; O1[1][r] *= f; L1[r] *= f; }
                }
            }
            if (c == 0) m0 = mref; else m1 = mref;
#pragma unroll
            for (int sub = 0; sub < 2; ++sub)
#pragma unroll
                for (int r = 0; r < 16; ++r) S[sub][r] = fexp2(S[sub][r] - mref);
#pragma unroll
            for (int sub = 0; sub < 2; ++sub)
#pragma unroll
                for (int sp = 0; sp < 2; ++sp) pf[c][sub][sp] = pack8(cvt4(S[sub][8 * sp], S[sub][8 * sp + 1], S[sub][8 * sp + 2], S[sub][8 * sp + 3]), cvt4(S[sub][8 * sp + 4], S[sub][8 * sp + 5], S[sub][8 * sp + 6], S[sub][8 * sp + 7]));
        }
#pragma unroll
        for (int vt = 0; vt < 2; ++vt) {
            f16x4 vlo[4], vhi[4];
#pragma unroll
            for (int k4 = 0; k4 < 4; ++k4) { vlo[k4] = lds_tr(vb + vt * 4096 + k4 * 1024); vhi[k4] = lds_tr(vb + vt * 4096 + k4 * 1024 + 512); }
            __builtin_amdgcn_sched_barrier(0);
#pragma unroll
            for (int k4 = 0; k4 < 4; ++k4) {
                const f16x8 vf = pack8(vlo[k4], vhi[k4]);
                O0[vt] = MFMA32(vf, pf[0][k4 >> 1][k4 & 1], O0[vt]);
                if (TYPE == 0) O1[vt] = MFMA32(vf, pf[TYPE ? 0 : 1][k4 >> 1][k4 & 1], O1[vt]);
            }
            __builtin_amdgcn_sched_barrier(0);
        }
#pragma unroll
        for (int k4 = 0; k4 < 4; ++k4) { L0 = MFMA32(ones, pf[0][k4 >> 1][k4 & 1], L0); if (TYPE == 0) L1 = MFMA32(ones, pf[TYPE ? 0 : 1][k4 >> 1][k4 & 1], L1); }
        if (t + 1 < NT) {
            if (t + 2 < NT) { if (two) { ATT_WAITBAR(3); } else { ATT_WAITBAR(2); } } else { ATT_WAITBAR(0); }
        }
        s_nx2 = s_cur; s_cur = (s_cur == 2) ? 0 : s_cur + 1;
    }
#undef ATT_DMA
    f16* o = WSP(f16, WS_OCAT) + row * DM + (TYPE ? 768 : 0) + hd * 64 + 4 * hi;
    if (TYPE) {
        const float inv = 1.0f / L0[0];
#pragma unroll
        for (int vt = 0; vt < 2; ++vt)
#pragma unroll
            for (int g = 0; g < 4; ++g) *(f16x4*)(o + 32 * vt + 8 * g) = cvt4(O0[vt][4 * g] * inv, O0[vt][4 * g + 1] * inv, O0[vt][4 * g + 2] * inv, O0[vt][4 * g + 3] * inv);
    } else {
        const float i0 = 1.0f / L0[0], i1 = lam / L1[0];
        float ss = 0.f;
#pragma unroll
        for (int vt = 0; vt < 2; ++vt)
#pragma unroll
            for (int r = 0; r < 16; ++r) { const float v = O0[vt][r] * i0 - O1[vt][r] * i1; O0[vt][r] = v; ss += v * v; }
        ss += __shfl_xor(ss, 32);
        const float rs = (1.0f / sqrtf(ss * (1.0f / 64.0f) + EPS)) * (1.0f - lam_init);
        const float* sg = C.in[I_DSUB] + (size_t)l * 64 + 4 * hi;
        f32x4 sgv[2][4];
#pragma unroll
        for (int vt = 0; vt < 2; ++vt)
#pragma unroll
            for (int g = 0; g < 4; ++g) sgv[vt][g] = *(const f32x4*)(sg + 32 * vt + 8 * g);
#pragma unroll
        for (int vt = 0; vt < 2; ++vt)
#pragma unroll
            for (int g = 0; g < 4; ++g) { const f32x4 gg = sgv[vt][g];
                *(f16x4*)(o + 32 * vt + 8 * g) = cvt4(O0[vt][4 * g] * rs * gg[0], O0[vt][4 * g + 1] * rs * gg[1], O0[vt][4 * g + 2] * rs * gg[2], O0[vt][4 * g + 3] * rs * gg[3]); }
    }
    ATT_LBAR();
}

template <int mode>
__device__ __forceinline__ void phase_mx(const Ctx& C0, int l, unsigned* ctr) {
    const Ctx C = ctx_fresh(C0);
#pragma unroll 1
    for (int u = C.bid; u < 544; u += C.G) {
        ATT_LBAR();
        if (mode == 1 || mode == 4) continue;
#ifndef NO_MXT
        const int lane = lane_id_fresh();
        if (u < 288) {
            const int g = u >> 2, hd = u & 3;
            const f16* wsrc = ((g < 64) ? WSP(f16, WS_WUKV) : WSP(f16, WS_WUKV0)) + ((size_t)(l * 4 + hd) * 32) * 512 + lane * 8;
#pragma unroll
            for (int i = 0; i < 4; ++i) ATT_GLDS(wsrc + (C.wave + 8 * i) * 512, C.lds + (C.wave + 8 * i) * 1024);
            if (g < 32) mx_kv<0>(C, l, g * 8 + C.wave, hd, C.lds); else if (g < 64) mx_kv<1>(C, l, g * 8 + C.wave, hd, C.lds); else mx_kv<2>(C, l, 512 + (g - 64) * 8 + C.wave, hd, C.lds);
        } else {
            const int v = u - 288, g = v >> 2, hd = v & 3;
            const f16* wsrc = WSP(f16, WS_WUQ) + ((size_t)(l * 4 + hd) * 36) * 512 + lane * 8;
#pragma unroll
            for (int i = 0; i < 5; ++i) if (C.wave + 8 * i < 36) ATT_GLDS(wsrc + (C.wave + 8 * i) * 512, C.lds + (C.wave + 8 * i) * 1024);
            if (g < 32) mx_q<0>(C, l, g * 8 + C.wave, hd, C.lds); else mx_q<1>(C, l, g * 8 + C.wave, hd, C.lds);
        }
#endif
    }
    constexpr int NA = 512 + 576 + 576;
#ifndef NO_LRU1
    if (mode != 2 && mode != 3 && mode != 4)
#pragma unroll 1
        for (int i = C.gw; i < 2048; i += C.ngw) lru_item<false>(C, l, i >> 3, i & 7);
#endif
#ifndef NO_MXT
    if (mode != 1 && mode != 3)
#pragma unroll 1
        for (int it = C.ngw - 1 - C.gw; it < NA; it += C.ngw) {
            if (it < 512) { if (it < 256) mx_a<0, 0>(C, l, it); else mx_a<1, 0>(C, l, it); }
            else if (it < 1088) { const int w = it - 512; if (w < 256) mx_a<0, 1>(C, l, w); else if (w < 512) mx_a<1, 1>(C, l, w); else mx_a<2, 1>(C, l, w); }
            else { const int w = it - 1088; if (w < 256) mx_a<0, 2>(C, l, w); else if (w < 512) mx_a<1, 2>(C, l, w); else mx_a<2, 2>(C, l, w); }
        }
#endif
}

template <int mode>
__device__ __forceinline__ void phase_att(const Ctx& C0, int l, unsigned* ctr) {
    const Ctx C = ctx_fresh(C0);
    const int half = C.G >> 1;
    if (mode != 1) {
#pragma unroll 1
        for (int u = C.bid; u < 128; u += half) { if (C.bid >= half) break;
#ifndef NO_ATTA
            if (mode == 0 || mode == 2 || mode == 5) { const int pr = (u & 7) * 2 + ((u >> 3) >> 3), qb = (u >> 3) & 7;
                attn_unit<0>(C, l, 1, pr >> 2, pr & 3, qb); }
#endif
        }
        if (C.bid >= half) {
#pragma unroll 1
            for (int u = C.bid - half; u < 128; u += half) {
#ifndef NO_ATTC
                if (mode == 0 || mode == 2 || mode == 6) { const int pr = (u & 7) * 2 + ((u >> 3) >> 3), qb = (u >> 3) & 7;
                    attn_unit<1>(C, l, 1, pr >> 2, pr & 3, qb); }
#endif
            }
#pragma unroll 1
            for (int u = C.bid - half; u < 128; u += half) {
#ifndef NO_ATTA
                if (mode == 0 || mode == 2 || mode == 7) attn_unit<0>(C, l, 0, u >> 2, u & 3, 0);
#endif
#ifndef NO_ATTC
                if (mode == 0 || mode == 2 || mode == 7) attn_unit<1>(C, l, 0, u >> 2, u & 3, 0);
#endif
            }
        }
    }
#ifndef NO_LRU2
    if (mode == 0 || mode == 1) {
#pragma unroll 1
        for (int it = C.gw; it < 2048; it += C.ngw) lru_item<true>(C, l, it >> 3, it & 7);
    }
#endif
}

__global__ void __launch_bounds__(512, 2) mk_fwd(Args args) {
    extern __shared__ __attribute__((aligned(16))) unsigned char lds_raw[];
    Ctx C;
    C.in = args.in; C.out = args.out; C.ws = args.ws;
    C.lds = (LAS unsigned char*)lds_raw;
    C.tid = threadIdx.x; C.lane = C.tid & 63; C.wave = __builtin_amdgcn_readfirstlane(C.tid >> 6);
    C.gw = 0; C.ngw = 0; C.bid = 0; C.G = 0;
    volatile LAS unsigned* MISC = (volatile LAS unsigned*)(C.lds + MISC_OFF);
    for (int u = C.tid; u < (LDS_BYTES - LDSCTL_OFF) / 4; u += 512) ((LAS unsigned*)(C.lds + LDSCTL_OFF))[u] = 0u;
    __syncthreads();
    unsigned* ctl = (unsigned*)(args.ws + WS_CTL);
    XcdBarrier bar = xcd_barrier_post(ctl + CW_BAR, MISC + 8);
    const int lo = args.ph_lo, hi = args.ph_hi;
#define IN(k) (lo <= (k) && (k) < hi)
#define SEAM(k) do { if (IN(k) && IN((k) + 1)) xcd_barrier(bar); } while (0)

    int rep = 0;
#pragma unroll 1
    for (int p = lo; p < hi; ++p) {
        const int l = (p >= 10) ? 1 : 0, q = (p < 2) ? -1 - p : (p - 2 - 8 * l);
        int bid = blockIdx.x, G = gridDim.x; asm volatile("" : "+s"(bid), "+s"(G));
        const float* modl = WSP(float, WS_MOD) + (size_t)l * 5 * NMODV;
        if (q == -1) {
#ifndef NO_PREP
            phase_prep(C);
#endif
        } else if (q == -2) phase_norm<true>(C, 0, 0);
        else if (q == 0 || q == 6) {
            const int s = (q == 6);
            pg8::Gemm g{WSP(f16, WS_H), WSP(f16, WS_WFI) + (size_t)(l * 2 + s) * NFF2 * 1024, M, NFF2, 1024}; pg8::StaticOrder S; S.init(M, NFF2, G, bid);
            pg8::EpiSwiglu E{WSP(f16, WS_ACT)};
            pg8::gemm_phase<pg8::EpiSwiglu, pg8::StaticOrder, true, true>(C.lds, g, S, E, C.wave);
        } else if (q == 1 || q == 7 || q == 5) {
            const int s = (q == 7);
            const f16* A = (q == 5) ? WSP(f16, WS_OCAT) : WSP(f16, WS_ACT);
            const f16* B = (q == 5) ? WSP(f16, WS_WOUT) + (size_t)l * 1024 * 1024 : WSP(f16, WS_WFO) + (size_t)(l * 2 + s) * 1024 * DFF;
            pg8::Gemm g{A, B, M, 1024, (q == 5) ? 1024 : DFF}; pg8::StaticOrder S; S.init(M, 1024, G, bid);
            const int nl = (q == 7) ? l + 1 : l, nsub = (q == 1) ? 1 : ((q == 5) ? 2 : 0), donorm = (nl < DEPTH) ? 1 : 0, nlc = donorm ? nl : l;
            pg8::EpiResidNorm E{C.out, WSP(f16, WS_XH), modl, (q == 5) ? 5 : (s ? 8 : 2), (rep > 0) ? 0.0f : ((q == 5) ? 1.0f : 0.5f),
                                donorm, WSP(f16, WS_H), C.in[I_NG] + ((size_t)nlc * 3 + nsub) * DM, WSP(float, WS_MOD) + (size_t)nlc * 5 * NMODV + (3 * nsub) * DM,
                                WSP(float, WS_XBUF), ctl + CW_PAN + (p + 18 * rep) * 4096};
            pg8::gemm_phase<pg8::EpiResidNorm, pg8::StaticOrder, false, true>(C.lds, g, S, E, C.wave);
        } else if (q == 2) {
            pg8::Gemm g{WSP(f16, WS_H), WSP(f16, WS_WIN) + (size_t)l * DINP * 1024, M, DINP, 1024}; pg8::StaticOrder S; S.init(M, DINP, G, bid);
            pg8::EpiStore E{WSP(f16, WS_ACT), DINP};
            pg8::gemm_phase<pg8::EpiStore, pg8::StaticOrder, true, true>(C.lds, g, S, E, C.wave);
        } else if (q == 3) { if (REP_MODE != 0 && rep) phase_mx<REP_MODE>(C, l, ctl + CW_Q + 64 * (p + 32 * rep)); else phase_mx<0>(C, l, ctl + CW_Q + 64 * (p + 32 * rep)); }
        else if (q == 4) { if (REP_MODE != 0 && rep) phase_att<REP_MODE>(C, l, ctl + CW_Q + 64 * (p + 32 * rep)); else phase_att<0>(C, l, ctl + CW_Q + 64 * (p + 32 * rep)); }
        if (REP_Q == 99 && p == 1) { for (int k = 0; k < 10; ++k) xcd_barrier(bar, C.wave); }
        if (q == REP_Q && rep < REP_N) { ++rep; --p; xcd_barrier(bar, C.wave); continue; }
        rep = 0;
        if (p + 1 < hi) xcd_barrier(bar, C.wave);
    }
#undef IN
#undef SEAM
}

extern "C" void kernel_launch(void* const* d_in, const int* in_sizes, int n_in, void* d_out, int out_size, void* d_ws, size_t ws_size, hipStream_t stream) {
    static int grid = 0;
    if (grid == 0) {
        if (n_in != N_IN || ws_size < WS_END || out_size != 27852800) { fprintf(stderr, "kernel_launch: unexpected shapes: n_in %d ws %zu out %d\n", n_in, ws_size, out_size); grid = -1; return; }
        int dev = 0, cus = 0, per_cu = 0;
        if (hipGetDevice(&dev) != hipSuccess || hipDeviceGetAttribute(&cus, hipDeviceAttributeMultiprocessorCount, dev) != hipSuccess) { grid = -1; return; }
        if (hipFuncSetAttribute((const void*)mk_fwd, hipFuncAttributeMaxDynamicSharedMemorySize, LDS_BYTES) != hipSuccess) { fprintf(stderr, "kernel_launch: hipFuncSetAttribute failed\n"); grid = -1; return; }
        if (hipOccupancyMaxActiveBlocksPerMultiprocessor(&per_cu, (const void*)mk_fwd, 512, LDS_BYTES) != hipSuccess || per_cu < 1) { fprintf(stderr, "kernel_launch: occupancy query says %d\n", per_cu); per_cu = 1; }
        (void)hipGetLastError();
        grid = cus;
    }
    if (grid < 0) return;
    if (hipMemsetAsync((char*)d_ws + WS_CTL, 0, CTL_ZERO_BYTES, stream) != hipSuccess) return;
    Args a{};
    for (int i = 0; i < N_IN; ++i) a.in[i] = (const float*)d_in[i];
    a.out = (float*)d_out; a.ws = (unsigned char*)d_ws;
#if MK_MULTI
    for (int p = 0; p < MK_PH_HI; ++p) { a.ph_lo = p; a.ph_hi = p + 1; hipLaunchKernelGGL(mk_fwd, dim3(grid), dim3(512), LDS_BYTES, stream, a); }
#else
    a.ph_lo = 0; a.ph_hi = MK_PH_HI;
    void* kargs[] = {&a};
    hipError_t e = hipLaunchCooperativeKernel((const void*)mk_fwd, dim3(grid), dim3(512), kargs, LDS_BYTES, stream);
    if (e != hipSuccess) { (void)hipGetLastError(); fprintf(stderr, "kernel_launch: cooperative launch failed (%s), plain launch instead\n", hipGetErrorString(e));
        hipLaunchKernelGGL(mk_fwd, dim3(grid), dim3(512), LDS_BYTES, stream, a); }
#endif
}
```

```cpp
#include <hip/hip_runtime.h>
#include <cstdio>
#include <cstdint>

#define GAS __attribute__((address_space(1)))
#define LAS __attribute__((address_space(3)))
typedef _Float16 f16;
typedef _Float16 f16x2 __attribute__((ext_vector_type(2)));
typedef _Float16 f16x4 __attribute__((ext_vector_type(4)));
typedef _Float16 f16x8 __attribute__((ext_vector_type(8)));
typedef float f32x2 __attribute__((ext_vector_type(2)));
typedef float f32x4 __attribute__((ext_vector_type(4)));
typedef float f32x16 __attribute__((ext_vector_type(16)));
typedef unsigned u32x2 __attribute__((ext_vector_type(2)));
typedef unsigned u32x4 __attribute__((ext_vector_type(4)));
typedef GAS unsigned gu32;

#ifndef MK_PH_HI
#define MK_PH_HI 18
#endif
#ifndef REP_Q
#define REP_Q -2
#endif
#ifndef REP_N
#define REP_N 1
#endif
#ifndef REP_MODE
#define REP_MODE 0
#endif
#ifndef MK_MULTI
#define MK_MULTI 0
#endif

constexpr int DM = 1024, NBP = 32, TP = 256, NBS = 4, TS = 2048, PAST = 512, DEPTH = 2;
constexpr int MP = NBP * TP, MS = NBS * TS, M = MP + MS;
constexpr int DFF = 2816, NFF2 = 5632, DIN = 2144, DINP = 2304, NMODV = 9216;
constexpr int TKS = PAST + TS;
constexpr float EPS = 1e-6f;
constexpr float LOG2E = 1.4426950408889634f;
constexpr int PC_QA = 0, PC_KA = 256, PC_VA = 512, PC_XB = 768, PC_GB = 1280, PC_CQ = 1792, PC_CKV = 1984, PC_KR = 2112;
constexpr size_t OUT_YP = 0, OUT_YS = 8388608, OUT_DK = 16777216, OUT_DV = 20971520, OUT_CKV = 25165824, OUT_KR = 27262976, OUT_ST = 27787264;
enum { I_XP = 0, I_XS, I_CDK, I_CDV, I_CCKV, I_CKR, I_ST, I_C, I_CCTX, I_NG, I_WADA, I_BADA, I_WFI, I_WFO, I_WIN, I_WOUT, I_DQKN, I_DLAM, I_DSUB,
       I_CONVW, I_CONVB, I_WGATE, I_BGATE, I_LLAM, I_CQN, I_CKVN, I_WUQ, I_WUKV, I_QKN, N_IN };

constexpr size_t MiB = 1u << 20;
constexpr size_t WS_CTL = 0, CTL_ZERO_BYTES = 1 * MiB;
constexpr size_t WS_MOD = 1 * MiB;
constexpr size_t WS_WUQ = 2 * MiB;
constexpr size_t WS_WUKV = 2 * MiB + 512 * 1024;
constexpr size_t WS_WUKV0 = 3 * MiB + 512 * 1024;
constexpr size_t WS_IDN = 3 * MiB + 768 * 1024;
constexpr size_t WS_WG = 3 * MiB;
constexpr size_t WS_SUM = 4 * MiB;
constexpr size_t WS_XBUF = 4 * MiB + 2 * MiB + 512 * 1024;
constexpr size_t WS_WFI = 8 * MiB;
constexpr size_t WS_WFO = 52 * MiB;
constexpr size_t WS_WIN = 74 * MiB;
constexpr size_t WS_WOUT = 83 * MiB;
constexpr size_t WS_H = 88 * MiB;
constexpr size_t WS_OCAT = 120 * MiB;
constexpr size_t WS_ACT = 152 * MiB;
constexpr size_t WS_XC = 224 * MiB;
constexpr size_t WS_QA = 240 * MiB;
constexpr size_t WS_QC = 248 * MiB;
constexpr size_t WS_KAS = 260 * MiB;
constexpr size_t WS_KAP = 265 * MiB;
constexpr size_t WS_VATS = 269 * MiB;
constexpr size_t WS_VATP = 274 * MiB;
constexpr size_t WS_KCS = 278 * MiB;
constexpr size_t WS_KCP = 286 * MiB;
constexpr size_t WS_VCTS = 292 * MiB;
constexpr size_t WS_VCTP = 297 * MiB;
constexpr size_t WS_XH = 301 * MiB;
constexpr size_t WS_END = 333 * MiB;
constexpr int CW_BAR = 4096;
constexpr int CW_Q = 16384;
constexpr int CW_PAN = 65536;

constexpr int RING_BYTES = 131072;
constexpr int LDSCTL_OFF = RING_BYTES, MISC_OFF = LDSCTL_OFF + 320;
constexpr int LDS_BYTES = 147456;

__device__ __forceinline__ int crow(int r, int hi) { return (r & 3) + 8 * (r >> 2) + 4 * hi; }
__device__ __forceinline__ int swap23(int x) { return (x & ~12) | ((x & 4) << 1) | ((x & 8) >> 1); }
__device__ __forceinline__ f16x2 cvt2(float a, float b) { f32x2 v = {a, b}; return __builtin_convertvector(v, f16x2); }
__device__ __forceinline__ f16x4 cvt4(float a, float b, float c, float d) { f32x4 v = {a, b, c, d}; return __builtin_convertvector(v, f16x4); }
__device__ __forceinline__ f16x4 cvt4v(f32x4 v) { return __builtin_convertvector(v, f16x4); }
__device__ __forceinline__ f32x4 tof32(f16x4 v) { return __builtin_convertvector(v, f32x4); }
__device__ __forceinline__ f16x8 pack8(f16x4 a, f16x4 b) { return __builtin_shufflevector(a, b, 0, 1, 2, 3, 4, 5, 6, 7); }
__device__ __forceinline__ float fexp2(float x) { return __builtin_amdgcn_exp2f(x); }
__device__ __forceinline__ float frcp(float x) { return __builtin_amdgcn_rcpf(x); }
__device__ __forceinline__ float sigmoidf_(float x) { return frcp(1.0f + fexp2(-x * LOG2E)); }
__device__ __forceinline__ float wave_sum(float v) {
#pragma unroll
    for (int o = 1; o < 64; o <<= 1) v += __shfl_xor(v, o);
    return v;
}
#define FENCE() asm volatile("" ::: "memory")
__device__ __forceinline__ int lane_id_fresh() { int l; asm volatile("v_mbcnt_lo_u32_b32 %0, -1, 0\n\tv_mbcnt_hi_u32_b32 %0, -1, %0" : "=v"(l)); return l; }
#define MFMA32(a, b, c) __builtin_amdgcn_mfma_f32_32x32x16_f16((a), (b), (c), 0, 0, 0)

namespace pg8 {
#define PG8_LAS __attribute__((address_space(3)))
constexpr int BM = 256, BK = 64, HALF = 128, HTB = HALF * BK * 2, STAGE_BYTES = 8 * HTB, NXCD = 8, WGM = 8;
__host__ __device__ __forceinline__ int lds_byte(int r, int c) { const int st = (r >> 4) * 2 + (c >> 5), rr = r & 15, cc = c & 31, ob = rr * 64 + cc * 2; return st * 1024 + (ob ^ (((ob >> 9) & 1) << 5)); }
__host__ __device__ __forceinline__ void stage_rc(int b, int& R, int& C) { const int st = b / 1024, sb = b % 1024, swz = sb ^ (((sb >> 9) & 1) << 5); R = (st >> 1) * 16 + swz / 64; C = (st & 1) * 32 + (swz % 64) / 2; }
__host__ __device__ __forceinline__ int perm32(int rho) { const int n = rho >> 4, i = rho & 15; return 8 * (i >> 2) + 4 * n + (i & 3); }
struct Unit { int pm, pn; };
struct Gemm { const f16* A; const f16* Bt; int M, N, K; };
struct StaticOrder {
    int nM, nN, nwg, G, c;
    __host__ __device__ void init(int M_, int N_, int G_, int c_) { nM = M_ / BM; nN = N_ / BM; nwg = nM * nN; G = G_; c = c_; }
    __host__ __device__ bool next(int i, Unit& u) const {
        const long L = (long)i * G + c; if (L >= nwg) return false;
        int wgid = (int)L; { const int q = nwg / NXCD, r = nwg % NXCD, xcd = wgid % NXCD, off = wgid / NXCD; wgid = (xcd < r ? xcd * (q + 1) : r * (q + 1) + (xcd - r) * q) + off; }
        const int nig = WGM * nN, gid = wgid / nig, fm = gid * WGM, gsz = (nM - fm) < WGM ? (nM - fm) : WGM;
        u.pm = fm + ((wgid % nig) % gsz); u.pn = (wgid % nig) / gsz; return true;
    }
};
struct EpiSwiglu {
    static constexpr bool PERM = true, AFTER_DRAIN = false;
    f16* O;
    __device__ __forceinline__ void operator()(const f32x4 (&acc)[2][2][4][2], const Unit& u, int wr, int wc, int fr, int fq) const {
        const int row0 = u.pm * BM + wr * 64 + fr, col0 = u.pn * 128 + wc * 32 + 8 * fq;
#pragma unroll
        for (int ai = 0; ai < 2; ++ai)
#pragma unroll
            for (int m = 0; m < 4; ++m) {
                f16* rowp = O + (size_t)(row0 + ai * HALF + m * 16) * DFF + col0;
                f32x4 a0, a1;
#pragma unroll
                for (int e = 0; e < 4; ++e) {
                    const float g0 = acc[ai][0][m][0][e], g1 = acc[ai][0][m][1][e];
                    a0[e] = g0 * sigmoidf_(g0) * acc[ai][1][m][0][e];
                    a1[e] = g1 * sigmoidf_(g1) * acc[ai][1][m][1][e];
                }
                *(f16x8*)rowp = pack8(cvt4v(a0), cvt4v(a1));
            }
    }
};
struct EpiStore {
    static constexpr bool PERM = true, AFTER_DRAIN = false;
    f16* O; int ldc;
    __device__ __forceinline__ void operator()(const f32x4 (&acc)[2][2][4][2], const Unit& u, int wr, int wc, int fr, int fq) const {
        const int row0 = u.pm * BM + wr * 64 + fr, col0 = u.pn * BM + wc * 32 + 8 * fq;
#pragma unroll
        for (int ai = 0; ai < 2; ++ai)
#pragma unroll
            for (int m = 0; m < 4; ++m) {
                f16* rowp = O + (size_t)(row0 + ai * HALF + m * 16) * ldc + col0;
#pragma unroll
                for (int bj = 0; bj < 2; ++bj) *(f16x8*)(rowp + bj * HALF) = pack8(cvt4v(acc[ai][bj][m][0]), cvt4v(acc[ai][bj][m][1]));
            }
    }
};
struct EpiResidNorm {
    static constexpr bool PERM = true, AFTER_DRAIN = true;
    float* X; f16* XH; const float* modl; int gidx; float coef;
    int donorm; f16* H; const float* gn; const float* shn;
    float* xbuf; unsigned* cnt;
    __device__ __forceinline__ void fused(f32x4 (&acc)[2][2][4][2], const Unit& u, int wr, int wc, int fr, int fq, PG8_LAS unsigned char* lds, int wid, int lane) const {
        const int cond = (u.pm < 32) ? 4 : ((u.pm - 32) >> 3);
        const int col0 = u.pn * BM + wc * 32 + 8 * fq;
        {
            const float* gp = modl + (size_t)cond * NMODV + gidx * DM + col0;
            f32x4 gv[2][2];
#pragma unroll
            for (int bj = 0; bj < 2; ++bj)
#pragma unroll
                for (int n = 0; n < 2; ++n) gv[bj][n] = *(const f32x4*)(gp + bj * HALF + n * 4) * coef;
#pragma unroll
            for (int ai = 0; ai < 2; ++ai)
#pragma unroll
                for (int m = 0; m < 4; ++m) {
                    const f16* rowp = XH + (size_t)(u.pm * BM + ai * HALF + wr * 64 + m * 16 + fr) * DM + col0;
                    f32x4 xv[2][2];
#pragma unroll
                    for (int bj = 0; bj < 2; ++bj) { const f16x8 xh = *(const f16x8*)(rowp + bj * HALF);
                        xv[bj][0] = (f32x4){(float)xh[0], (float)xh[1], (float)xh[2], (float)xh[3]}; xv[bj][1] = (f32x4){(float)xh[4], (float)xh[5], (float)xh[6], (float)xh[7]}; }
#pragma unroll
                    for (int bj = 0; bj < 2; ++bj)
#pragma unroll
                        for (int n = 0; n < 2; ++n) { const f32x4 v = xv[bj][n] + gv[bj][n] * acc[ai][bj][m][n]; acc[ai][bj][m][n] = v; }
                    asm volatile("" : "+v"(acc[ai][0][m][0]), "+v"(acc[ai][0][m][1]), "+v"(acc[ai][1][m][0]), "+v"(acc[ai][1][m][1]));
                    if (m & 1) asm volatile("" ::: "memory");
                }
        }
        if (!donorm) {
#pragma unroll
            for (int ai = 0; ai < 2; ++ai)
#pragma unroll
                for (int m = 0; m < 4; ++m) {
                    float* rowp = X + (size_t)(u.pm * BM + ai * HALF + wr * 64 + m * 16 + fr) * DM + col0;
#pragma unroll
                    for (int bj = 0; bj < 2; ++bj)
#pragma unroll
                        for (int n = 0; n < 2; ++n) *(f32x4*)(rowp + bj * HALF + n * 4) = acc[ai][bj][m][n];
                }
            return;
        }
        PG8_LAS float* P = (PG8_LAS float*)lds;
        PG8_LAS float* S = (PG8_LAS float*)(lds + 4096);
#pragma unroll
        for (int ai = 0; ai < 2; ++ai)
#pragma unroll
            for (int m = 0; m < 4; ++m) {
                float q = 0.f;
#pragma unroll
                for (int bj = 0; bj < 2; ++bj)
#pragma unroll
                    for (int n = 0; n < 2; ++n) { const f32x4 x = acc[ai][bj][m][n]; q += (x[0] * x[0] + x[1] * x[1]) + (x[2] * x[2] + x[3] * x[3]); }
                q += __shfl_xor(q, 16); q += __shfl_xor(q, 32);
                if (fq == 0) P[(ai * HALF + wr * 64 + m * 16 + fr) * 4 + wc] = q;
            }
        asm volatile("s_waitcnt lgkmcnt(0)" ::: "memory"); __builtin_amdgcn_s_barrier(); asm volatile("" ::: "memory");
        const int row = wid * 32 + (lane & 31);
        if (lane < 32) {
            const float tot = (P[row * 4 + 0] + P[row * 4 + 1]) + (P[row * 4 + 2] + P[row * 4 + 3]);
            __hip_atomic_store(xbuf + ((size_t)(u.pm * BM + row) * 4 + u.pn), tot, __ATOMIC_RELAXED, __HIP_MEMORY_SCOPE_AGENT);
        }
        asm volatile("s_waitcnt vmcnt(0)" ::: "memory");
        if (lane == 0) __hip_atomic_fetch_add(cnt + 64 * u.pm, 1u, __ATOMIC_RELAXED, __HIP_MEMORY_SCOPE_AGENT);
#pragma unroll
        for (int ai = 0; ai < 2; ++ai)
#pragma unroll
            for (int m = 0; m < 4; ++m) {
                f16* rowp = XH + (size_t)(u.pm * BM + ai * HALF + wr * 64 + m * 16 + fr) * DM + col0;
#pragma unroll
                for (int bj = 0; bj < 2; ++bj) *(f16x8*)(rowp + bj * HALF) = pack8(cvt4v(acc[ai][bj][m][0]), cvt4v(acc[ai][bj][m][1]));
            }
        if (wid == 0) {
            unsigned spins = 0;
            for (;;) {
                if ((unsigned)__builtin_amdgcn_readfirstlane(__hip_atomic_load(cnt + 64 * u.pm, __ATOMIC_RELAXED, __HIP_MEMORY_SCOPE_AGENT)) >= 32u) break;
                if (++spins > (1u << 20)) break;
                __builtin_amdgcn_s_sleep(2);
            }
            __builtin_amdgcn_fence(__ATOMIC_ACQUIRE, "agent");
        }
        asm volatile("s_waitcnt vmcnt(0) lgkmcnt(0)" ::: "memory"); __builtin_amdgcn_s_barrier(); asm volatile("" ::: "memory");
        if (lane < 32) {
            const float* slot = xbuf + (size_t)(u.pm * BM + row) * 4;
            const float t0 = __hip_atomic_load(slot + 0, __ATOMIC_RELAXED, __HIP_MEMORY_SCOPE_AGENT), t1 = __hip_atomic_load(slot + 1, __ATOMIC_RELAXED, __HIP_MEMORY_SCOPE_AGENT);
            const float t2 = __hip_atomic_load(slot + 2, __ATOMIC_RELAXED, __HIP_MEMORY_SCOPE_AGENT), t3 = __hip_atomic_load(slot + 3, __ATOMIC_RELAXED, __HIP_MEMORY_SCOPE_AGENT);
            S[row] = 1.0f / sqrtf(((t0 + t1) + (t2 + t3)) * (1.0f / DM) + EPS);
        }
        asm volatile("s_waitcnt lgkmcnt(0)" ::: "memory"); __builtin_amdgcn_s_barrier(); asm volatile("" ::: "memory");
        const float* shp = shn + (size_t)cond * NMODV + col0;
        f32x4 gsv[2][2], shv[2][2];
#pragma unroll
        for (int bj = 0; bj < 2; ++bj)
#pragma unroll
            for (int n = 0; n < 2; ++n) { const int co = bj * HALF + n * 4;
                gsv[bj][n] = *(const f32x4*)(gn + col0 + co) * (*(const f32x4*)(shp + DM + co) + 1.0f); shv[bj][n] = *(const f32x4*)(shp + co); }
#pragma unroll
        for (int ai = 0; ai < 2; ++ai)
#pragma unroll
            for (int m = 0; m < 4; ++m) { const int r = ai * HALF + wr * 64 + m * 16 + fr; const float sr = S[r];
#pragma unroll
                for (int bj = 0; bj < 2; ++bj) *(f16x8*)(H + (size_t)(u.pm * BM + r) * DM + col0 + bj * HALF) = pack8(cvt4v(acc[ai][bj][m][0] * sr * gsv[bj][0] + shv[bj][0]), cvt4v(acc[ai][bj][m][1] * sr * gsv[bj][1] + shv[bj][1])); }
    }
};

template <class Epi, class Sched, bool ALIGN_EPI, bool SP2>
__device__ __forceinline__ void gemm_phase(PG8_LAS unsigned char* lds, const Gemm g, const Sched& S, const Epi& E, int wave_id) {
    const int lane = lane_id_fresh(), wid = wave_id, tid = wid * 64 + lane, wr = wid >> 2, wc = wid & 3, fr = lane & 15, fq = lane >> 4;
    const int K = g.K, nt = K / BK;
    unsigned voffA[2], voffB[2];
#pragma unroll
    for (int i = 0; i < 2; ++i) { int R, C; stage_rc(tid * 16 + i * 8192, R, C); const int Rb = Epi::PERM ? ((R & ~31) + perm32(R & 31)) : R;
        voffA[i] = (unsigned)(R * K + C) * 2u; voffB[i] = (unsigned)(Rb * K + C) * 2u; }
    const size_t kstep = (size_t)(BK * 2);
    const size_t hstep = (size_t)HALF * K * 2;
    const size_t tstep = 2 * hstep;
    const unsigned ldsw = (unsigned)wid * 1024u;
    const int aoff = lds_byte(wr * 64 + fr, fq * 8), boff = lds_byte(wc * 32 + fr, fq * 8);
#define PG8_SA(b, h) (((b) * 2 + (h)) * HTB)
#define PG8_SB(b, h) ((4 + (b) * 2 + (h)) * HTB)
#define PG8_STAGE(bufoff, gbase, voff) do { _Pragma("unroll") for (int _i = 0; _i < 2; ++_i) \
        __builtin_amdgcn_global_load_lds((const unsigned*)((const char*)(gbase) + (voff)[_i]), (PG8_LAS unsigned*)(lds + (bufoff) + ldsw + _i * 8192), 16, 0, 0); } while (0)
#define PG8_LDA(dst, b, h) do { _Pragma("unroll") for (int m = 0; m < 4; ++m) _Pragma("unroll") for (int k = 0; k < 2; ++k) dst[m][k] = *(const PG8_LAS f16x8*)(lds + PG8_SA(b, h) + aoff + m * 2048 + k * 1024); } while (0)
#define PG8_LDB(dst, b, h) do { _Pragma("unroll") for (int n = 0; n < 2; ++n) _Pragma("unroll") for (int k = 0; k < 2; ++k) dst[n][k] = *(const PG8_LAS f16x8*)(lds + PG8_SB(b, h) + boff + n * 2048 + k * 1024); } while (0)
#define PG8_MMA(ai, bj, At, Bt) do { __builtin_amdgcn_s_setprio(1); _Pragma("unroll") for (int m = 0; m < 4; ++m) _Pragma("unroll") for (int n = 0; n < 2; ++n) _Pragma("unroll") for (int k = 0; k < 2; ++k) \
        acc[ai][bj][m][n] = __builtin_amdgcn_mfma_f32_16x16x32_f16(Bt[n][k], At[m][k], acc[ai][bj][m][n], 0, 0, 0); __builtin_amdgcn_s_setprio(0); } while (0)
#define PG8_WAIT_V(n) asm volatile("s_waitcnt vmcnt(" #n ")" ::: "memory")
#define PG8_WAIT_L(n) asm volatile("s_waitcnt lgkmcnt(" #n ")" ::: "memory")
#define PG8_BAR __builtin_amdgcn_s_barrier()
#define PG8_SCHED __builtin_amdgcn_sched_barrier(0)
    Unit cur, nxt; int ui = 0;
    if (!S.next(0, cur)) return;
    f32x4 acc[2][2][4][2];
#pragma unroll
    for (int a = 0; a < 2; ++a)
#pragma unroll
        for (int b = 0; b < 2; ++b)
#pragma unroll
            for (int m = 0; m < 4; ++m)
#pragma unroll
                for (int n = 0; n < 2; ++n) acc[a][b][m][n] = (f32x4){0.f, 0.f, 0.f, 0.f};
    f16x8 At[4][2], B0[2][2], B1[2][2];
    const char* cA = (const char*)g.A + (size_t)cur.pm * tstep; const char* cB = (const char*)g.Bt + (size_t)cur.pn * tstep;
    if constexpr (SP2) {
        PG8_STAGE(PG8_SB(0, 0), cB, voffB); PG8_STAGE(PG8_SB(0, 1), cB + hstep, voffB); PG8_STAGE(PG8_SA(0, 0), cA, voffA); PG8_STAGE(PG8_SA(0, 1), cA + hstep, voffA);
        if (wr == 1) PG8_BAR;
        PG8_WAIT_V(2); PG8_BAR;
        PG8_STAGE(PG8_SB(1, 0), cB + kstep, voffB); PG8_STAGE(PG8_SA(1, 0), cA + kstep, voffA); PG8_STAGE(PG8_SB(1, 1), cB + hstep + kstep, voffB);
        PG8_WAIT_V(6); PG8_BAR;
    } else {
        PG8_STAGE(PG8_SB(0, 0), cB, voffB); PG8_STAGE(PG8_SA(0, 0), cA, voffA); PG8_STAGE(PG8_SB(0, 1), cB + hstep, voffB); PG8_STAGE(PG8_SA(0, 1), cA + hstep, voffA);
        if (wr == 1) PG8_BAR;
        PG8_WAIT_V(4); PG8_BAR;
        PG8_STAGE(PG8_SB(1, 0), cB + kstep, voffB); PG8_STAGE(PG8_SA(1, 0), cA + kstep, voffA); PG8_STAGE(PG8_SB(1, 1), cB + hstep + kstep, voffB);
        PG8_WAIT_V(6); PG8_BAR;
    }
    for (;;) {
        const bool has_next = S.next(ui + 1, nxt);
        const char* nA = has_next ? (const char*)g.A + (size_t)nxt.pm * tstep : cA; const char* nB = has_next ? (const char*)g.Bt + (size_t)nxt.pn * tstep : cB;
        for (int t = 0; t < nt; t += 2) {
            const bool last = (t == nt - 2);
            const char* a1 = cA + (size_t)(t + 1) * kstep;
            const char* a2 = last ? nA : cA + (size_t)(t + 2) * kstep; const char* b2 = last ? nB : cB + (size_t)(t + 2) * kstep;
            const char* a3 = a2 + kstep; const char* b3 = b2 + kstep;
            if constexpr (SP2) {
            PG8_LDB(B0, 0, 0); PG8_LDB(B1, 0, 1); PG8_SCHED; PG8_LDA(At, 0, 0); PG8_STAGE(PG8_SA(1, 1), a1 + hstep, voffA);
            PG8_WAIT_V(8); PG8_WAIT_L(0); PG8_BAR; PG8_MMA(0, 0, At, B0); PG8_MMA(0, 1, At, B1); PG8_BAR; PG8_SCHED;
            PG8_LDA(At, 0, 1); PG8_STAGE(PG8_SB(0, 0), b2, voffB); PG8_STAGE(PG8_SB(0, 1), b2 + hstep, voffB); PG8_STAGE(PG8_SA(0, 0), a2, voffA);
            PG8_WAIT_V(8); PG8_WAIT_L(0); PG8_BAR; PG8_MMA(1, 0, At, B0); PG8_MMA(1, 1, At, B1); PG8_BAR; PG8_SCHED;
            PG8_LDB(B0, 1, 0); PG8_LDB(B1, 1, 1); PG8_SCHED; PG8_LDA(At, 1, 0); PG8_STAGE(PG8_SA(0, 1), a2 + hstep, voffA);
            PG8_WAIT_V(8); PG8_WAIT_L(0); PG8_BAR; PG8_MMA(0, 0, At, B0); PG8_MMA(0, 1, At, B1); PG8_BAR; PG8_SCHED;
            PG8_LDA(At, 1, 1); PG8_STAGE(PG8_SB(1, 0), b3, voffB); PG8_STAGE(PG8_SB(1, 1), b3 + hstep, voffB); PG8_STAGE(PG8_SA(1, 0), a3, voffA);
            PG8_WAIT_V(8); PG8_WAIT_L(0); PG8_BAR; PG8_MMA(1, 0, At, B0); PG8_MMA(1, 1, At, B1); PG8_BAR; PG8_SCHED;
            } else {
            PG8_LDB(B0, 0, 0); PG8_SCHED; PG8_LDA(At, 0, 0); PG8_STAGE(PG8_SA(1, 1), a1 + hstep, voffA);
            PG8_WAIT_L(8); PG8_BAR; PG8_WAIT_L(0); PG8_MMA(0, 0, At, B0); PG8_BAR; PG8_SCHED;
            PG8_LDB(B1, 0, 1); PG8_STAGE(PG8_SB(0, 0), b2, voffB);
            PG8_BAR; PG8_WAIT_L(0); PG8_MMA(0, 1, At, B1); PG8_BAR;
            PG8_LDA(At, 0, 1); PG8_STAGE(PG8_SA(0, 0), a2, voffA);
            PG8_BAR; PG8_WAIT_L(0); PG8_MMA(1, 0, At, B0); PG8_BAR; PG8_SCHED;
            PG8_STAGE(PG8_SB(0, 1), b2 + hstep, voffB);
            PG8_WAIT_V(6); PG8_BAR; PG8_MMA(1, 1, At, B1); PG8_BAR;
            PG8_LDB(B0, 1, 0); PG8_SCHED; PG8_LDA(At, 1, 0); PG8_STAGE(PG8_SA(0, 1), a2 + hstep, voffA);
            PG8_WAIT_L(8); PG8_BAR; PG8_WAIT_L(0); PG8_MMA(0, 0, At, B0); PG8_BAR; PG8_SCHED;
            PG8_LDB(B1, 1, 1); PG8_STAGE(PG8_SB(1, 0), b3, voffB);
            PG8_BAR; PG8_WAIT_L(0); PG8_MMA(0, 1, At, B1); PG8_BAR;
            PG8_LDA(At, 1, 1); PG8_STAGE(PG8_SA(1, 0), a3, voffA);
            PG8_BAR; PG8_WAIT_L(0); PG8_MMA(1, 0, At, B0); PG8_BAR; PG8_SCHED;
            PG8_STAGE(PG8_SB(1, 1), b3 + hstep, voffB);
            PG8_WAIT_V(6); PG8_BAR; PG8_MMA(1, 1, At, B1); PG8_BAR;
            }
        }
        if constexpr (ALIGN_EPI) { if (wr == 0) PG8_BAR; }
        if constexpr (!Epi::AFTER_DRAIN) E(acc, cur, wr, wc, fr, fq);
        if (!has_next) break;
#pragma unroll
        for (int a = 0; a < 2; ++a)
#pragma unroll
            for (int b = 0; b < 2; ++b)
#pragma unroll
                for (int m = 0; m < 4; ++m)
#pragma unroll
                    for (int n = 0; n < 2; ++n) acc[a][b][m][n] = (f32x4){0.f, 0.f, 0.f, 0.f};
        cur = nxt; cA = nA; cB = nB; ++ui;
        if constexpr (ALIGN_EPI) { if (wr == 1) PG8_BAR; }
    }
    PG8_WAIT_V(0);
    if constexpr (!ALIGN_EPI) { if (wr == 0) PG8_BAR; }
    PG8_BAR;
    if constexpr (Epi::AFTER_DRAIN) E.fused(acc, cur, wr, wc, fr, fq, lds, wid, lane);
#undef PG8_SA
#undef PG8_SB
#undef PG8_STAGE
#undef PG8_LDA
#undef PG8_LDB
#undef PG8_MMA
#undef PG8_WAIT_V
#undef PG8_WAIT_L
#undef PG8_BAR
#undef PG8_SCHED
}
}

#define XB_TMO      128
#define XB_XCNT(j)  (256  + 64 * (j))
#define XB_XSUB(j)  (1280 + 64 * (j))
#define XB_XGEN(j)  (2304 + 64 * (j))
#define XB_TOP      3328
#define XB_TOPGEN   3392
#define XCD_BAR_WORDS 3456
#define XB_SPIN_CAP (1u << 18)
__device__ __forceinline__ unsigned xb_ld(unsigned* p)              { return __hip_atomic_load(p, __ATOMIC_RELAXED, __HIP_MEMORY_SCOPE_AGENT); }
__device__ __forceinline__ unsigned xb_add(unsigned* p, unsigned v) { return __hip_atomic_fetch_add(p, v, __ATOMIC_RELAXED, __HIP_MEMORY_SCOPE_AGENT); }
__device__ __forceinline__ unsigned xb_xcc_id() { return (unsigned)__builtin_amdgcn_s_getreg((3 << 11) | 20) & 0xFu; }
#define XB_SPIN(cond, bar) do { unsigned _sp = 0; while (cond) { __builtin_amdgcn_s_sleep(1); \
    if ((++_sp & 255u) == 0u) { if (xb_ld(&(bar)[XB_TMO])) break; if (_sp > XB_SPIN_CAP) { atomicAdd(&(bar)[XB_TMO], 1u); break; } } } } while (0)
struct XcdBarrier { unsigned* bar; unsigned x; volatile LAS unsigned* st; };
__device__ __forceinline__ XcdBarrier xcd_barrier_post(unsigned* bar, volatile LAS unsigned* st) {
    XcdBarrier b; b.bar = bar; b.x = xb_xcc_id(); b.st = st;
    if (threadIdx.x == 0) (void)xb_add(&bar[XB_XCNT(b.x)], 1u);
    return b;
}
__device__ __forceinline__ void xcd_barrier_complete(unsigned* bar, unsigned x, unsigned& nloc, unsigned& nx) {
    const unsigned G = gridDim.x * gridDim.y * gridDim.z;
    unsigned sum, cnt, mine, sp = 0u;
    for (;;) {
        sum = 0u; cnt = 0u; mine = 0u;
#pragma unroll
        for (unsigned j = 0; j < 16; ++j) { const unsigned c = xb_ld(&bar[XB_XCNT(j)]); sum += c; cnt += (c > 0u) ? 1u : 0u; mine = (j == x) ? c : mine; }
        if (sum == G) break;
        __builtin_amdgcn_s_sleep(1);
        if ((++sp & 255u) == 0u) { if (xb_ld(&bar[XB_TMO])) break; if (sp > XB_SPIN_CAP) { atomicAdd(&bar[XB_TMO], 1u); break; } }
    }
    nloc = mine > 0u ? mine : 1u; nx = cnt > 0u ? cnt : 1u;
}
__device__ __forceinline__ void xcd_barrier(const XcdBarrier& b, int wave_id) {
    asm volatile("s_waitcnt vmcnt(0)" ::: "memory");
    __syncthreads();
    if (wave_id == 0 && lane_id_fresh() == 0) {
        unsigned* bar = b.bar;
        __builtin_amdgcn_s_waitcnt(0);
        unsigned nloc = b.st[0], nx = b.st[1];
        if (nloc == 0u) { xcd_barrier_complete(bar, b.x, nloc, nx); b.st[0] = nloc; b.st[1] = nx; }
        const unsigned old = xb_add(&bar[XB_XSUB(b.x)], 1u);
        const unsigned gen = old / nloc;
        if (old + 1u == (gen + 1u) * nloc) {
            __builtin_amdgcn_fence(__ATOMIC_RELEASE, "agent");
            asm volatile("s_waitcnt vmcnt(0)" ::: "memory");
            const unsigned og = xb_add(&bar[XB_TOP], 1u);
            const unsigned tg = og / nx;
            if (og + 1u == (tg + 1u) * nx) xb_add(&bar[XB_TOPGEN], 1u);
            else XB_SPIN(xb_ld(&bar[XB_TOPGEN]) == tg, bar);
            __builtin_amdgcn_fence(__ATOMIC_ACQUIRE, "agent");
            xb_add(&bar[XB_XGEN(b.x)], 1u);
            asm volatile("s_waitcnt vmcnt(0)" ::: "memory");
        } else {
            XB_SPIN(xb_ld(&bar[XB_XGEN(b.x)]) == gen, bar);
            __builtin_amdgcn_fence(__ATOMIC_ACQUIRE, "agent");
            asm volatile("s_waitcnt vmcnt(0)" ::: "memory");
        }
    }
    __syncthreads();
}

struct Args { const float* in[N_IN]; float* out; unsigned char* ws; int ph_lo, ph_hi; };
static_assert(sizeof(Args) == N_IN * 8 + 8 + 8 + 8, "Args has no padding");

struct Ctx {
    const float* const* in; float* out; unsigned char* ws;
    LAS unsigned char* lds;
    int tid, lane, wave, gw, ngw, bid, G;
};
#define WSP(T, off) ((T*)(C.ws + (off)))
__device__ __forceinline__ Ctx ctx_fresh(const Ctx& C0) {
    Ctx C = C0; C.lane = lane_id_fresh(); C.tid = C.wave * 64 + C.lane;
    int bid = blockIdx.x, G = gridDim.x; asm volatile("" : "+s"(bid), "+s"(G));
    C.bid = bid; C.G = G; C.gw = bid * 8 + C.wave; C.ngw = G * 8;
    return C;
}

__device__ __forceinline__ int wq_next(unsigned* ctr, int lane) {
    unsigned v = 0;
    if (lane == 0) v = __hip_atomic_fetch_add(ctr, 1u, __ATOMIC_RELAXED, __HIP_MEMORY_SCOPE_AGENT);
    return (int)__builtin_amdgcn_readfirstlane(v);
}

__device__ __forceinline__ void transpose_item(const float* W, int ldw, f16* WT, int ldt, int dst_row0, int k0, int n0, LAS float* scr, int lane) {
    f32x4 wv[8];
#pragma unroll
    for (int i = 0; i < 8; ++i) wv[i] = __builtin_nontemporal_load((const f32x4*)(W + (size_t)(k0 + 8 * i + (lane >> 3)) * ldw + n0 + 4 * (lane & 7)));
#pragma unroll
    for (int i = 0; i < 8; ++i) { LAS float* d = scr + (8 * i + (lane >> 3)) * 33 + 4 * (lane & 7); d[0] = wv[i][0]; d[1] = wv[i][1]; d[2] = wv[i][2]; d[3] = wv[i][3]; }
    asm volatile("s_waitcnt lgkmcnt(0)" ::: "memory");
    const int c = lane & 7;
#pragma unroll
    for (int j = 0; j < 4; ++j) { const int n = (lane >> 3) + 8 * j; const LAS float* s = scr + (8 * c) * 33 + n;
        const f16x8 o = pack8(cvt4(s[0 * 33], s[1 * 33], s[2 * 33], s[3 * 33]), cvt4(s[4 * 33], s[5 * 33], s[6 * 33], s[7 * 33]));
        *(f16x8*)(WT + (size_t)(dst_row0 + n) * ldt + k0 + 8 * c) = o; }
    asm volatile("s_waitcnt lgkmcnt(0)" ::: "memory");
}
__device__ __forceinline__ void phase_prep(const Ctx& C0) {
    const Ctx C = ctx_fresh(C0);
    {
        LAS float* sc = (LAS float*)C.lds;
        LAS float* red = (LAS float*)(C.lds + 20480);
        const float* cv = C.in[I_C]; const float* cctx = C.in[I_CCTX];
        for (int i = C.tid; i < 5 * 1024; i += 512) { const int c = i >> 10, k = i & 1023; const float v = (c < 4) ? cv[c * 1024 + k] : cctx[k]; sc[i] = v / (1.0f + __expf(-v)); }
        __syncthreads();
        float* mod = WSP(float, WS_MOD);
        for (int item = C.bid; item < 2 * 144; item += C.G) {
            const int l = item / 144, j0 = (item % 144) * 64, k0 = C.wave * 128;
            const float* wp = C.in[I_WADA] + ((size_t)l * 1024 + k0) * NMODV + j0 + C.lane;
            float a0 = 0.f, a1 = 0.f, a2 = 0.f, a3 = 0.f, a4 = 0.f;
#pragma unroll 16
            for (int kk = 0; kk < 128; ++kk) {
                const float w = __builtin_nontemporal_load(&wp[(size_t)kk * NMODV]);
                a0 += sc[0 * 1024 + k0 + kk] * w; a1 += sc[1 * 1024 + k0 + kk] * w; a2 += sc[2 * 1024 + k0 + kk] * w; a3 += sc[3 * 1024 + k0 + kk] * w; a4 += sc[4 * 1024 + k0 + kk] * w;
            }
            red[(C.wave * 5 + 0) * 64 + C.lane] = a0; red[(C.wave * 5 + 1) * 64 + C.lane] = a1; red[(C.wave * 5 + 2) * 64 + C.lane] = a2;
            red[(C.wave * 5 + 3) * 64 + C.lane] = a3; red[(C.wave * 5 + 4) * 64 + C.lane] = a4;
            __syncthreads();
            if (C.tid < 320) { const int c = C.tid >> 6, ln = C.tid & 63; float s = 0.f;
#pragma unroll
                for (int w = 0; w < 8; ++w) s += red[(w * 5 + c) * 64 + ln];
                mod[((size_t)l * 5 + c) * NMODV + j0 + ln] = s + C.in[I_BADA][(size_t)l * NMODV + j0 + ln]; }
            __syncthreads();
        }
    }
    __syncthreads();
    {
        LAS float* scr = (LAS float*)(C.lds + C.wave * 16384);
        constexpr int IFI = 16 * 176, IFO = 44 * 32, IIN = 16 * 67, IOUT = 16 * 32;
        constexpr int NIT = 4 * IFI + 4 * IFO + 2 * IIN + 2 * IOUT;
        for (int it = C.gw; it < NIT; it += C.ngw) {
            int r = it;
            if (r < 4 * IFI) { const int mat = r / IFI, rr = r % IFI, kb = rr / 176, n0 = (rr % 176) * 32;
                const int drow = (n0 < DFF) ? ((n0 >> 7) * 256 + (n0 & 127)) : (((n0 - DFF) >> 7) * 256 + 128 + ((n0 - DFF) & 127));
                transpose_item(C.in[I_WFI] + (size_t)mat * 1024 * NFF2, NFF2, WSP(f16, WS_WFI) + (size_t)mat * NFF2 * 1024, 1024, drow, kb * 64, n0, scr, C.lane); continue; }
            r -= 4 * IFI;
            if (r < 4 * IFO) { const int mat = r / IFO, rr = r % IFO, kb = rr / 32, n0 = (rr % 32) * 32;
                transpose_item(C.in[I_WFO] + (size_t)mat * DFF * 1024, 1024, WSP(f16, WS_WFO) + (size_t)mat * 1024 * DFF, DFF, n0, kb * 64, n0, scr, C.lane); continue; }
            r -= 4 * IFO;
            if (r < 2 * IIN) { const int l = r / IIN, rr = r % IIN, kb = rr / 67, n0 = (rr % 67) * 32;
                transpose_item(C.in[I_WIN] + (size_t)l * 1024 * DIN, DIN, WSP(f16, WS_WIN) + (size_t)l * DINP * 1024, 1024, n0, kb * 64, n0, scr, C.lane); continue; }
            r -= 2 * IIN;
            { const int l = r / IOUT, rr = r % IOUT, kb = rr / 32, n0 = (rr % 32) * 32;
                transpose_item(C.in[I_WOUT] + (size_t)l * 1024 * 1024, 1024, WSP(f16, WS_WOUT) + (size_t)l * 1024 * 1024, 1024, n0, kb * 64, n0, scr, C.lane); }
        }
    }
    {
        const int gt = C.bid * 512 + C.tid, ngt = C.G * 512;
        for (int i = gt; i < 2 * 160 * 128; i += ngt) { const int l = i / (160 * 128), rr = i % (160 * 128);
            unsigned z = 0u; asm volatile("" : "+v"(z));
            *(u32x4*)(WSP(f16, WS_WIN) + ((size_t)l * DINP + DIN) * 1024 + (size_t)rr * 8) = (u32x4){z, z, z, z}; }
        f16* wuq = WSP(f16, WS_WUQ);
        for (int i = gt; i < 2 * 384 * 192; i += ngt) { const int e = i & 7, r = (i >> 3) & 31, rest = i >> 8, c = rest % 24, rest2 = rest / 24, t3 = rest2 % 3, lh = rest2 / 3, l = lh >> 2, hd = lh & 3;
            wuq[i] = (f16)(C.in[I_CQN][l * 192 + 8 * c + e] * C.in[I_WUQ][(size_t)l * 192 * 384 + (size_t)(8 * c + e) * 384 + hd * 96 + 32 * t3 + r]); }
        f16* wukv = WSP(f16, WS_WUKV);
        for (int i = gt; i < 2 * 512 * 128; i += ngt) { const int e = i & 7, r = (i >> 3) & 31, rest = i >> 8, c = rest & 15, rest2 = rest >> 4, t4 = rest2 & 3, lh = rest2 >> 2, l = lh >> 2, hd = lh & 3;
            const float w = C.in[I_WUKV][(size_t)l * 128 * 512 + (size_t)(8 * c + e) * 512 + hd * 128 + 32 * t4 + r];
            wukv[i] = (f16)(C.in[I_CKVN][l * 128 + 8 * c + e] * w); WSP(f16, WS_WUKV0)[i] = (f16)w; }
        for (int i = gt; i < 4096; i += ngt) WSP(f16, WS_IDN)[i] = ((i >> 6) == (i & 63)) ? (f16)1.0f : (f16)0.0f;
        f16* wg = WSP(f16, WS_WG);
        for (int i = gt; i < 64 * 4096; i += ngt) { const int m = i >> 12, d = (i >> 6) & 63, c = i & 63; wg[i] = (f16)C.in[I_WGATE][(size_t)m * 4096 + c * 64 + d]; }
    }
}

template <bool FIRST>
__device__ __forceinline__ void phase_norm(const Ctx& C0, int l, int sub) {
    const Ctx C = ctx_fresh(C0);
    const float* gvec = C.in[I_NG] + ((size_t)l * 3 + sub) * DM;
    const float* modl = WSP(float, WS_MOD) + (size_t)l * 5 * NMODV;
    f16* H = WSP(f16, WS_H);
    for (int row = C.gw; row < M; row += C.ngw) {
        const float* src = FIRST ? ((row < MP) ? C.in[I_XP] + (size_t)row * DM : C.in[I_XS] + (size_t)(row - MP) * DM) : C.out + (size_t)row * DM;
        const int cond = (row < MP) ? 4 : ((row - MP) >> 11);
        const float* shp = modl + (size_t)cond * NMODV + (3 * sub) * DM; const float* scp = shp + DM;
        f32x4 v[4]; float ss = 0.f;
#pragma unroll
        for (int j = 0; j < 4; ++j) { v[j] = FIRST ? __builtin_nontemporal_load((const f32x4*)(src + 256 * j + 4 * C.lane)) : *(const f32x4*)(src + 256 * j + 4 * C.lane); ss += (v[j].x * v[j].x + v[j].y * v[j].y) + (v[j].z * v[j].z + v[j].w * v[j].w); }
        const float rstd = 1.0f / sqrtf(wave_sum(ss) * (1.0f / DM) + EPS);
        f32x4 gs[4], shv[4];
#pragma unroll
        for (int j = 0; j < 4; ++j) { const int k = 256 * j + 4 * C.lane; gs[j] = *(const f32x4*)(gvec + k) * (*(const f32x4*)(scp + k) + 1.0f); shv[j] = *(const f32x4*)(shp + k); }
#pragma unroll
        for (int j = 0; j < 4; ++j) {
            const int k = 256 * j + 4 * C.lane;
            *(f16x4*)(H + (size_t)row * DM + k) = cvt4v(v[j] * rstd * gs[j] + shv[j]);
            if (FIRST) *(f16x4*)(WSP(f16, WS_XH) + (size_t)row * DM + k) = cvt4v(v[j]);
        }
    }
}

__device__ __forceinline__ void glds16(const void* gsrc, unsigned lds_dst) { unsigned keep;
    asm volatile("s_mov_b32 %0, m0\n\ts_mov_b32 m0, %2\n\ts_nop 0\n\tglobal_load_lds_dwordx4 %1, off\n\ts_mov_b32 m0, %0" : "=&s"(keep) : "v"(gsrc), "s"(lds_dst) : "memory"); }
#define ATT_GLDS(g, l) glds16((const void*)(g), (unsigned)__builtin_amdgcn_readfirstlane((unsigned)(uintptr_t)(l)))
#define ATT_WAITBAR(N) asm volatile("s_waitcnt vmcnt(" #N ") lgkmcnt(0)\n\ts_barrier" ::: "memory")
#define ATT_LBAR() asm volatile("s_waitcnt lgkmcnt(0)\n\ts_barrier" ::: "memory")
struct MxTok { int b, t, key, ktile, kin; size_t row, ob; };
template <int KIND>
__device__ __forceinline__ MxTok mx_decode(int wt, int tok, int l) {
    MxTok m; m.row = 0;
    if (KIND == 0) { m.row = (size_t)wt * 32 + tok; m.b = (int)(m.row >> 8); m.t = (int)(m.row & 255); m.key = m.t; }
    else if (KIND == 1) { m.row = (size_t)wt * 32 + tok; const int rs = (int)m.row - MP; m.b = rs >> 11; m.t = rs & 2047; m.key = PAST + m.t; }
    else { const int idx = (wt - 512) * 32 + tok; m.b = idx >> 9; m.t = idx & 511; m.key = m.t; }
    m.ktile = m.key >> 6; m.kin = m.key & 63; m.ob = ((size_t)m.b * 2 + l) * TP + m.t;
    return m;
}
template <int KIND>
__device__ __forceinline__ void mx_rope(int t, int hi, float (&cr)[4], float (&sr)[4], float (&cc)[4], float (&scn)[4]) {
#pragma unroll
    for (int e = 0; e < 4; ++e) { cr[e] = 1.f; sr[e] = 0.f; cc[e] = 1.f; scn[e] = 0.f; }
    if (KIND == 1) {
        const float gr = (float)(t >> 6), gc = (float)(t & 63);
#pragma unroll
        for (int e = 0; e < 4; ++e) { const float inv = exp2f(-(float)(4 * hi + e) * (13.287712379549449f / 8.0f));
            const float fr = gr * inv * 0.15915494309189535f, fc = gc * inv * 0.15915494309189535f;
            sr[e] = __builtin_amdgcn_sinf(fr); cr[e] = __builtin_amdgcn_cosf(fr); scn[e] = __builtin_amdgcn_sinf(fc); cc[e] = __builtin_amdgcn_cosf(fc); }
    }
}
template <int KIND, int SUB>
__device__ __forceinline__ void mx_a(const Ctx& C, int l, int wt) {
    const int lane = lane_id_fresh(), tok = lane & 31, hi = lane >> 5;
    constexpr int Tk = (KIND == 0) ? TP : TKS, NT = Tk / 64;
    const MxTok m = mx_decode<KIND>(wt, tok, l);
    const f16* prow = WSP(f16, WS_ACT) + m.row * DINP;
    f16* KA = (KIND == 0) ? WSP(f16, WS_KAP) : WSP(f16, WS_KAS);
    f16* VA = (KIND == 0) ? WSP(f16, WS_VATP) : WSP(f16, WS_VATS);
    if (SUB < 2) {
        if (KIND != 2) {
            constexpr int qk = SUB;
            float cr[4], sr[4], cc[4], scn[4];
            mx_rope<KIND>(m.t, hi, cr, sr, cc, scn);
            f32x4 gain[4];
#pragma unroll
            for (int g = 0; g < 4; ++g) gain[g] = *(const f32x4*)(C.in[I_DQKN] + ((size_t)l * 2 + qk) * 32 + 8 * g + 4 * hi);
            f16x4 raw[8][4];
#pragma unroll
            for (int hc = 0; hc < 8; ++hc)
#pragma unroll
                for (int g = 0; g < 4; ++g) raw[hc][g] = *(const f16x4*)(prow + (qk ? PC_KA : PC_QA) + hc * 32 + 4 * hi + 8 * g);
#pragma unroll
            for (int hc = 0; hc < 8; ++hc) {
                f32x4 x[4]; float ss = 0.f;
#pragma unroll
                for (int g = 0; g < 4; ++g) { x[g] = tof32(raw[hc][g]); ss += (x[g].x * x[g].x + x[g].y * x[g].y) + (x[g].z * x[g].z + x[g].w * x[g].w); }
                ss += __shfl_xor(ss, 32);
                const float rstd = 1.0f / sqrtf(ss * (1.0f / 32.0f) + EPS);
#pragma unroll
                for (int g = 0; g < 4; ++g) x[g] = x[g] * rstd * gain[g];
                if (qk == 1 && KIND == 0) {
                    float* o = C.out + OUT_DK + m.ob * 256 + hc * 32 + 4 * hi;
#pragma unroll
                    for (int g = 0; g < 4; ++g) *(f32x4*)(o + 8 * g) = x[g];
                }
                if (KIND == 1) {
#pragma unroll
                    for (int e = 0; e < 4; ++e) {
                        const float a1 = x[0][e], a2 = x[2][e]; x[0][e] = a1 * cr[e] - a2 * sr[e]; x[2][e] = a2 * cr[e] + a1 * sr[e];
                        const float b1 = x[1][e], b2 = x[3][e]; x[1][e] = b1 * cc[e] - b2 * scn[e]; x[3][e] = b2 * cc[e] + b1 * scn[e];
                    }
                }
                if (qk == 0) {
                    const float sc = 0.17677669529663687f * LOG2E;
                    f16* o = WSP(f16, WS_QA) + m.row * 256 + hc * 32 + 4 * hi;
#pragma unroll
                    for (int g = 0; g < 4; ++g) *(f16x4*)(o + 8 * g) = cvt4v(x[g] * sc);
                } else {
                    f16* o = KA + ((((size_t)m.b * 4 + (hc >> 1)) * NT + m.ktile) * 8 + (hc & 1) * 4) * 512 + m.kin * 8 + 4 * hi;
#pragma unroll
                    for (int g = 0; g < 4; ++g) *(f16x4*)(o + g * 512) = cvt4v(x[g]);
                }
            }
        } else if (SUB == 1) {
            const float* ck = C.in[I_CDK] + (((size_t)m.b * 2 + l) * PAST + m.t) * 256;
            f32x4 raw[8][4];
#pragma unroll
            for (int hc = 0; hc < 8; ++hc)
#pragma unroll
                for (int g = 0; g < 4; ++g) raw[hc][g] = *(const f32x4*)(ck + hc * 32 + 4 * hi + 8 * g);
#pragma unroll
            for (int hc = 0; hc < 8; ++hc) {
                f16* o = KA + ((((size_t)m.b * 4 + (hc >> 1)) * NT + m.ktile) * 8 + (hc & 1) * 4) * 512 + m.kin * 8 + 4 * hi;
#pragma unroll
                for (int g = 0; g < 4; ++g) *(f16x4*)(o + g * 512) = cvt4v(raw[hc][g]);
            }
        }
    } else {
        if (KIND != 2) {
            f16x8 rawv[4][4];
#pragma unroll
            for (int hd = 0; hd < 4; ++hd)
#pragma unroll
                for (int j = 0; j < 4; ++j) rawv[hd][j] = *(const f16x8*)(prow + PC_VA + hd * 64 + 32 * hi + 8 * j);
#pragma unroll
            for (int hd = 0; hd < 4; ++hd) {
                f16* vt = VA + ((((size_t)m.b * 4 + hd) * NT + m.ktile) * 2 + hi) * 2048 + m.kin * 32;
#pragma unroll
                for (int j = 0; j < 4; ++j) {
                    const f16x8 v = rawv[hd][j];
                    if (KIND == 0) {
                        float* o = C.out + OUT_DV + m.ob * 256 + hd * 64 + 32 * hi + 8 * j;
                        *(f32x4*)o = (f32x4){(float)v[0], (float)v[1], (float)v[2], (float)v[3]}; *(f32x4*)(o + 4) = (f32x4){(float)v[4], (float)v[5], (float)v[6], (float)v[7]};
                    }
                    *(f16x8*)(vt + 8 * j) = v;
                }
            }
        } else {
            const float* cvp = C.in[I_CDV] + (((size_t)m.b * 2 + l) * PAST + m.t) * 256;
#pragma unroll
            for (int hd = 0; hd < 4; ++hd) {
                f16* vt = VA + ((((size_t)m.b * 4 + hd) * NT + m.ktile) * 2 + hi) * 2048 + m.kin * 32;
                f32x4 rawc[8];
#pragma unroll
                for (int j = 0; j < 8; ++j) rawc[j] = *(const f32x4*)(cvp + hd * 64 + 32 * hi + 4 * j);
#pragma unroll
                for (int j = 0; j < 8; ++j) *(f16x4*)(vt + 4 * j) = cvt4v(rawc[j]);
            }
        }
    }
}
template <int KIND>
__device__ __forceinline__ void mx_q(const Ctx& C, int l, int wt, int hd, LAS unsigned char* wl) {
    const int lane = lane_id_fresh(), tok = lane & 31, hi = lane >> 5;
    const MxTok m = mx_decode<KIND>(wt, tok, l);
    const f16* prow = WSP(f16, WS_ACT) + m.row * DINP;
    float cr[4], sr[4], cc[4], scn[4];
    mx_rope<KIND>(m.t, hi, cr, sr, cc, scn);
    f16x8 bq[12]; float ss = 0.f;
#pragma unroll
    for (int ks = 0; ks < 12; ++ks) { bq[ks] = *(const f16x8*)(prow + PC_CQ + 16 * ks + 8 * hi);
#pragma unroll
        for (int e = 0; e < 8; ++e) { const float f = (float)bq[ks][e]; ss += f * f; } }
    ss += __shfl_xor(ss, 32);
    const float rstd = 1.0f / sqrtf(ss * (1.0f / 192.0f) + EPS);
    const float* gq = C.in[I_QKN] + ((size_t)l * 2 + 0) * 96;
    f32x4 gqv[3][4];
#pragma unroll
    for (int t3 = 0; t3 < 3; ++t3)
#pragma unroll
        for (int g = 0; g < 4; ++g) gqv[t3][g] = *(const f32x4*)(gq + 32 * t3 + 8 * g + 4 * hi);
    ATT_WAITBAR(0);
    LAS unsigned char* wp = wl + hi * 512 + tok * 16;
    f32x16 acc[3];
#pragma unroll
    for (int t3 = 0; t3 < 3; ++t3) { acc[t3] = (f32x16){};
#pragma unroll
        for (int ks = 0; ks < 12; ++ks) acc[t3] = MFMA32(*(const LAS f16x8*)(wp + (t3 * 24 + 2 * ks) * 512), bq[ks], acc[t3]); }
    float s2 = 0.f;
#pragma unroll
    for (int t3 = 0; t3 < 3; ++t3)
#pragma unroll
        for (int r = 0; r < 16; ++r) s2 += acc[t3][r] * acc[t3][r];
    s2 += __shfl_xor(s2, 32);
    const float rs = rstd / sqrtf(s2 * (rstd * rstd) * (1.0f / 96.0f) + EPS);
#pragma unroll
    for (int t3 = 0; t3 < 3; ++t3)
#pragma unroll
        for (int g = 0; g < 4; ++g) { const f32x4 gg = gqv[t3][g];
#pragma unroll
            for (int e = 0; e < 4; ++e) acc[t3][4 * g + e] *= rs * gg[e]; }
    if (KIND == 1) {
#pragma unroll
        for (int e = 0; e < 4; ++e) {
            const float a1 = acc[2][e], a2 = acc[2][8 + e]; acc[2][e] = a1 * cr[e] - a2 * sr[e]; acc[2][8 + e] = a2 * cr[e] + a1 * sr[e];
            const float b1 = acc[2][4 + e], b2 = acc[2][12 + e]; acc[2][4 + e] = b1 * cc[e] - b2 * scn[e]; acc[2][12 + e] = b2 * cc[e] + b1 * scn[e];
        }
    }
    const float sc = 0.10206207261596575f * LOG2E;
    f16* o = WSP(f16, WS_QC) + m.row * 384 + hd * 96 + 4 * hi;
#pragma unroll
    for (int t3 = 0; t3 < 3; ++t3)
#pragma unroll
        for (int g = 0; g < 4; ++g) *(f16x4*)(o + 32 * t3 + 8 * g) = cvt4(acc[t3][4 * g] * sc, acc[t3][4 * g + 1] * sc, acc[t3][4 * g + 2] * sc, acc[t3][4 * g + 3] * sc);
}
template <int KIND>
__device__ __forceinline__ void mx_kv(const Ctx& C, int l, int wt, int hd, LAS unsigned char* wl) {
    const int lane = lane_id_fresh(), tok = lane & 31, hi = lane >> 5;
    constexpr int Tk = (KIND == 0) ? TP : TKS, NT = Tk / 64;
    const MxTok m = mx_decode<KIND>(wt, tok, l);
    const f16* prow = WSP(f16, WS_ACT) + m.row * DINP;
    f16* KC = (KIND == 0) ? WSP(f16, WS_KCP) : WSP(f16, WS_KCS);
    f16* VC = (KIND == 0) ? WSP(f16, WS_VCTP) : WSP(f16, WS_VCTS);
    float cr[4], sr[4], cc[4], scn[4];
    mx_rope<KIND>(m.t, hi, cr, sr, cc, scn);
    f16x8 bk[8]; f32x4 kr[4]; float rstd = 1.0f;
    if (KIND != 2) {
        float ss = 0.f;
#pragma unroll
        for (int ks = 0; ks < 8; ++ks) { bk[ks] = *(const f16x8*)(prow + PC_CKV + 16 * ks + 8 * hi);
#pragma unroll
            for (int e = 0; e < 8; ++e) { const float f = (float)bk[ks][e]; ss += f * f; } }
        ss += __shfl_xor(ss, 32);
        rstd = 1.0f / sqrtf(ss * (1.0f / 128.0f) + EPS);
        if (KIND == 0 && hd == 0) {
            f32x4 gv0[8], gv1[8];
#pragma unroll
            for (int ks = 0; ks < 8; ++ks) { gv0[ks] = *(const f32x4*)(C.in[I_CKVN] + (size_t)l * 128 + 16 * ks + 8 * hi); gv1[ks] = *(const f32x4*)(C.in[I_CKVN] + (size_t)l * 128 + 16 * ks + 8 * hi + 4); }
#pragma unroll
            for (int ks = 0; ks < 8; ++ks) {
                const f32x4 g0 = gv0[ks], g1 = gv1[ks];
                const f16x8 v = bk[ks];
                float* o = C.out + OUT_CKV + m.ob * 128 + 16 * ks + 8 * hi;
                *(f32x4*)o = (f32x4){(float)v[0] * rstd * g0[0], (float)v[1] * rstd * g0[1], (float)v[2] * rstd * g0[2], (float)v[3] * rstd * g0[3]};
                *(f32x4*)(o + 4) = (f32x4){(float)v[4] * rstd * g1[0], (float)v[5] * rstd * g1[1], (float)v[6] * rstd * g1[2], (float)v[7] * rstd * g1[3]};
            }
        }
#pragma unroll
        for (int g = 0; g < 4; ++g) kr[g] = tof32(*(const f16x4*)(prow + PC_KR + 8 * g + 4 * hi));
        if (KIND == 0 && hd == 0) { float* o = C.out + OUT_KR + m.ob * 32 + 4 * hi;
#pragma unroll
            for (int g = 0; g < 4; ++g) *(f32x4*)(o + 8 * g) = kr[g]; }
    } else {
        const float* cp = C.in[I_CCKV] + (((size_t)m.b * 2 + l) * PAST + m.t) * 128;
#pragma unroll
        for (int ks = 0; ks < 8; ++ks) bk[ks] = pack8(cvt4v(*(const f32x4*)(cp + 16 * ks + 8 * hi)), cvt4v(*(const f32x4*)(cp + 16 * ks + 8 * hi + 4)));
        const float* kp = C.in[I_CKR] + (((size_t)m.b * 2 + l) * PAST + m.t) * 32;
#pragma unroll
        for (int g = 0; g < 4; ++g) kr[g] = *(const f32x4*)(kp + 8 * g + 4 * hi);
    }
    float skr = 0.f;
#pragma unroll
    for (int g = 0; g < 4; ++g) skr += (kr[g].x * kr[g].x + kr[g].y * kr[g].y) + (kr[g].z * kr[g].z + kr[g].w * kr[g].w);
    const float* gk = C.in[I_QKN] + ((size_t)l * 2 + 1) * 96;
    f32x4 gkv[3][4];
#pragma unroll
    for (int t3 = 0; t3 < 3; ++t3)
#pragma unroll
        for (int g = 0; g < 4; ++g) gkv[t3][g] = *(const f32x4*)(gk + 32 * t3 + 8 * g + 4 * hi);
    ATT_WAITBAR(0);
    LAS unsigned char* wp = wl + hi * 512 + tok * 16;
    f32x16 acc[2];
#pragma unroll
    for (int t4 = 0; t4 < 2; ++t4) { acc[t4] = (f32x16){};
#pragma unroll
        for (int ks = 0; ks < 8; ++ks) acc[t4] = MFMA32(*(const LAS f16x8*)(wp + (t4 * 16 + 2 * ks) * 512), bk[ks], acc[t4]); }
    float s2 = 0.f;
#pragma unroll
    for (int t4 = 0; t4 < 2; ++t4)
#pragma unroll
        for (int r = 0; r < 16; ++r) s2 += acc[t4][r] * acc[t4][r];
    s2 = s2 * (rstd * rstd) + skr;
    s2 += __shfl_xor(s2, 32);
    const float rs = 1.0f / sqrtf(s2 * (1.0f / 96.0f) + EPS), rsn = rs * rstd;
    f16* ko = KC + ((((size_t)m.b * 4 + hd) * NT + m.ktile) * 12) * 512 + m.kin * 8 + 4 * hi;
#pragma unroll
    for (int t4 = 0; t4 < 2; ++t4)
#pragma unroll
        for (int g = 0; g < 4; ++g) { const f32x4 gg = gkv[t4][g];
            *(f16x4*)(ko + (4 * t4 + g) * 512) = cvt4(acc[t4][4 * g] * rsn * gg[0], acc[t4][4 * g + 1] * rsn * gg[1], acc[t4][4 * g + 2] * rsn * gg[2], acc[t4][4 * g + 3] * rsn * gg[3]); }
    f32x4 kn[4];
#pragma unroll
    for (int g = 0; g < 4; ++g) kn[g] = kr[g] * rs * gkv[2][g];
    if (KIND == 1) {
#pragma unroll
        for (int e = 0; e < 4; ++e) {
            const float a1 = kn[0][e], a2 = kn[2][e]; kn[0][e] = a1 * cr[e] - a2 * sr[e]; kn[2][e] = a2 * cr[e] + a1 * sr[e];
            const float b1 = kn[1][e], b2 = kn[3][e]; kn[1][e] = b1 * cc[e] - b2 * scn[e]; kn[3][e] = b2 * cc[e] + b1 * scn[e];
        }
    }
#pragma unroll
    for (int g = 0; g < 4; ++g) *(f16x4*)(ko + (8 + g) * 512) = cvt4v(kn[g]);
    f16* vo = VC + ((((size_t)m.b * 4 + hd) * NT + m.ktile) * 2) * 2048 + m.kin * 32 + 4 * hi;
#pragma unroll
    for (int t4 = 2; t4 < 4; ++t4) {
        f32x16 av = (f32x16){};
#pragma unroll
        for (int ks = 0; ks < 8; ++ks) av = MFMA32(*(const LAS f16x8*)(wp + (t4 * 16 + 2 * ks) * 512), bk[ks], av);
#pragma unroll
        for (int g = 0; g < 4; ++g) *(f16x4*)(vo + (t4 - 2) * 2048 + 8 * g) = cvt4(av[4 * g] * rstd, av[4 * g + 1] * rstd, av[4 * g + 2] * rstd, av[4 * g + 3] * rstd);
    }
}

template <int DIR, bool PASS2>
__device__ __forceinline__ void lru_dir(const Ctx& C, int l, int ch, int n, const f16x8 (&bx)[2][4], int b, int T, int cidx, int seqch0, bool prompt, int row0, int lane) {
    const int l31 = lane & 31, hi = lane >> 5;
    const f16* wg = WSP(f16, WS_WG);
    const f16* PROJ = WSP(f16, WS_ACT);
    float* SUM = WSP(float, WS_SUM);
    f16* OC = WSP(f16, WS_OCAT);
    const int nch = T >> 6;
    float bg0[2], bg1[2], spl[2], hc[2], At[2], Bt[2];
#pragma unroll
    for (int t2 = 0; t2 < 2; ++t2) {
        const int chn = 64 * n + 32 * t2 + l31;
        bg0[t2] = C.in[I_BGATE][((size_t)(l * 2 + DIR) * 2 + 0) * 512 + chn]; bg1[t2] = C.in[I_BGATE][((size_t)(l * 2 + DIR) * 2 + 1) * 512 + chn];
        spl[t2] = -8.0f * LOG2E * log1pf(__expf(-C.in[I_LLAM][(size_t)(l * 2 + DIR) * 512 + chn]));
        At[t2] = 1.0f; Bt[t2] = 0.0f; hc[t2] = 0.0f;
    }
    if (PASS2) {
        const int cnt = (DIR == 0) ? cidx : (nch - 1 - cidx), m = (cnt + 1) >> 1;
        const int lo = hi ? m : 0, up = hi ? cnt : m;
        float A0 = 1.f, B0 = 0.f, A1 = 1.f, B1 = 0.f;
#pragma unroll 1
        for (int ib = lo; ib < up; ib += 8) {
            float a0[8], b0[8], a1[8], b1[8];
#pragma unroll
            for (int k = 0; k < 8; ++k) {
                const int i = (ib + k < up) ? ib + k : up - 1, j = (DIR == 0) ? i : (nch - 1 - i);
                const float* p = SUM + ((((size_t)(seqch0 + j)) * 8 + n) * 2 + DIR) * 128 + l31;
                a0[k] = p[0]; b0[k] = p[64]; a1[k] = p[32]; b1[k] = p[96];
            }
#pragma unroll
            for (int k = 0; k < 8; ++k) if (ib + k < up) { B0 = a0[k] * B0 + b0[k]; A0 *= a0[k]; B1 = a1[k] * B1 + b1[k]; A1 *= a1[k]; }
        }
        {
            const float pa0 = __shfl_xor(A0, 32), pb0 = __shfl_xor(B0, 32), pa1 = __shfl_xor(A1, 32), pb1 = __shfl_xor(B1, 32);
            const float fa0 = hi ? pa0 : A0, fb0 = hi ? pb0 : B0, sa0 = hi ? A0 : pa0, sb0 = hi ? B0 : pb0;
            const float fa1 = hi ? pa1 : A1, fb1 = hi ? pb1 : B1, sa1 = hi ? A1 : pa1, sb1 = hi ? B1 : pb1;
            float h00 = 0.f, h01 = 0.f;
            if (!prompt) { const float* st = C.in[I_ST] + (((size_t)b * 2 + l) * 2 + DIR) * 512 + 64 * n + l31; h00 = st[0]; h01 = st[32]; }
            hc[0] = sa0 * (fa0 * h00 + fb0) + sb0; hc[1] = sa1 * (fa1 * h01 + fb1) + sb1;
        }
    }
    const f16* idp = WSP(f16, WS_IDN);
    __builtin_amdgcn_sched_barrier(0);
#pragma unroll
    for (int t2 = 0; t2 < 2; ++t2) {
        f16x8 w0[4], w1[4], idn[4];
#pragma unroll
        for (int ks = 0; ks < 4; ++ks) {
            w0[ks] = *(const f16x8*)(wg + ((((size_t)(l * 2 + DIR) * 2 + 0) * 8 + n) * 64 + 32 * t2 + l31) * 64 + 16 * ks + 8 * hi);
            w1[ks] = *(const f16x8*)(wg + ((((size_t)(l * 2 + DIR) * 2 + 1) * 8 + n) * 64 + 32 * t2 + l31) * 64 + 16 * ks + 8 * hi);
            idn[ks] = *(const f16x8*)(idp + (32 * t2 + l31) * 64 + 16 * ks + 8 * hi);
        }
#pragma unroll
        for (int sci = 0; sci < 2; ++sci) {
            const int sc = DIR ? 1 - sci : sci;
            f32x16 g0 = (f32x16){}, g1 = (f32x16){}, X = (f32x16){};
#pragma unroll
            for (int ks = 0; ks < 4; ++ks) { g0 = MFMA32(bx[sc][ks], w0[ks], g0); g1 = MFMA32(bx[sc][ks], w1[ks], g1); X = MFMA32(bx[sc][ks], idn[ks], X); }
#pragma unroll
            for (int r = 0; r < 16; ++r) {
                const float rr = sigmoidf_(g0[r] + bg0[t2]), ii = sigmoidf_(g1[r] + bg1[t2]);
                const float a = fexp2(rr * spl[t2]);
                g0[r] = a; g1[r] = __builtin_amdgcn_sqrtf(fmaxf(1.0f - a * a, 0.f)) * (ii * X[r]);
            }
            float As[4], Bs[4], Ap[4], Bp[4];
#pragma unroll
            for (int g = 0; g < 4; ++g) {
                float pa = 1.f, pb = 0.f;
#pragma unroll
                for (int ee = 0; ee < 4; ++ee) { const int e = DIR ? 3 - ee : ee; pb = g0[4 * g + e] * pb + g1[4 * g + e]; pa *= g0[4 * g + e]; }
                As[g] = pa; Bs[g] = pb; Ap[g] = __shfl_xor(pa, 32); Bp[g] = __shfl_xor(pb, 32);
            }
            float h = hc[t2];
#pragma unroll
            for (int gi = 0; gi < 4; ++gi) {
                const int g = DIR ? 3 - gi : gi;
                const bool mine_first = DIR ? (hi == 1) : (hi == 0);
                const float fa = mine_first ? As[g] : Ap[g], fb = mine_first ? Bs[g] : Bp[g], sa = mine_first ? Ap[g] : As[g], sb = mine_first ? Bp[g] : Bs[g];
                const float mid = fa * h + fb;
                float hh = mine_first ? h : mid;
                if (PASS2) {
#pragma unroll
                    for (int ee = 0; ee < 4; ++ee) { const int e = DIR ? 3 - ee : ee; hh = g0[4 * g + e] * hh + g1[4 * g + e]; g1[4 * g + e] = hh; }
                }
                h = sa * mid + sb;
                if (!PASS2) { Bt[t2] = sa * (fa * Bt[t2] + fb) + sb; At[t2] *= fa * sa; }
            }
            hc[t2] = h;
            if (PASS2) {
                LAS f16* op = (LAS f16*)(C.lds + C.wave * 16384) + (32 * sc + 4 * hi) * 64 + 32 * t2 + l31;
                if (DIR == 0) {
#pragma unroll
                    for (int r = 0; r < 16; ++r) op[((r & 3) + 8 * (r >> 2)) * 64] = (f16)g1[r];
                } else {
                    f32x16 G = (f32x16){};
#pragma unroll
                    for (int ks = 0; ks < 4; ++ks) {
                        const f16x8 gbf = *(const f16x8*)(PROJ + (size_t)(row0 + 32 * sc + l31) * DINP + PC_GB + 64 * n + 16 * ks + 8 * hi);
                        G = MFMA32(gbf, idn[ks], G);
                    }
                    float hfv[16];
#pragma unroll
                    for (int r = 0; r < 16; ++r) hfv[r] = (float)op[((r & 3) + 8 * (r >> 2)) * 64];
#pragma unroll
                    for (int r = 0; r < 16; ++r) {
                        LAS f16* q = op + ((r & 3) + 8 * (r >> 2)) * 64;
                        const float hf = hfv[r];
                        const float x = G[r], u = 0.7978845608028654f * (x + 0.044715f * x * x * x);
                        const float th = 1.0f - 2.0f * frcp(1.0f + fexp2(2.0f * u * LOG2E));
                        *q = (f16)((hf + g1[r]) * (0.5f * x * (1.0f + th)));
                    }
                }
            }
            FENCE(); __builtin_amdgcn_sched_barrier(0);
        }
    }
    if (!PASS2) {
        if (hi == 0) { float* sa = SUM + ((((size_t)ch) * 8 + n) * 2 + DIR) * 128 + l31; sa[0] = At[0]; sa[64] = Bt[0]; sa[32] = At[1]; sa[96] = Bt[1]; }
    } else if (prompt) {
        const bool fin = (DIR == 0) ? (cidx == nch - 1) : (cidx == 0);
        if (fin && hi == 0) { float* o = C.out + OUT_ST + (((size_t)b * 2 + l) * 2 + DIR) * 512 + 64 * n + l31; o[0] = hc[0]; o[32] = hc[1]; }
    }
}
template <bool PASS2>
__device__ __forceinline__ void lru_item(const Ctx& C, int l, int ch, int n) {
    const int lane = lane_id_fresh(), l31 = lane & 31, hi = lane >> 5;
    const f16* PROJ = WSP(f16, WS_ACT);
    const int row0 = ch * 64;
    const bool prompt = row0 < MP;
    int b, t0, T, seqrow0;
    if (prompt) { b = row0 >> 8; t0 = row0 & 255; T = TP; seqrow0 = b * TP; } else { const int rs = row0 - MP; b = rs >> 11; t0 = rs & 2047; T = TS; seqrow0 = MP + b * TS; }
    const int cidx = t0 >> 6, seqch0 = seqrow0 >> 6;
    f16x8 bx[2][4];
    f16x8* xcbuf = WSP(f16x8, WS_XC) + ((size_t)(ch * 8 + n) * 8) * 64 + lane;
    if (PASS2) {
#pragma unroll
        for (int sc = 0; sc < 2; ++sc)
#pragma unroll
            for (int ks = 0; ks < 4; ++ks) bx[sc][ks] = xcbuf[(sc * 4 + ks) * 64];
    } else
#pragma unroll
    for (int ks = 0; ks < 4; ++ks) {
        int chn = 64 * n + 16 * ks + 8 * hi; asm volatile("" : "+v"(chn));
        f32x4 w0[4], w1[4];
#pragma unroll
        for (int j = 0; j < 4; ++j) { w0[j] = *(const f32x4*)(C.in[I_CONVW] + ((size_t)l * 4 + j) * 512 + chn); w1[j] = *(const f32x4*)(C.in[I_CONVW] + ((size_t)l * 4 + j) * 512 + chn + 4); }
        const f32x4 c0 = *(const f32x4*)(C.in[I_CONVB] + (size_t)l * 512 + chn), c1 = *(const f32x4*)(C.in[I_CONVB] + (size_t)l * 512 + chn + 4);
#pragma unroll
        for (int sc = 0; sc < 2; ++sc) {
            const int t = t0 + 32 * sc + l31;
            f16x8 v[4]; float wm[4];
#pragma unroll
            for (int j = 0; j < 4; ++j) { const int tt = t + j - 2; const bool ok = (tt >= 0 && tt < T); wm[j] = ok ? 1.0f : 0.0f;
                v[j] = *(const f16x8*)(PROJ + (size_t)(seqrow0 + (ok ? tt : t)) * DINP + PC_XB + chn); }
            f32x4 a0 = c0, a1 = c1;
#pragma unroll
            for (int j = 0; j < 4; ++j) { a0 += (w0[j] * wm[j]) * (f32x4){(float)v[j][0], (float)v[j][1], (float)v[j][2], (float)v[j][3]}; a1 += (w1[j] * wm[j]) * (f32x4){(float)v[j][4], (float)v[j][5], (float)v[j][6], (float)v[j][7]}; }
            bx[sc][ks] = pack8(cvt4v(a0), cvt4v(a1));
            xcbuf[(sc * 4 + ks) * 64] = bx[sc][ks];
        }
        FENCE(); __builtin_amdgcn_sched_barrier(0);
    }
    __builtin_amdgcn_sched_barrier(0);
    lru_dir<0, PASS2>(C, l, ch, n, bx, b, T, cidx, seqch0, prompt, row0, lane);
    FENCE(); __builtin_amdgcn_sched_barrier(0);
    lru_dir<1, PASS2>(C, l, ch, n, bx, b, T, cidx, seqch0, prompt, row0, lane);
    if (PASS2) {
        FENCE(); asm volatile("s_waitcnt lgkmcnt(0)" ::: "memory");
        const LAS unsigned char* tl = C.lds + C.wave * 16384;
        f16* oc = WSP(f16, WS_OCAT) + (size_t)row0 * DM + 256 + 64 * n;
        f16x8 ov[8];
#pragma unroll
        for (int i = 0; i < 8; ++i) ov[i] = *(const LAS f16x8*)(tl + (8 * i + (lane >> 3)) * 128 + (lane & 7) * 16);
#pragma unroll
        for (int i = 0; i < 8; ++i) *(f16x8*)(oc + (size_t)(8 * i + (lane >> 3)) * DM + (lane & 7) * 8) = ov[i];
        asm volatile("s_waitcnt lgkmcnt(0)" ::: "memory"); FENCE();
    }
}

constexpr int ATT_SLOT = 20480, ATT_VOFF = 12288;
constexpr float ATT_THR = 8.0f;
typedef short v4i16_t __attribute__((ext_vector_type(4)));
__device__ __forceinline__ f16x4 lds_tr(LAS unsigned char* p) { return __builtin_bit_cast(f16x4, __builtin_amdgcn_ds_read_tr16_b64_v4i16((LAS v4i16_t*)p)); }
template <int TYPE>
__device__ __forceinline__ void attn_unit(const Ctx& C, int l, int kind, int b, int hd, int qblk) {
    const int lane = lane_id_fresh(), tok = lane & 31, hi = lane >> 5, wid = C.wave;
    constexpr int NC = TYPE ? 12 : 8, KTILE = NC * 512;
    const int Tk = kind ? TKS : TP, NT = Tk >> 6;
    const size_t row = (kind ? (size_t)MP + (size_t)b * TS : (size_t)b * TP) + 256 * qblk + 32 * wid + tok;
    const f16* Kimg = (TYPE ? (kind ? WSP(f16, WS_KCS) : WSP(f16, WS_KCP)) : (kind ? WSP(f16, WS_KAS) : WSP(f16, WS_KAP))) + ((size_t)b * 4 + hd) * NT * KTILE + lane * 8;
    const f16* Vimg = (TYPE ? (kind ? WSP(f16, WS_VCTS) : WSP(f16, WS_VCTP)) : (kind ? WSP(f16, WS_VATS) : WSP(f16, WS_VATP))) + ((size_t)b * 4 + hd) * NT * 4096 + wid * 512 + lane * 8;
    LAS unsigned char* lds = C.lds;
    const bool two = (TYPE == 1) && (wid < 4);
#define ATT_DMA(t, sl) do { const f16* kt_ = Kimg + (size_t)(t) * KTILE; LAS unsigned char* ls_ = lds + (sl) * ATT_SLOT; \
        ATT_GLDS(kt_ + wid * 512, ls_ + wid * 1024); if (two) ATT_GLDS(kt_ + (8 + wid) * 512, ls_ + (8 + wid) * 1024); \
        ATT_GLDS(Vimg + (size_t)(t) * 4096, ls_ + ATT_VOFF + wid * 1024); } while (0)
    f16x8 bq[TYPE ? 6 : 4];
    if (TYPE) {
#pragma unroll
        for (int ks = 0; ks < 6; ++ks) bq[ks] = *(const f16x8*)(WSP(f16, WS_QC) + row * 384 + hd * 96 + 16 * ks + 8 * hi);
    } else {
#pragma unroll
        for (int i = 0; i < 4; ++i) bq[i] = *(const f16x8*)(WSP(f16, WS_QA) + row * 256 + hd * 64 + 16 * i + 8 * hi);
    }
    float lam = 0.f, lam_init = 0.f;
    if (TYPE == 0) {
        const float* lp = C.in[I_DLAM] + (size_t)l * 128;
        float s1 = (lane < 32) ? lp[lane] * lp[32 + lane] : 0.f, s2 = (lane < 32) ? lp[64 + lane] * lp[96 + lane] : 0.f;
        s1 = wave_sum(s1); s2 = wave_sum(s2);
        lam_init = 0.8f - 0.6f * expf(-0.3f * (float)l);
        lam = expf(s1) - expf(s2) + lam_init;
    }
#pragma unroll
    for (int i = 0; i < (TYPE ? 6 : 4); ++i) asm volatile("" : "+v"(bq[i]));
    asm volatile("" : "+v"(lam), "+v"(lam_init));
    ATT_DMA(0, 0); ATT_DMA(1, 1);
    if (two) { ATT_WAITBAR(3); } else { ATT_WAITBAR(2); }
    float m0 = 0.f, m1 = 0.f;
    f32x16 O0[2], O1[2], L0 = (f32x16){}, L1 = (f32x16){}; O0[0] = (f32x16){}; O0[1] = (f32x16){}; O1[0] = (f32x16){}; O1[1] = (f32x16){};
    const f16x8 ones = {(f16)1.0f, (f16)1.0f, (f16)1.0f, (f16)1.0f, (f16)1.0f, (f16)1.0f, (f16)1.0f, (f16)1.0f};
    int s_cur = 0, s_nx2 = 2;
    LAS unsigned char* vb0 = lds + ATT_VOFF + (4 * hi + ((lane & 15) >> 2)) * 64 + ((lane >> 4) & 1) * 32 + (lane & 3) * 8;
    LAS unsigned char* kb0 = lds + hi * 1024 + tok * 16;
#pragma unroll 1
    for (int t = 0; t < NT; ++t) {
        if (t + 2 < NT) ATT_DMA(t + 2, s_nx2);
        LAS unsigned char* kb = kb0 + s_cur * ATT_SLOT; LAS unsigned char* vb = vb0 + s_cur * ATT_SLOT;
        f16x8 pf[TYPE ? 1 : 2][2][2];
#pragma unroll
        for (int c = 0; c < (TYPE ? 1 : 2); ++c) {
            f32x16 S[2];
            {
                f16x8 kf[2][TYPE ? 6 : 2];
#pragma unroll
                for (int sub = 0; sub < 2; ++sub)
#pragma unroll
                    for (int ks = 0; ks < (TYPE ? 6 : 2); ++ks) kf[sub][ks] = *(const LAS f16x8*)(kb + c * 4096 + ks * 2048 + sub * 512);
                __builtin_amdgcn_sched_barrier(0);
#pragma unroll
                for (int sub = 0; sub < 2; ++sub) { S[sub] = (f32x16){};
#pragma unroll
                    for (int ks = 0; ks < (TYPE ? 6 : 2); ++ks) S[sub] = MFMA32(kf[sub][ks], bq[c * 2 + ks], S[sub]); }
                __builtin_amdgcn_sched_barrier(0);
            }
            float ma = fmaxf(fmaxf(S[0][0], S[0][1]), S[1][0]), mb = fmaxf(fmaxf(S[0][2], S[0][3]), S[1][1]);
            ma = fmaxf(fmaxf(ma, S[1][2]), S[1][3]);
#pragma unroll
            for (int r = 4; r < 16; r += 4) { ma = fmaxf(fmaxf(ma, S[0][r]), S[0][r + 1]); mb = fmaxf(fmaxf(mb, S[0][r + 2]), S[0][r + 3]); ma = fmaxf(fmaxf(ma, S[1][r]), S[1][r + 1]); mb = fmaxf(fmaxf(mb, S[1][r + 2]), S[1][r + 3]); }
            float rm = fmaxf(ma, mb); rm = fmaxf(rm, __shfl_xor(rm, 32));
            float mref = c ? m1 : m0;
            if (t == 0) mref = rm;
            else if (__any(rm - mref > ATT_THR)) {
                const float dl = fmaxf(rm - mref, 0.f), f = fexp2(-dl); mref += dl;
                if (c == 0) {
#pragma unroll
                    for (int r = 0; r < 16; ++r) { O0[0][r] *= f; O0[1][r] *= f; L0[r] *= f; }
                } else {
#pragma unroll
                    for (int r = 0; r < 16; ++r) { O1[0][r] *= f; O1[1][r] *= f; L1[r] *= f; }
                }
            }
            if (c == 0) m0 = mref; else m1 = mref;
#pragma unroll
            for (int sub = 0; sub < 2; ++sub)
#pragma unroll
                for (int r = 0; r < 16; ++r) S[sub][r] = fexp2(S[sub][r] - mref);
#pragma unroll
            for (int sub = 0; sub < 2; ++sub)
#pragma unroll
                for (int sp = 0; sp < 2; ++sp) pf[c][sub][sp] = pack8(cvt4(S[sub][8 * sp], S[sub][8 * sp + 1], S[sub][8 * sp + 2], S[sub][8 * sp + 3]), cvt4(S[sub][8 * sp + 4], S[sub][8 * sp + 5], S[sub][8 * sp + 6], S[sub][8 * sp + 7]));
        }
#pragma unroll
        for (int vt = 0; vt < 2; ++vt) {
            f16x4 vlo[4], vhi[4];
#pragma unroll
            for (int k4 = 0; k4 < 4; ++k4) { vlo[k4] = lds_tr(vb + vt * 4096 + k4 * 1024); vhi[k4] = lds_tr(vb + vt * 4096 + k4 * 1024 + 512); }
            __builtin_amdgcn_sched_barrier(0);
#pragma unroll
            for (int k4 = 0; k4 < 4; ++k4) {
                const f16x8 vf = pack8(vlo[k4], vhi[k4]);
                O0[vt] = MFMA32(vf, pf[0][k4 >> 1][k4 & 1], O0[vt]);
                if (TYPE == 0) O1[vt] = MFMA32(vf, pf[TYPE ? 0 : 1][k4 >> 1][k4 & 1], O1[vt]);
            }
            __builtin_amdgcn_sched_barrier(0);
        }
#pragma unroll
        for (int k4 = 0; k4 < 4; ++k4) { L0 = MFMA32(ones, pf[0][k4 >> 1][k4 & 1], L0); if (TYPE == 0) L1 = MFMA32(ones, pf[TYPE ? 0 : 1][k4 >> 1][k4 & 1], L1); }
        if (t + 1 < NT) {
            if (t + 2 < NT) { if (two) { ATT_WAITBAR(3); } else { ATT_WAITBAR(2); } } else { ATT_WAITBAR(0); }
        }
        s_nx2 = s_cur; s_cur = (s_cur == 2) ? 0 : s_cur + 1;
    }
#undef ATT_DMA
    f16* o = WSP(f16, WS_OCAT) + row * DM + (TYPE ? 768 : 0) + hd * 64 + 4 * hi;
    if (TYPE) {
        const float inv = 1.0f / L0[0];
#pragma unroll
        for (int vt = 0; vt < 2; ++vt)
#pragma unroll
            for (int g = 0; g < 4; ++g) *(f16x4*)(o + 32 * vt + 8 * g) = cvt4(O0[vt][4 * g] * inv, O0[vt][4 * g + 1] * inv, O0[vt][4 * g + 2] * inv, O0[vt][4 * g + 3] * inv);
    } else {
        const float i0 = 1.0f / L0[0], i1 = lam / L1[0];
        float ss = 0.f;
#pragma unroll
        for (int vt = 0; vt < 2; ++vt)
#pragma unroll
            for (int r = 0; r < 16; ++r) { const float v = O0[vt][r] * i0 - O1[vt][r] * i1; O0[vt][r] = v; ss += v * v; }
        ss += __shfl_xor(ss, 32);
        const float rs = (1.0f / sqrtf(ss * (1.0f / 64.0f) + EPS)) * (1.0f - lam_init);
        const float* sg = C.in[I_DSUB] + (size_t)l * 64 + 4 * hi;
        f32x4 sgv[2][4];
#pragma unroll
        for (int vt = 0; vt < 2; ++vt)
#pragma unroll
            for (int g = 0; g < 4; ++g) sgv[vt][g] = *(const f32x4*)(sg + 32 * vt + 8 * g);
#pragma unroll
        for (int vt = 0; vt < 2; ++vt)
#pragma unroll
            for (int g = 0; g < 4; ++g) { const f32x4 gg = sgv[vt][g];
                *(f16x4*)(o + 32 * vt + 8 * g) = cvt4(O0[vt][4 * g] * rs * gg[0], O0[vt][4 * g + 1] * rs * gg[1], O0[vt][4 * g + 2] * rs * gg[2], O0[vt][4 * g + 3] * rs * gg[3]); }
    }
    ATT_LBAR();
}

template <int mode>
__device__ __forceinline__ void phase_mx(const Ctx& C0, int l, unsigned* ctr) {
    const Ctx C = ctx_fresh(C0);
#pragma unroll 1
    for (int u = C.bid; u < 544; u += C.G) {
        ATT_LBAR();
        if (mode == 1 || mode == 4) continue;
#ifndef NO_MXT
        const int lane = lane_id_fresh();
        if (u < 288) {
            const int g = u >> 2, hd = u & 3;
            const f16* wsrc = ((g < 64) ? WSP(f16, WS_WUKV) : WSP(f16, WS_WUKV0)) + ((size_t)(l * 4 + hd) * 32) * 512 + lane * 8;
#pragma unroll
            for (int i = 0; i < 4; ++i) ATT_GLDS(wsrc + (C.wave + 8 * i) * 512, C.lds + (C.wave + 8 * i) * 1024);
            if (g < 32) mx_kv<0>(C, l, g * 8 + C.wave, hd, C.lds); else if (g < 64) mx_kv<1>(C, l, g * 8 + C.wave, hd, C.lds); else mx_kv<2>(C, l, 512 + (g - 64) * 8 + C.wave, hd, C.lds);
        } else {
            const int v = u - 288, g = v >> 2, hd = v & 3;
            const f16* wsrc = WSP(f16, WS_WUQ) + ((size_t)(l * 4 + hd) * 36) * 512 + lane * 8;
#pragma unroll
            for (int i = 0; i < 5; ++i) if (C.wave + 8 * i < 36) ATT_GLDS(wsrc + (C.wave + 8 * i) * 512, C.lds + (C.wave + 8 * i) * 1024);
            if (g < 32) mx_q<0>(C, l, g * 8 + C.wave, hd, C.lds); else mx_q<1>(C, l, g * 8 + C.wave, hd, C.lds);
        }
#endif
    }
    constexpr int NA = 512 + 576 + 576;
#ifndef NO_LRU1
    if (mode != 2 && mode != 3 && mode != 4)
#pragma unroll 1
        for (int i = C.gw; i < 2048; i += C.ngw) lru_item<false>(C, l, i >> 3, i & 7);
#endif
#ifndef NO_MXT
    if (mode != 1 && mode != 3)
#pragma unroll 1
        for (int it = C.ngw - 1 - C.gw; it < NA; it += C.ngw) {
            if (it < 512) { if (it < 256) mx_a<0, 0>(C, l, it); else mx_a<1, 0>(C, l, it); }
            else if (it < 1088) { const int w = it - 512; if (w < 256) mx_a<0, 1>(C, l, w); else if (w < 512) mx_a<1, 1>(C, l, w); else mx_a<2, 1>(C, l, w); }
            else { const int w = it - 1088; if (w < 256) mx_a<0, 2>(C, l, w); else if (w < 512) mx_a<1, 2>(C, l, w); else mx_a<2, 2>(C, l, w); }
        }
#endif
}

template <int mode>
__device__ __forceinline__ void phase_att(const Ctx& C0, int l, unsigned* ctr) {
    const Ctx C = ctx_fresh(C0);
    const int half = C.G >> 1;
    if (mode != 1) {
#pragma unroll 1
        for (int u = C.bid; u < 128; u += half) { if (C.bid >= half) break;
#ifndef NO_ATTA
            if (mode == 0 || mode == 2 || mode == 5) { const int pr = (u & 7) * 2 + ((u >> 3) >> 3), qb = (u >> 3) & 7;
                attn_unit<0>(C, l, 1, pr >> 2, pr & 3, qb); }
#endif
        }
        if (C.bid >= half) {
#pragma unroll 1
            for (int u = C.bid - half; u < 128; u += half) {
#ifndef NO_ATTC
                if (mode == 0 || mode == 2 || mode == 6) { const int pr = (u & 7) * 2 + ((u >> 3) >> 3), qb = (u >> 3) & 7;
                    attn_unit<1>(C, l, 1, pr >> 2, pr & 3, qb); }
#endif
            }
#pragma unroll 1
            for (int u = C.bid - half; u < 128; u += half) {
#ifndef NO_ATTA
                if (mode == 0 || mode == 2 || mode == 7) attn_unit<0>(C, l, 0, u >> 2, u & 3, 0);
#endif
#ifndef NO_ATTC
                if (mode == 0 || mode == 2 || mode == 7) attn_unit<1>(C, l, 0, u >> 2, u & 3, 0);
#endif
            }
        }
    }
#ifndef NO_LRU2
    if (mode == 0 || mode == 1) {
#pragma unroll 1
        for (int it = C.gw; it < 2048; it += C.ngw) lru_item<true>(C, l, it >> 3, it & 7);
    }
#endif
}

__global__ void __launch_bounds__(512, 2) mk_fwd(Args args) {
    extern __shared__ __attribute__((aligned(16))) unsigned char lds_raw[];
    Ctx C;
    C.in = args.in; C.out = args.out; C.ws = args.ws;
    C.lds = (LAS unsigned char*)lds_raw;
    C.tid = threadIdx.x; C.lane = C.tid & 63; C.wave = __builtin_amdgcn_readfirstlane(C.tid >> 6);
    C.gw = 0; C.ngw = 0; C.bid = 0; C.G = 0;
    volatile LAS unsigned* MISC = (volatile LAS unsigned*)(C.lds + MISC_OFF);
    for (int u = C.tid; u < (LDS_BYTES - LDSCTL_OFF) / 4; u += 512) ((LAS unsigned*)(C.lds + LDSCTL_OFF))[u] = 0u;
    __syncthreads();
    unsigned* ctl = (unsigned*)(args.ws + WS_CTL);
    XcdBarrier bar = xcd_barrier_post(ctl + CW_BAR, MISC + 8);
    const int lo = args.ph_lo, hi = args.ph_hi;
#define IN(k) (lo <= (k) && (k) < hi)
#define SEAM(k) do { if (IN(k) && IN((k) + 1)) xcd_barrier(bar); } while (0)

    int rep = 0;
#pragma unroll 1
    for (int p = lo; p < hi; ++p) {
        const int l = (p >= 10) ? 1 : 0, q = (p < 2) ? -1 - p : (p - 2 - 8 * l);
        int bid = blockIdx.x, G = gridDim.x; asm volatile("" : "+s"(bid), "+s"(G));
        const float* modl = WSP(float, WS_MOD) + (size_t)l * 5 * NMODV;
        if (q == -1) {
#ifndef NO_PREP
            phase_prep(C);
#endif
        } else if (q == -2) phase_norm<true>(C, 0, 0);
        else if (q == 0 || q == 6) {
            const int s = (q == 6);
            pg8::Gemm g{WSP(f16, WS_H), WSP(f16, WS_WFI) + (size_t)(l * 2 + s) * NFF2 * 1024, M, NFF2, 1024}; pg8::StaticOrder S; S.init(M, NFF2, G, bid);
            pg8::EpiSwiglu E{WSP(f16, WS_ACT)};
            pg8::gemm_phase<pg8::EpiSwiglu, pg8::StaticOrder, true, true>(C.lds, g, S, E, C.wave);
        } else if (q == 1 || q == 7 || q == 5) {
            const int s = (q == 7);
            const f16* A = (q == 5) ? WSP(f16, WS_OCAT) : WSP(f16, WS_ACT);
            const f16* B = (q == 5) ? WSP(f16, WS_WOUT) + (size_t)l * 1024 * 1024 : WSP(f16, WS_WFO) + (size_t)(l * 2 + s) * 1024 * DFF;
            pg8::Gemm g{A, B, M, 1024, (q == 5) ? 1024 : DFF}; pg8::StaticOrder S; S.init(M, 1024, G, bid);
            const int nl = (q == 7) ? l + 1 : l, nsub = (q == 1) ? 1 : ((q == 5) ? 2 : 0), donorm = (nl < DEPTH) ? 1 : 0, nlc = donorm ? nl : l;
            pg8::EpiResidNorm E{C.out, WSP(f16, WS_XH), modl, (q == 5) ? 5 : (s ? 8 : 2), (rep > 0) ? 0.0f : ((q == 5) ? 1.0f : 0.5f),
                                donorm, WSP(f16, WS_H), C.in[I_NG] + ((size_t)nlc * 3 + nsub) * DM, WSP(float, WS_MOD) + (size_t)nlc * 5 * NMODV + (3 * nsub) * DM,
                                WSP(float, WS_XBUF), ctl + CW_PAN + (p + 18 * rep) * 4096};
            pg8::gemm_phase<pg8::EpiResidNorm, pg8::StaticOrder, false, true>(C.lds, g, S, E, C.wave);
        } else if (q == 2) {
            pg8::Gemm g{WSP(f16, WS_H), WSP(f16, WS_WIN) + (size_t)l * DINP * 1024, M, DINP, 1024}; pg8::StaticOrder S; S.init(M, DINP, G, bid);
            pg8::EpiStore E{WSP(f16, WS_ACT), DINP};
            pg8::gemm_phase<pg8::EpiStore, pg8::StaticOrder, true, true>(C.lds, g, S, E, C.wave);
        } else if (q == 3) { if (REP_MODE != 0 && rep) phase_mx<REP_MODE>(C, l, ctl + CW_Q + 64 * (p + 32 * rep)); else phase_mx<0>(C, l, ctl + CW_Q + 64 * (p + 32 * rep)); }
        else if (q == 4) { if (REP_MODE != 0 && rep) phase_att<REP_MODE>(C, l, ctl + CW_Q + 64 * (p + 32 * rep)); else phase_att<0>(C, l, ctl + CW_Q + 64 * (p + 32 * rep)); }
        if (REP_Q == 99 && p == 1) { for (int k = 0; k < 10; ++k) xcd_barrier(bar, C.wave); }
        if (q == REP_Q && rep < REP_N) { ++rep; --p; xcd_barrier(bar, C.wave); continue; }
        rep = 0;
        if (p + 1 < hi) xcd_barrier(bar, C.wave);
    }
#undef IN
#undef SEAM
}

extern "C" void kernel_launch(void* const* d_in, const int* in_sizes, int n_in, void* d_out, int out_size, void* d_ws, size_t ws_size, hipStream_t stream) {
    static int grid = 0;
    if (grid == 0) {
        if (n_in != N_IN || ws_size < WS_END || out_size != 27852800) { fprintf(stderr, "kernel_launch: unexpected shapes: n_in %d ws %zu out %d\n", n_in, ws_size, out_size); grid = -1; return; }
        int dev = 0, cus = 0, per_cu = 0;
        if (hipGetDevice(&dev) != hipSuccess || hipDeviceGetAttribute(&cus, hipDeviceAttributeMultiprocessorCount, dev) != hipSuccess) { grid = -1; return; }
        if (hipFuncSetAttribute((const void*)mk_fwd, hipFuncAttributeMaxDynamicSharedMemorySize, LDS_BYTES) != hipSuccess) { fprintf(stderr, "kernel_launch: hipFuncSetAttribute failed\n"); grid = -1; return; }
        if (hipOccupancyMaxActiveBlocksPerMultiprocessor(&per_cu, (const void*)mk_fwd, 512, LDS_BYTES) != hipSuccess || per_cu < 1) { fprintf(stderr, "kernel_launch: occupancy query says %d\n", per_cu); per_cu = 1; }
        (void)hipGetLastError();
        grid = cus;
    }
    if (grid < 0) return;
    if (hipMemsetAsync((char*)d_ws + WS_CTL, 0, CTL_ZERO_BYTES, stream) != hipSuccess) return;
    Args a{};
    for (int i = 0; i < N_IN; ++i) a.in[i] = (const float*)d_in[i];
    a.out = (float*)d_out; a.ws = (unsigned char*)d_ws;
#if MK_MULTI
    for (int p = 0; p < MK_PH_HI; ++p) { a.ph_lo = p; a.ph_hi = p + 1; hipLaunchKernelGGL(mk_fwd, dim3(grid), dim3(512), LDS_BYTES, stream, a); }
#else
    a.ph_lo = 0; a.ph_hi = MK_PH_HI;
    void* kargs[] = {&a};
    hipError_t e = hipLaunchCooperativeKernel((const void*)mk_fwd, dim3(grid), dim3(512), kargs, LDS_BYTES, stream);
    if (e != hipSuccess) { (void)hipGetLastError(); fprintf(stderr, "kernel_launch: cooperative launch failed (%s), plain launch instead\n", hipGetErrorString(e));
        hipLaunchKernelGGL(mk_fwd, dim3(grid), dim3(512), LDS_BYTES, stream, a); }
#endif
}
```

```cpp
#include <hip/hip_runtime.h>
#include <cstdio>
#include <cstdint>

#define GAS __attribute__((address_space(1)))
#define LAS __attribute__((address_space(3)))
typedef _Float16 f16;
typedef _Float16 f16x2 __attribute__((ext_vector_type(2)));
typedef _Float16 f16x4 __attribute__((ext_vector_type(4)));
typedef _Float16 f16x8 __attribute__((ext_vector_type(8)));
typedef float f32x2 __attribute__((ext_vector_type(2)));
typedef float f32x4 __attribute__((ext_vector_type(4)));
typedef float f32x16 __attribute__((ext_vector_type(16)));
typedef unsigned u32x2 __attribute__((ext_vector_type(2)));
typedef unsigned u32x4 __attribute__((ext_vector_type(4)));
typedef GAS unsigned gu32;

#ifndef MK_PH_HI
#define MK_PH_HI 18
#endif
#ifndef REP_Q
#define REP_Q -2
#endif
#ifndef REP_N
#define REP_N 1
#endif
#ifndef REP_MODE
#define REP_MODE 0
#endif
#ifndef MK_MULTI
#define MK_MULTI 0
#endif

constexpr int DM = 1024, NBP = 32, TP = 256, NBS = 4, TS = 2048, PAST = 512, DEPTH = 2;
constexpr int MP = NBP * TP, MS = NBS * TS, M = MP + MS;
constexpr int DFF = 2816, NFF2 = 5632, DIN = 2144, DINP = 2304, NMODV = 9216;
constexpr int TKS = PAST + TS;
constexpr float EPS = 1e-6f;
constexpr float LOG2E = 1.4426950408889634f;
constexpr int PC_QA = 0, PC_KA = 256, PC_VA = 512, PC_XB = 768, PC_GB = 1280, PC_CQ = 1792, PC_CKV = 1984, PC_KR = 2112;
constexpr size_t OUT_YP = 0, OUT_YS = 8388608, OUT_DK = 16777216, OUT_DV = 20971520, OUT_CKV = 25165824, OUT_KR = 27262976, OUT_ST = 27787264;
enum { I_XP = 0, I_XS, I_CDK, I_CDV, I_CCKV, I_CKR, I_ST, I_C, I_CCTX, I_NG, I_WADA, I_BADA, I_WFI, I_WFO, I_WIN, I_WOUT, I_DQKN, I_DLAM, I_DSUB,
       I_CONVW, I_CONVB, I_WGATE, I_BGATE, I_LLAM, I_CQN, I_CKVN, I_WUQ, I_WUKV, I_QKN, N_IN };

constexpr size_t MiB = 1u << 20;
constexpr size_t WS_CTL = 0, CTL_ZERO_BYTES = 1 * MiB;
constexpr size_t WS_MOD = 1 * MiB;
constexpr size_t WS_WUQ = 2 * MiB;
constexpr size_t WS_WUKV = 2 * MiB + 512 * 1024;
constexpr size_t WS_WUKV0 = 3 * MiB + 512 * 1024;
constexpr size_t WS_IDN = 3 * MiB + 768 * 1024;
constexpr size_t WS_WG = 3 * MiB;
constexpr size_t WS_SUM = 4 * MiB;
constexpr size_t WS_XBUF = 4 * MiB + 2 * MiB + 512 * 1024;
constexpr size_t WS_WFI = 8 * MiB;
constexpr size_t WS_WFO = 52 * MiB;
constexpr size_t WS_WIN = 74 * MiB;
constexpr size_t WS_WOUT = 83 * MiB;
constexpr size_t WS_H = 88 * MiB;
constexpr size_t WS_OCAT = 120 * MiB;
constexpr size_t WS_ACT = 152 * MiB;
constexpr size_t WS_XC = 224 * MiB;
constexpr size_t WS_QA = 240 * MiB;
constexpr size_t WS_QC = 248 * MiB;
constexpr size_t WS_KAS = 260 * MiB;
constexpr size_t WS_KAP = 265 * MiB;
constexpr size_t WS_VATS = 269 * MiB;
constexpr size_t WS_VATP = 274 * MiB;
constexpr size_t WS_KCS = 278 * MiB;
constexpr size_t WS_KCP = 286 * MiB;
constexpr size_t WS_VCTS = 292 * MiB;
constexpr size_t WS_VCTP = 297 * MiB;
constexpr size_t WS_XH = 301 * MiB;
constexpr size_t WS_END = 333 * MiB;
constexpr int CW_BAR = 4096;
constexpr int CW_Q = 16384;
constexpr int CW_PAN = 65536;

constexpr int RING_BYTES = 131072;
constexpr int LDSCTL_OFF = RING_BYTES, MISC_OFF = LDSCTL_OFF + 320;
constexpr int LDS_BYTES = 147456;

__device__ __forceinline__ int crow(int r, int hi) { return (r & 3) + 8 * (r >> 2) + 4 * hi; }
__device__ __forceinline__ int swap23(int x) { return (x & ~12) | ((x & 4) << 1) | ((x & 8) >> 1); }
__device__ __forceinline__ f16x2 cvt2(float a, float b) { f32x2 v = {a, b}; return __builtin_convertvector(v, f16x2); }
__device__ __forceinline__ f16x4 cvt4(float a, float b, float c, float d) { f32x4 v = {a, b, c, d}; return __builtin_convertvector(v, f16x4); }
__device__ __forceinline__ f16x4 cvt4v(f32x4 v) { return __builtin_convertvector(v, f16x4); }
__device__ __forceinline__ f32x4 tof32(f16x4 v) { return __builtin_convertvector(v, f32x4); }
__device__ __forceinline__ f16x8 pack8(f16x4 a, f16x4 b) { return __builtin_shufflevector(a, b, 0, 1, 2, 3, 4, 5, 6, 7); }
__device__ __forceinline__ float fexp2(float x) { return __builtin_amdgcn_exp2f(x); }
__device__ __forceinline__ float frcp(float x) { return __builtin_amdgcn_rcpf(x); }
__device__ __forceinline__ float sigmoidf_(float x) { return frcp(1.0f + fexp2(-x * LOG2E)); }
__device__ __forceinline__ float wave_sum(float v) {
#pragma unroll
    for (int o = 1; o < 64; o <<= 1) v += __shfl_xor(v, o);
    return v;
}
__device__ __forceinline__ f16x8 pair8(f16x4 a, f16x4 b) {
    const u32x2 ua = __builtin_bit_cast(u32x2, a), ub = __builtin_bit_cast(u32x2, b);
    const auto r0 = __builtin_amdgcn_permlane32_swap(ua.x, ub.x, false, false);
    const auto r1 = __builtin_amdgcn_permlane32_swap(ua.y, ub.y, false, false);
    const u32x4 o = {r0[0], r1[0], r0[1], r1[1]};
    return __builtin_bit_cast(f16x8, o);
}
#define FENCE() asm volatile("" ::: "memory")
__device__ __forceinline__ int lane_id_fresh() { int l; asm volatile("v_mbcnt_lo_u32_b32 %0, -1, 0\n\tv_mbcnt_hi_u32_b32 %0, -1, %0" : "=v"(l)); return l; }
#define MFMA32(a, b, c) __builtin_amdgcn_mfma_f32_32x32x16_f16((a), (b), (c), 0, 0, 0)

namespace pg8 {
#define PG8_LAS __attribute__((address_space(3)))
constexpr int BM = 256, BK = 64, HALF = 128, HTB = HALF * BK * 2, STAGE_BYTES = 8 * HTB, NXCD = 8, WGM = 8;
__host__ __device__ __forceinline__ int lds_byte(int r, int c) { const int st = (r >> 4) * 2 + (c >> 5), rr = r & 15, cc = c & 31, ob = rr * 64 + cc * 2; return st * 1024 + (ob ^ (((ob >> 9) & 1) << 5)); }
__host__ __device__ __forceinline__ void stage_rc(int b, int& R, int& C) { const int st = b / 1024, sb = b % 1024, swz = sb ^ (((sb >> 9) & 1) << 5); R = (st >> 1) * 16 + swz / 64; C = (st & 1) * 32 + (swz % 64) / 2; }
__host__ __device__ __forceinline__ int perm32(int rho) { const int n = rho >> 4, i = rho & 15; return 8 * (i >> 2) + 4 * n + (i & 3); }
struct Unit { int pm, pn; };
struct Gemm { const f16* A; const f16* Bt; int M, N, K; };
struct StaticOrder {
    int nM, nN, nwg, G, c;
    __host__ __device__ void init(int M_, int N_, int G_, int c_) { nM = M_ / BM; nN = N_ / BM; nwg = nM * nN; G = G_; c = c_; }
    __host__ __device__ bool next(int i, Unit& u) const {
        const long L = (long)i * G + c; if (L >= nwg) return false;
        int wgid = (int)L; { const int q = nwg / NXCD, r = nwg % NXCD, xcd = wgid % NXCD, off = wgid / NXCD; wgid = (xcd < r ? xcd * (q + 1) : r * (q + 1) + (xcd - r) * q) + off; }
        const int nig = WGM * nN, gid = wgid / nig, fm = gid * WGM, gsz = (nM - fm) < WGM ? (nM - fm) : WGM;
        u.pm = fm + ((wgid % nig) % gsz); u.pn = (wgid % nig) / gsz; return true;
    }
};
struct EpiSwiglu {
    static constexpr bool PERM = true, AFTER_DRAIN = false;
    f16* O;
    __device__ __forceinline__ void operator()(const f32x4 (&acc)[2][2][4][2], const Unit& u, int wr, int wc, int fr, int fq) const {
        const int row0 = u.pm * BM + wr * 64 + fr, col0 = u.pn * 128 + wc * 32 + 8 * fq;
#pragma unroll
        for (int ai = 0; ai < 2; ++ai)
#pragma unroll
            for (int m = 0; m < 4; ++m) {
                f16* rowp = O + (size_t)(row0 + ai * HALF + m * 16) * DFF + col0;
                f32x4 a0, a1;
#pragma unroll
                for (int e = 0; e < 4; ++e) {
                    const float g0 = acc[ai][0][m][0][e], g1 = acc[ai][0][m][1][e];
                    a0[e] = g0 * sigmoidf_(g0) * acc[ai][1][m][0][e];
                    a1[e] = g1 * sigmoidf_(g1) * acc[ai][1][m][1][e];
                }
                *(f16x8*)rowp = pack8(cvt4v(a0), cvt4v(a1));
            }
    }
};
struct EpiStore {
    static constexpr bool PERM = true, AFTER_DRAIN = false;
    f16* O; int ldc;
    __device__ __forceinline__ void operator()(const f32x4 (&acc)[2][2][4][2], const Unit& u, int wr, int wc, int fr, int fq) const {
        const int row0 = u.pm * BM + wr * 64 + fr, col0 = u.pn * BM + wc * 32 + 8 * fq;
#pragma unroll
        for (int ai = 0; ai < 2; ++ai)
#pragma unroll
            for (int m = 0; m < 4; ++m) {
                f16* rowp = O + (size_t)(row0 + ai * HALF + m * 16) * ldc + col0;
#pragma unroll
                for (int bj = 0; bj < 2; ++bj) *(f16x8*)(rowp + bj * HALF) = pack8(cvt4v(acc[ai][bj][m][0]), cvt4v(acc[ai][bj][m][1]));
            }
    }
};
struct EpiResidNorm {
    static constexpr bool PERM = true, AFTER_DRAIN = true;
    float* X; f16* XH; const float* modl; int gidx; float coef;
    int donorm; f16* H; const float* gn; const float* shn;
    float* xbuf; unsigned* cnt;
    __device__ __forceinline__ void fused(f32x4 (&acc)[2][2][4][2], const Unit& u, int wr, int wc, int fr, int fq, PG8_LAS unsigned char* lds, int wid, int lane) const {
        const int cond = (u.pm < 32) ? 4 : ((u.pm - 32) >> 3);
        const int col0 = u.pn * BM + wc * 32 + 8 * fq;
        {
            const float* gp = modl + (size_t)cond * NMODV + gidx * DM + col0;
            f32x4 gv[2][2];
#pragma unroll
            for (int bj = 0; bj < 2; ++bj)
#pragma unroll
                for (int n = 0; n < 2; ++n) gv[bj][n] = *(const f32x4*)(gp + bj * HALF + n * 4) * coef;
#pragma unroll
            for (int ai = 0; ai < 2; ++ai)
#pragma unroll
                for (int m = 0; m < 4; ++m) {
                    const f16* rowp = XH + (size_t)(u.pm * BM + ai * HALF + wr * 64 + m * 16 + fr) * DM + col0;
                    f32x4 xv[2][2];
#pragma unroll
                    for (int bj = 0; bj < 2; ++bj) { const f16x8 xh = *(const f16x8*)(rowp + bj * HALF);
                        xv[bj][0] = (f32x4){(float)xh[0], (float)xh[1], (float)xh[2], (float)xh[3]}; xv[bj][1] = (f32x4){(float)xh[4], (float)xh[5], (float)xh[6], (float)xh[7]}; }
#pragma unroll
                    for (int bj = 0; bj < 2; ++bj)
#pragma unroll
                        for (int n = 0; n < 2; ++n) { const f32x4 v = xv[bj][n] + gv[bj][n] * acc[ai][bj][m][n]; acc[ai][bj][m][n] = v; }
                    asm volatile("" : "+v"(acc[ai][0][m][0]), "+v"(acc[ai][0][m][1]), "+v"(acc[ai][1][m][0]), "+v"(acc[ai][1][m][1]));
                    if (m & 1) asm volatile("" ::: "memory");
                }
        }
        if (!donorm) {
#pragma unroll
            for (int ai = 0; ai < 2; ++ai)
#pragma unroll
                for (int m = 0; m < 4; ++m) {
                    float* rowp = X + (size_t)(u.pm * BM + ai * HALF + wr * 64 + m * 16 + fr) * DM + col0;
#pragma unroll
                    for (int bj = 0; bj < 2; ++bj)
#pragma unroll
                        for (int n = 0; n < 2; ++n) *(f32x4*)(rowp + bj * HALF + n * 4) = acc[ai][bj][m][n];
                }
            return;
        }
        PG8_LAS float* P = (PG8_LAS float*)lds;
        PG8_LAS float* S = (PG8_LAS float*)(lds + 4096);
#pragma unroll
        for (int ai = 0; ai < 2; ++ai)
#pragma unroll
            for (int m = 0; m < 4; ++m) {
                float q = 0.f;
#pragma unroll
                for (int bj = 0; bj < 2; ++bj)
#pragma unroll
                    for (int n = 0; n < 2; ++n) { const f32x4 x = acc[ai][bj][m][n]; q += (x[0] * x[0] + x[1] * x[1]) + (x[2] * x[2] + x[3] * x[3]); }
                q += __shfl_xor(q, 16); q += __shfl_xor(q, 32);
                if (fq == 0) P[(ai * HALF + wr * 64 + m * 16 + fr) * 4 + wc] = q;
            }
        asm volatile("s_waitcnt lgkmcnt(0)" ::: "memory"); __builtin_amdgcn_s_barrier(); asm volatile("" ::: "memory");
        const int row = wid * 32 + (lane & 31);
        if (lane < 32) {
            const float tot = (P[row * 4 + 0] + P[row * 4 + 1]) + (P[row * 4 + 2] + P[row * 4 + 3]);
            __hip_atomic_store(xbuf + ((size_t)(u.pm * BM + row) * 4 + u.pn), tot, __ATOMIC_RELAXED, __HIP_MEMORY_SCOPE_AGENT);
        }
        asm volatile("s_waitcnt vmcnt(0)" ::: "memory");
        if (lane == 0) __hip_atomic_fetch_add(cnt + 64 * u.pm, 1u, __ATOMIC_RELAXED, __HIP_MEMORY_SCOPE_AGENT);
#pragma unroll
        for (int ai = 0; ai < 2; ++ai)
#pragma unroll
            for (int m = 0; m < 4; ++m) {
                f16* rowp = XH + (size_t)(u.pm * BM + ai * HALF + wr * 64 + m * 16 + fr) * DM + col0;
#pragma unroll
                for (int bj = 0; bj < 2; ++bj) *(f16x8*)(rowp + bj * HALF) = pack8(cvt4v(acc[ai][bj][m][0]), cvt4v(acc[ai][bj][m][1]));
            }
        if (wid == 0) {
            unsigned spins = 0;
            for (;;) {
                if ((unsigned)__builtin_amdgcn_readfirstlane(__hip_atomic_load(cnt + 64 * u.pm, __ATOMIC_RELAXED, __HIP_MEMORY_SCOPE_AGENT)) >= 32u) break;
                if (++spins > (1u << 20)) break;
                __builtin_amdgcn_s_sleep(2);
            }
            __builtin_amdgcn_fence(__ATOMIC_ACQUIRE, "agent");
        }
        asm volatile("s_waitcnt vmcnt(0) lgkmcnt(0)" ::: "memory"); __builtin_amdgcn_s_barrier(); asm volatile("" ::: "memory");
        if (lane < 32) {
            const float* slot = xbuf + (size_t)(u.pm * BM + row) * 4;
            const float t0 = __hip_atomic_load(slot + 0, __ATOMIC_RELAXED, __HIP_MEMORY_SCOPE_AGENT), t1 = __hip_atomic_load(slot + 1, __ATOMIC_RELAXED, __HIP_MEMORY_SCOPE_AGENT);
            const float t2 = __hip_atomic_load(slot + 2, __ATOMIC_RELAXED, __HIP_MEMORY_SCOPE_AGENT), t3 = __hip_atomic_load(slot + 3, __ATOMIC_RELAXED, __HIP_MEMORY_SCOPE_AGENT);
            S[row] = 1.0f / sqrtf(((t0 + t1) + (t2 + t3)) * (1.0f / DM) + EPS);
        }
        asm volatile("s_waitcnt lgkmcnt(0)" ::: "memory"); __builtin_amdgcn_s_barrier(); asm volatile("" ::: "memory");
        const float* shp = shn + (size_t)cond * NMODV + col0;
        f32x4 gsv[2][2], shv[2][2];
#pragma unroll
        for (int bj = 0; bj < 2; ++bj)
#pragma unroll
            for (int n = 0; n < 2; ++n) { const int co = bj * HALF + n * 4;
                gsv[bj][n] = *(const f32x4*)(gn + col0 + co) * (*(const f32x4*)(shp + DM + co) + 1.0f); shv[bj][n] = *(const f32x4*)(shp + co); }
#pragma unroll
        for (int ai = 0; ai < 2; ++ai)
#pragma unroll
            for (int m = 0; m < 4; ++m) { const int r = ai * HALF + wr * 64 + m * 16 + fr; const float sr = S[r];
#pragma unroll
                for (int bj = 0; bj < 2; ++bj) *(f16x8*)(H + (size_t)(u.pm * BM + r) * DM + col0 + bj * HALF) = pack8(cvt4v(acc[ai][bj][m][0] * sr * gsv[bj][0] + shv[bj][0]), cvt4v(acc[ai][bj][m][1] * sr * gsv[bj][1] + shv[bj][1])); }
    }
};

template <class Epi, class Sched, bool ALIGN_EPI, bool SP2>
__device__ __forceinline__ void gemm_phase(PG8_LAS unsigned char* lds, const Gemm g, const Sched& S, const Epi& E, int wave_id) {
    const int lane = lane_id_fresh(), wid = wave_id, tid = wid * 64 + lane, wr = wid >> 2, wc = wid & 3, fr = lane & 15, fq = lane >> 4;
    const int K = g.K, nt = K / BK;
    unsigned voffA[2], voffB[2];
#pragma unroll
    for (int i = 0; i < 2; ++i) { int R, C; stage_rc(tid * 16 + i * 8192, R, C); const int Rb = Epi::PERM ? ((R & ~31) + perm32(R & 31)) : R;
        voffA[i] = (unsigned)(R * K + C) * 2u; voffB[i] = (unsigned)(Rb * K + C) * 2u; }
    const size_t kstep = (size_t)(BK * 2);
    const size_t hstep = (size_t)HALF * K * 2;
    const size_t tstep = 2 * hstep;
    const unsigned ldsw = (unsigned)wid * 1024u;
    const int aoff = lds_byte(wr * 64 + fr, fq * 8), boff = lds_byte(wc * 32 + fr, fq * 8);
#define PG8_SA(b, h) (((b) * 2 + (h)) * HTB)
#define PG8_SB(b, h) ((4 + (b) * 2 + (h)) * HTB)
#define PG8_STAGE(bufoff, gbase, voff) do { _Pragma("unroll") for (int _i = 0; _i < 2; ++_i) \
        __builtin_amdgcn_global_load_lds((const unsigned*)((const char*)(gbase) + (voff)[_i]), (PG8_LAS unsigned*)(lds + (bufoff) + ldsw + _i * 8192), 16, 0, 0); } while (0)
#define PG8_LDA(dst, b, h) do { _Pragma("unroll") for (int m = 0; m < 4; ++m) _Pragma("unroll") for (int k = 0; k < 2; ++k) dst[m][k] = *(const PG8_LAS f16x8*)(lds + PG8_SA(b, h) + aoff + m * 2048 + k * 1024); } while (0)
#define PG8_LDB(dst, b, h) do { _Pragma("unroll") for (int n = 0; n < 2; ++n) _Pragma("unroll") for (int k = 0; k < 2; ++k) dst[n][k] = *(const PG8_LAS f16x8*)(lds + PG8_SB(b, h) + boff + n * 2048 + k * 1024); } while (0)
#define PG8_MMA(ai, bj, At, Bt) do { __builtin_amdgcn_s_setprio(1); _Pragma("unroll") for (int m = 0; m < 4; ++m) _Pragma("unroll") for (int n = 0; n < 2; ++n) _Pragma("unroll") for (int k = 0; k < 2; ++k) \
        acc[ai][bj][m][n] = __builtin_amdgcn_mfma_f32_16x16x32_f16(Bt[n][k], At[m][k], acc[ai][bj][m][n], 0, 0, 0); __builtin_amdgcn_s_setprio(0); } while (0)
#define PG8_WAIT_V(n) asm volatile("s_waitcnt vmcnt(" #n ")" ::: "memory")
#define PG8_WAIT_L(n) asm volatile("s_waitcnt lgkmcnt(" #n ")" ::: "memory")
#define PG8_BAR __builtin_amdgcn_s_barrier()
#define PG8_SCHED __builtin_amdgcn_sched_barrier(0)
    Unit cur, nxt; int ui = 0;
    if (!S.next(0, cur)) return;
    f32x4 acc[2][2][4][2];
#pragma unroll
    for (int a = 0; a < 2; ++a)
#pragma unroll
        for (int b = 0; b < 2; ++b)
#pragma unroll
            for (int m = 0; m < 4; ++m)
#pragma unroll
                for (int n = 0; n < 2; ++n) acc[a][b][m][n] = (f32x4){0.f, 0.f, 0.f, 0.f};
    f16x8 At[4][2], B0[2][2], B1[2][2];
    const char* cA = (const char*)g.A + (size_t)cur.pm * tstep; const char* cB = (const char*)g.Bt + (size_t)cur.pn * tstep;
    if constexpr (SP2) {
        PG8_STAGE(PG8_SB(0, 0), cB, voffB); PG8_STAGE(PG8_SB(0, 1), cB + hstep, voffB); PG8_STAGE(PG8_SA(0, 0), cA, voffA); PG8_STAGE(PG8_SA(0, 1), cA + hstep, voffA);
        if (wr == 1) PG8_BAR;
        PG8_WAIT_V(2); PG8_BAR;
        PG8_STAGE(PG8_SB(1, 0), cB + kstep, voffB); PG8_STAGE(PG8_SA(1, 0), cA + kstep, voffA); PG8_STAGE(PG8_SB(1, 1), cB + hstep + kstep, voffB);
        PG8_WAIT_V(6); PG8_BAR;
    } else {
        PG8_STAGE(PG8_SB(0, 0), cB, voffB); PG8_STAGE(PG8_SA(0, 0), cA, voffA); PG8_STAGE(PG8_SB(0, 1), cB + hstep, voffB); PG8_STAGE(PG8_SA(0, 1), cA + hstep, voffA);
        if (wr == 1) PG8_BAR;
        PG8_WAIT_V(4); PG8_BAR;
        PG8_STAGE(PG8_SB(1, 0), cB + kstep, voffB); PG8_STAGE(PG8_SA(1, 0), cA + kstep, voffA); PG8_STAGE(PG8_SB(1, 1), cB + hstep + kstep, voffB);
        PG8_WAIT_V(6); PG8_BAR;
    }
    for (;;) {
        const bool has_next = S.next(ui + 1, nxt);
        const char* nA = has_next ? (const char*)g.A + (size_t)nxt.pm * tstep : cA; const char* nB = has_next ? (const char*)g.Bt + (size_t)nxt.pn * tstep : cB;
        for (int t = 0; t < nt; t += 2) {
            const bool last = (t == nt - 2);
            const char* a1 = cA + (size_t)(t + 1) * kstep;
            const char* a2 = last ? nA : cA + (size_t)(t + 2) * kstep; const char* b2 = last ? nB : cB + (size_t)(t + 2) * kstep;
            const char* a3 = a2 + kstep; const char* b3 = b2 + kstep;
            if constexpr (SP2) {
            PG8_LDB(B0, 0, 0); PG8_LDB(B1, 0, 1); PG8_SCHED; PG8_LDA(At, 0, 0); PG8_STAGE(PG8_SA(1, 1), a1 + hstep, voffA);
            PG8_WAIT_V(8); PG8_WAIT_L(0); PG8_BAR; PG8_MMA(0, 0, At, B0); PG8_MMA(0, 1, At, B1); PG8_BAR; PG8_SCHED;
            PG8_LDA(At, 0, 1); PG8_STAGE(PG8_SB(0, 0), b2, voffB); PG8_STAGE(PG8_SB(0, 1), b2 + hstep, voffB); PG8_STAGE(PG8_SA(0, 0), a2, voffA);
            PG8_WAIT_V(8); PG8_WAIT_L(0); PG8_BAR; PG8_MMA(1, 0, At, B0); PG8_MMA(1, 1, At, B1); PG8_BAR; PG8_SCHED;
            PG8_LDB(B0, 1, 0); PG8_LDB(B1, 1, 1); PG8_SCHED; PG8_LDA(At, 1, 0); PG8_STAGE(PG8_SA(0, 1), a2 + hstep, voffA);
            PG8_WAIT_V(8); PG8_WAIT_L(0); PG8_BAR; PG8_MMA(0, 0, At, B0); PG8_MMA(0, 1, At, B1); PG8_BAR; PG8_SCHED;
            PG8_LDA(At, 1, 1); PG8_STAGE(PG8_SB(1, 0), b3, voffB); PG8_STAGE(PG8_SB(1, 1), b3 + hstep, voffB); PG8_STAGE(PG8_SA(1, 0), a3, voffA);
            PG8_WAIT_V(8); PG8_WAIT_L(0); PG8_BAR; PG8_MMA(1, 0, At, B0); PG8_MMA(1, 1, At, B1); PG8_BAR; PG8_SCHED;
            } else {
            PG8_LDB(B0, 0, 0); PG8_SCHED; PG8_LDA(At, 0, 0); PG8_STAGE(PG8_SA(1, 1), a1 + hstep, voffA);
            PG8_WAIT_L(8); PG8_BAR; PG8_WAIT_L(0); PG8_MMA(0, 0, At, B0); PG8_BAR; PG8_SCHED;
            PG8_LDB(B1, 0, 1); PG8_STAGE(PG8_SB(0, 0), b2, voffB);
            PG8_BAR; PG8_WAIT_L(0); PG8_MMA(0, 1, At, B1); PG8_BAR;
            PG8_LDA(At, 0, 1); PG8_STAGE(PG8_SA(0, 0), a2, voffA);
            PG8_BAR; PG8_WAIT_L(0); PG8_MMA(1, 0, At, B0); PG8_BAR; PG8_SCHED;
            PG8_STAGE(PG8_SB(0, 1), b2 + hstep, voffB);
            PG8_WAIT_V(6); PG8_BAR; PG8_MMA(1, 1, At, B1); PG8_BAR;
            PG8_LDB(B0, 1, 0); PG8_SCHED; PG8_LDA(At, 1, 0); PG8_STAGE(PG8_SA(0, 1), a2 + hstep, voffA);
            PG8_WAIT_L(8); PG8_BAR; PG8_WAIT_L(0); PG8_MMA(0, 0, At, B0); PG8_BAR; PG8_SCHED;
            PG8_LDB(B1, 1, 1); PG8_STAGE(PG8_SB(1, 0), b3, voffB);
            PG8_BAR; PG8_WAIT_L(0); PG8_MMA(0, 1, At, B1); PG8_BAR;
            PG8_LDA(At, 1, 1); PG8_STAGE(PG8_SA(1, 0), a3, voffA);
            PG8_BAR; PG8_WAIT_L(0); PG8_MMA(1, 0, At, B0); PG8_BAR; PG8_SCHED;
            PG8_STAGE(PG8_SB(1, 1), b3 + hstep, voffB);
            PG8_WAIT_V(6); PG8_BAR; PG8_MMA(1, 1, At, B1); PG8_BAR;
            }
        }
        if constexpr (ALIGN_EPI) { if (wr == 0) PG8_BAR; }
        if constexpr (!Epi::AFTER_DRAIN) E(acc, cur, wr, wc, fr, fq);
        if (!has_next) break;
#pragma unroll
        for (int a = 0; a < 2; ++a)
#pragma unroll
            for (int b = 0; b < 2; ++b)
#pragma unroll
                for (int m = 0; m < 4; ++m)
#pragma unroll
                    for (int n = 0; n < 2; ++n) acc[a][b][m][n] = (f32x4){0.f, 0.f, 0.f, 0.f};
        cur = nxt; cA = nA; cB = nB; ++ui;
        if constexpr (ALIGN_EPI) { if (wr == 1) PG8_BAR; }
    }
    PG8_WAIT_V(0);
    if constexpr (!ALIGN_EPI) { if (wr == 0) PG8_BAR; }
    PG8_BAR;
    if constexpr (Epi::AFTER_DRAIN) E.fused(acc, cur, wr, wc, fr, fq, lds, wid, lane);
#undef PG8_SA
#undef PG8_SB
#undef PG8_STAGE
#undef PG8_LDA
#undef PG8_LDB
#undef PG8_MMA
#undef PG8_WAIT_V
#undef PG8_WAIT_L
#undef PG8_BAR
#undef PG8_SCHED
}
}

#define XB_TMO      128
#define XB_XCNT(j)  (256  + 64 * (j))
#define XB_XSUB(j)  (1280 + 64 * (j))
#define XB_XGEN(j)  (2304 + 64 * (j))
#define XB_TOP      3328
#define XB_TOPGEN   3392
#define XCD_BAR_WORDS 3456
#define XB_SPIN_CAP (1u << 18)
__device__ __forceinline__ unsigned xb_ld(unsigned* p)              { return __hip_atomic_load(p, __ATOMIC_RELAXED, __HIP_MEMORY_SCOPE_AGENT); }
__device__ __forceinline__ unsigned xb_add(unsigned* p, unsigned v) { return __hip_atomic_fetch_add(p, v, __ATOMIC_RELAXED, __HIP_MEMORY_SCOPE_AGENT); }
__device__ __forceinline__ unsigned xb_xcc_id() { return (unsigned)__builtin_amdgcn_s_getreg((3 << 11) | 20) & 0xFu; }
#define XB_SPIN(cond, bar) do { unsigned _sp = 0; while (cond) { __builtin_amdgcn_s_sleep(1); \
    if ((++_sp & 255u) == 0u) { if (xb_ld(&(bar)[XB_TMO])) break; if (_sp > XB_SPIN_CAP) { atomicAdd(&(bar)[XB_TMO], 1u); break; } } } } while (0)
struct XcdBarrier { unsigned* bar; unsigned x; volatile LAS unsigned* st; };
__device__ __forceinline__ XcdBarrier xcd_barrier_post(unsigned* bar, volatile LAS unsigned* st) {
    XcdBarrier b; b.bar = bar; b.x = xb_xcc_id(); b.st = st;
    if (threadIdx.x == 0) (void)xb_add(&bar[XB_XCNT(b.x)], 1u);
    return b;
}
__device__ __forceinline__ void xcd_barrier_complete(unsigned* bar, unsigned x, unsigned& nloc, unsigned& nx) {
    const unsigned G = gridDim.x * gridDim.y * gridDim.z;
    unsigned sum, cnt, mine, sp = 0u;
    for (;;) {
        sum = 0u; cnt = 0u; mine = 0u;
#pragma unroll
        for (unsigned j = 0; j < 16; ++j) { const unsigned c = xb_ld(&bar[XB_XCNT(j)]); sum += c; cnt += (c > 0u) ? 1u : 0u; mine = (j == x) ? c : mine; }
        if (sum == G) break;
        __builtin_amdgcn_s_sleep(1);
        if ((++sp & 255u) == 0u) { if (xb_ld(&bar[XB_TMO])) break; if (sp > XB_SPIN_CAP) { atomicAdd(&bar[XB_TMO], 1u); break; } }
    }
    nloc = mine > 0u ? mine : 1u; nx = cnt > 0u ? cnt : 1u;
}
__device__ __forceinline__ void xcd_barrier(const XcdBarrier& b, int wave_id) {
    asm volatile("s_waitcnt vmcnt(0)" ::: "memory");
    __syncthreads();
    if (wave_id == 0 && lane_id_fresh() == 0) {
        unsigned* bar = b.bar;
        __builtin_amdgcn_s_waitcnt(0);
        unsigned nloc = b.st[0], nx = b.st[1];
        if (nloc == 0u) { xcd_barrier_complete(bar, b.x, nloc, nx); b.st[0] = nloc; b.st[1] = nx; }
        const unsigned old = xb_add(&bar[XB_XSUB(b.x)], 1u);
        const unsigned gen = old / nloc;
        if (old + 1u == (gen + 1u) * nloc) {
            __builtin_amdgcn_fence(__ATOMIC_RELEASE, "agent");
            asm volatile("s_waitcnt vmcnt(0)" ::: "memory");
            const unsigned og = xb_add(&bar[XB_TOP], 1u);
            const unsigned tg = og / nx;
            if (og + 1u == (tg + 1u) * nx) xb_add(&bar[XB_TOPGEN], 1u);
            else XB_SPIN(xb_ld(&bar[XB_TOPGEN]) == tg, bar);
            __builtin_amdgcn_fence(__ATOMIC_ACQUIRE, "agent");
            xb_add(&bar[XB_XGEN(b.x)], 1u);
            asm volatile("s_waitcnt vmcnt(0)" ::: "memory");
        } else {
            XB_SPIN(xb_ld(&bar[XB_XGEN(b.x)]) == gen, bar);
            __builtin_amdgcn_fence(__ATOMIC_ACQUIRE, "agent");
            asm volatile("s_waitcnt vmcnt(0)" ::: "memory");
        }
    }
    __syncthreads();
}

struct Args { const float* in[N_IN]; float* out; unsigned char* ws; int ph_lo, ph_hi; };
static_assert(sizeof(Args) == N_IN * 8 + 8 + 8 + 8, "Args has no padding");

struct Ctx {
    const float* const* in; float* out; unsigned char* ws;
    LAS unsigned char* lds;
    int tid, lane, wave, gw, ngw, bid, G;
};
#define WSP(T, off) ((T*)(C.ws + (off)))
__device__ __forceinline__ Ctx ctx_fresh(const Ctx& C0) {
    Ctx C = C0; C.lane = lane_id_fresh(); C.tid = C.wave * 64 + C.lane;
    int bid = blockIdx.x, G = gridDim.x; asm volatile("" : "+s"(bid), "+s"(G));
    C.bid = bid; C.G = G; C.gw = bid * 8 + C.wave; C.ngw = G * 8;
    return C;
}

__device__ __forceinline__ int wq_next(unsigned* ctr, int lane) {
    unsigned v = 0;
    if (lane == 0) v = __hip_atomic_fetch_add(ctr, 1u, __ATOMIC_RELAXED, __HIP_MEMORY_SCOPE_AGENT);
    return (int)__builtin_amdgcn_readfirstlane(v);
}

__device__ __forceinline__ void transpose_item(const float* W, int ldw, f16* WT, int ldt, int dst_row0, int k0, int n0, LAS float* scr, int lane) {
    f32x4 wv[8];
#pragma unroll
    for (int i = 0; i < 8; ++i) wv[i] = __builtin_nontemporal_load((const f32x4*)(W + (size_t)(k0 + 8 * i + (lane >> 3)) * ldw + n0 + 4 * (lane & 7)));
#pragma unroll
    for (int i = 0; i < 8; ++i) { LAS float* d = scr + (8 * i + (lane >> 3)) * 33 + 4 * (lane & 7); d[0] = wv[i][0]; d[1] = wv[i][1]; d[2] = wv[i][2]; d[3] = wv[i][3]; }
    asm volatile("s_waitcnt lgkmcnt(0)" ::: "memory");
    const int c = lane & 7;
#pragma unroll
    for (int j = 0; j < 4; ++j) { const int n = (lane >> 3) + 8 * j; const LAS float* s = scr + (8 * c) * 33 + n;
        const f16x8 o = pack8(cvt4(s[0 * 33], s[1 * 33], s[2 * 33], s[3 * 33]), cvt4(s[4 * 33], s[5 * 33], s[6 * 33], s[7 * 33]));
        *(f16x8*)(WT + (size_t)(dst_row0 + n) * ldt + k0 + 8 * c) = o; }
    asm volatile("s_waitcnt lgkmcnt(0)" ::: "memory");
}
__device__ __forceinline__ void phase_prep(const Ctx& C0) {
    const Ctx C = ctx_fresh(C0);
    {
        LAS float* sc = (LAS float*)C.lds;
        LAS float* red = (LAS float*)(C.lds + 20480);
        const float* cv = C.in[I_C]; const float* cctx = C.in[I_CCTX];
        for (int i = C.tid; i < 5 * 1024; i += 512) { const int c = i >> 10, k = i & 1023; const float v = (c < 4) ? cv[c * 1024 + k] : cctx[k]; sc[i] = v / (1.0f + __expf(-v)); }
        __syncthreads();
        float* mod = WSP(float, WS_MOD);
        for (int item = C.bid; item < 2 * 144; item += C.G) {
            const int l = item / 144, j0 = (item % 144) * 64, k0 = C.wave * 128;
            const float* wp = C.in[I_WADA] + ((size_t)l * 1024 + k0) * NMODV + j0 + C.lane;
            float a0 = 0.f, a1 = 0.f, a2 = 0.f, a3 = 0.f, a4 = 0.f;
#pragma unroll 16
            for (int kk = 0; kk < 128; ++kk) {
                const float w = __builtin_nontemporal_load(&wp[(size_t)kk * NMODV]);
                a0 += sc[0 * 1024 + k0 + kk] * w; a1 += sc[1 * 1024 + k0 + kk] * w; a2 += sc[2 * 1024 + k0 + kk] * w; a3 += sc[3 * 1024 + k0 + kk] * w; a4 += sc[4 * 1024 + k0 + kk] * w;
            }
            red[(C.wave * 5 + 0) * 64 + C.lane] = a0; red[(C.wave * 5 + 1) * 64 + C.lane] = a1; red[(C.wave * 5 + 2) * 64 + C.lane] = a2;
            red[(C.wave * 5 + 3) * 64 + C.lane] = a3; red[(C.wave * 5 + 4) * 64 + C.lane] = a4;
            __syncthreads();
            if (C.tid < 320) { const int c = C.tid >> 6, ln = C.tid & 63; float s = 0.f;
#pragma unroll
                for (int w = 0; w < 8; ++w) s += red[(w * 5 + c) * 64 + ln];
                mod[((size_t)l * 5 + c) * NMODV + j0 + ln] = s + C.in[I_BADA][(size_t)l * NMODV + j0 + ln]; }
            __syncthreads();
        }
    }
    __syncthreads();
    {
        LAS float* scr = (LAS float*)(C.lds + C.wave * 16384);
        constexpr int IFI = 16 * 176, IFO = 44 * 32, IIN = 16 * 67, IOUT = 16 * 32;
        constexpr int NIT = 4 * IFI + 4 * IFO + 2 * IIN + 2 * IOUT;
        for (int it = C.gw; it < NIT; it += C.ngw) {
            int r = it;
            if (r < 4 * IFI) { const int mat = r / IFI, rr = r % IFI, kb = rr / 176, n0 = (rr % 176) * 32;
                const int drow = (n0 < DFF) ? ((n0 >> 7) * 256 + (n0 & 127)) : (((n0 - DFF) >> 7) * 256 + 128 + ((n0 - DFF) & 127));
                transpose_item(C.in[I_WFI] + (size_t)mat * 1024 * NFF2, NFF2, WSP(f16, WS_WFI) + (size_t)mat * NFF2 * 1024, 1024, drow, kb * 64, n0, scr, C.lane); continue; }
            r -= 4 * IFI;
            if (r < 4 * IFO) { const int mat = r / IFO, rr = r % IFO, kb = rr / 32, n0 = (rr % 32) * 32;
                transpose_item(C.in[I_WFO] + (size_t)mat * DFF * 1024, 1024, WSP(f16, WS_WFO) + (size_t)mat * 1024 * DFF, DFF, n0, kb * 64, n0, scr, C.lane); continue; }
            r -= 4 * IFO;
            if (r < 2 * IIN) { const int l = r / IIN, rr = r % IIN, kb = rr / 67, n0 = (rr % 67) * 32;
                transpose_item(C.in[I_WIN] + (size_t)l * 1024 * DIN, DIN, WSP(f16, WS_WIN) + (size_t)l * DINP * 1024, 1024, n0, kb * 64, n0, scr, C.lane); continue; }
            r -= 2 * IIN;
            { const int l = r / IOUT, rr = r % IOUT, kb = rr / 32, n0 = (rr % 32) * 32;
                transpose_item(C.in[I_WOUT] + (size_t)l * 1024 * 1024, 1024, WSP(f16, WS_WOUT) + (size_t)l * 1024 * 1024, 1024, n0, kb * 64, n0, scr, C.lane); }
        }
    }
    {
        const int gt = C.bid * 512 + C.tid, ngt = C.G * 512;
        for (int i = gt; i < 2 * 160 * 128; i += ngt) { const int l = i / (160 * 128), rr = i % (160 * 128);
            unsigned z = 0u; asm volatile("" : "+v"(z));
            *(u32x4*)(WSP(f16, WS_WIN) + ((size_t)l * DINP + DIN) * 1024 + (size_t)rr * 8) = (u32x4){z, z, z, z}; }
        f16* wuq = WSP(f16, WS_WUQ);
        for (int i = gt; i < 2 * 384 * 192; i += ngt) { const int e = i & 7, r = (i >> 3) & 31, rest = i >> 8, c = rest % 24, rest2 = rest / 24, t3 = rest2 % 3, lh = rest2 / 3, l = lh >> 2, hd = lh & 3;
            wuq[i] = (f16)(C.in[I_CQN][l * 192 + 8 * c + e] * C.in[I_WUQ][(size_t)l * 192 * 384 + (size_t)(8 * c + e) * 384 + hd * 96 + 32 * t3 + r]); }
        f16* wukv = WSP(f16, WS_WUKV);
        for (int i = gt; i < 2 * 512 * 128; i += ngt) { const int e = i & 7, r = (i >> 3) & 31, rest = i >> 8, c = rest & 15, rest2 = rest >> 4, t4 = rest2 & 3, lh = rest2 >> 2, l = lh >> 2, hd = lh & 3;
            const float w = C.in[I_WUKV][(size_t)l * 128 * 512 + (size_t)(8 * c + e) * 512 + hd * 128 + 32 * t4 + r];
            wukv[i] = (f16)(C.in[I_CKVN][l * 128 + 8 * c + e] * w); WSP(f16, WS_WUKV0)[i] = (f16)w; }
        for (int i = gt; i < 4096; i += ngt) WSP(f16, WS_IDN)[i] = ((i >> 6) == (i & 63)) ? (f16)1.0f : (f16)0.0f;
        f16* wg = WSP(f16, WS_WG);
        for (int i = gt; i < 64 * 4096; i += ngt) { const int m = i >> 12, d = (i >> 6) & 63, c = i & 63; wg[i] = (f16)C.in[I_WGATE][(size_t)m * 4096 + c * 64 + d]; }
    }
}

template <bool FIRST>
__device__ __forceinline__ void phase_norm(const Ctx& C0, int l, int sub) {
    const Ctx C = ctx_fresh(C0);
    const float* gvec = C.in[I_NG] + ((size_t)l * 3 + sub) * DM;
    const float* modl = WSP(float, WS_MOD) + (size_t)l * 5 * NMODV;
    f16* H = WSP(f16, WS_H);
    for (int row = C.gw; row < M; row += C.ngw) {
        const float* src = FIRST ? ((row < MP) ? C.in[I_XP] + (size_t)row * DM : C.in[I_XS] + (size_t)(row - MP) * DM) : C.out + (size_t)row * DM;
        const int cond = (row < MP) ? 4 : ((row - MP) >> 11);
        const float* shp = modl + (size_t)cond * NMODV + (3 * sub) * DM; const float* scp = shp + DM;
        f32x4 v[4]; float ss = 0.f;
#pragma unroll
        for (int j = 0; j < 4; ++j) { v[j] = FIRST ? __builtin_nontemporal_load((const f32x4*)(src + 256 * j + 4 * C.lane)) : *(const f32x4*)(src + 256 * j + 4 * C.lane); ss += (v[j].x * v[j].x + v[j].y * v[j].y) + (v[j].z * v[j].z + v[j].w * v[j].w); }
        const float rstd = 1.0f / sqrtf(wave_sum(ss) * (1.0f / DM) + EPS);
        f32x4 gs[4], shv[4];
#pragma unroll
        for (int j = 0; j < 4; ++j) { const int k = 256 * j + 4 * C.lane; gs[j] = *(const f32x4*)(gvec + k) * (*(const f32x4*)(scp + k) + 1.0f); shv[j] = *(const f32x4*)(shp + k); }
#pragma unroll
        for (int j = 0; j < 4; ++j) {
            const int k = 256 * j + 4 * C.lane;
            *(f16x4*)(H + (size_t)row * DM + k) = cvt4v(v[j] * rstd * gs[j] + shv[j]);
            if (FIRST) *(f16x4*)(WSP(f16, WS_XH) + (size_t)row * DM + k) = cvt4v(v[j]);
        }
    }
}

__device__ __forceinline__ void glds16(const void* gsrc, unsigned lds_dst) { unsigned keep;
    asm volatile("s_mov_b32 %0, m0\n\ts_mov_b32 m0, %2\n\ts_nop 0\n\tglobal_load_lds_dwordx4 %1, off\n\ts_mov_b32 m0, %0" : "=&s"(keep) : "v"(gsrc), "s"(lds_dst) : "memory"); }
#define ATT_GLDS(g, l) glds16((const void*)(g), (unsigned)__builtin_amdgcn_readfirstlane((unsigned)(uintptr_t)(l)))
#define ATT_WAITBAR(N) asm volatile("s_waitcnt vmcnt(" #N ") lgkmcnt(0)\n\ts_barrier" ::: "memory")
#define ATT_LBAR() asm volatile("s_waitcnt lgkmcnt(0)\n\ts_barrier" ::: "memory")
struct MxTok { int b, t, key, ktile, kin; size_t row, ob; };
template <int KIND>
__device__ __forceinline__ MxTok mx_decode(int wt, int tok, int l) {
    MxTok m; m.row = 0;
    if (KIND == 0) { m.row = (size_t)wt * 32 + tok; m.b = (int)(m.row >> 8); m.t = (int)(m.row & 255); m.key = m.t; }
    else if (KIND == 1) { m.row = (size_t)wt * 32 + tok; const int rs = (int)m.row - MP; m.b = rs >> 11; m.t = rs & 2047; m.key = PAST + m.t; }
    else { const int idx = (wt - 512) * 32 + tok; m.b = idx >> 9; m.t = idx & 511; m.key = m.t; }
    m.ktile = m.key >> 6; m.kin = m.key & 63; m.ob = ((size_t)m.b * 2 + l) * TP + m.t;
    return m;
}
template <int KIND>
__device__ __forceinline__ void mx_rope(int t, int hi, float (&cr)[4], float (&sr)[4], float (&cc)[4], float (&scn)[4]) {
#pragma unroll
    for (int e = 0; e < 4; ++e) { cr[e] = 1.f; sr[e] = 0.f; cc[e] = 1.f; scn[e] = 0.f; }
    if (KIND == 1) {
        const float gr = (float)(t >> 6), gc = (float)(t & 63);
#pragma unroll
        for (int e = 0; e < 4; ++e) { const float inv = exp2f(-(float)(4 * hi + e) * (13.287712379549449f / 8.0f));
            const float fr = gr * inv * 0.15915494309189535f, fc = gc * inv * 0.15915494309189535f;
            sr[e] = __builtin_amdgcn_sinf(fr); cr[e] = __builtin_amdgcn_cosf(fr); scn[e] = __builtin_amdgcn_sinf(fc); cc[e] = __builtin_amdgcn_cosf(fc); }
    }
}
template <int KIND, int SUB>
__device__ __forceinline__ void mx_a(const Ctx& C, int l, int wt) {
    const int lane = lane_id_fresh(), tok = lane & 31, hi = lane >> 5;
    constexpr int Tk = (KIND == 0) ? TP : TKS, NT = Tk / 64;
    const MxTok m = mx_decode<KIND>(wt, tok, l);
    const f16* prow = WSP(f16, WS_ACT) + m.row * DINP;
    f16* KA = (KIND == 0) ? WSP(f16, WS_KAP) : WSP(f16, WS_KAS);
    f16* VA = (KIND == 0) ? WSP(f16, WS_VATP) : WSP(f16, WS_VATS);
    if (SUB < 2) {
        if (KIND != 2) {
            constexpr int qk = SUB;
            float cr[4], sr[4], cc[4], scn[4];
            mx_rope<KIND>(m.t, hi, cr, sr, cc, scn);
            f32x4 gain[4];
#pragma unroll
            for (int g = 0; g < 4; ++g) gain[g] = *(const f32x4*)(C.in[I_DQKN] + ((size_t)l * 2 + qk) * 32 + 8 * g + 4 * hi);
            f16x4 raw[8][4];
#pragma unroll
            for (int hc = 0; hc < 8; ++hc)
#pragma unroll
                for (int g = 0; g < 4; ++g) raw[hc][g] = *(const f16x4*)(prow + (qk ? PC_KA : PC_QA) + hc * 32 + 4 * hi + 8 * g);
#pragma unroll
            for (int hc = 0; hc < 8; ++hc) {
                f32x4 x[4]; float ss = 0.f;
#pragma unroll
                for (int g = 0; g < 4; ++g) { x[g] = tof32(raw[hc][g]); ss += (x[g].x * x[g].x + x[g].y * x[g].y) + (x[g].z * x[g].z + x[g].w * x[g].w); }
                ss += __shfl_xor(ss, 32);
                const float rstd = 1.0f / sqrtf(ss * (1.0f / 32.0f) + EPS);
#pragma unroll
                for (int g = 0; g < 4; ++g) x[g] = x[g] * rstd * gain[g];
                if (qk == 1 && KIND == 0) {
                    float* o = C.out + OUT_DK + m.ob * 256 + hc * 32 + 4 * hi;
#pragma unroll
                    for (int g = 0; g < 4; ++g) *(f32x4*)(o + 8 * g) = x[g];
                }
                if (KIND == 1) {
#pragma unroll
                    for (int e = 0; e < 4; ++e) {
                        const float a1 = x[0][e], a2 = x[2][e]; x[0][e] = a1 * cr[e] - a2 * sr[e]; x[2][e] = a2 * cr[e] + a1 * sr[e];
                        const float b1 = x[1][e], b2 = x[3][e]; x[1][e] = b1 * cc[e] - b2 * scn[e]; x[3][e] = b2 * cc[e] + b1 * scn[e];
                    }
                }
                if (qk == 0) {
                    const float sc = 0.17677669529663687f * LOG2E;
                    f16* o = WSP(f16, WS_QA) + m.row * 256 + hc * 32 + 8 * hi;
#pragma unroll
                    for (int k = 0; k < 2; ++k) *(f16x8*)(o + 16 * k) = pair8(cvt4v(x[2 * k] * sc), cvt4v(x[2 * k + 1] * sc));
                } else {
                    f16* o = KA + ((((size_t)m.b * 4 + (hc >> 1)) * NT + m.ktile) * 8 + (hc & 1) * 4 + hi) * 512 + m.kin * 8;
#pragma unroll
                    for (int k = 0; k < 2; ++k) *(f16x8*)(o + 2 * k * 512) = pair8(cvt4v(x[2 * k]), cvt4v(x[2 * k + 1]));
                }
            }
        } else if (SUB == 1) {
            const float* ck = C.in[I_CDK] + (((size_t)m.b * 2 + l) * PAST + m.t) * 256;
            f32x4 raw[8][4];
#pragma unroll
            for (int hc = 0; hc < 8; ++hc)
#pragma unroll
                for (int g = 0; g < 4; ++g) raw[hc][g] = *(const f32x4*)(ck + hc * 32 + 4 * hi + 8 * g);
#pragma unroll
            for (int hc = 0; hc < 8; ++hc) {
                f16* o = KA + ((((size_t)m.b * 4 + (hc >> 1)) * NT + m.ktile) * 8 + (hc & 1) * 4 + hi) * 512 + m.kin * 8;
#pragma unroll
                for (int k = 0; k < 2; ++k) *(f16x8*)(o + 2 * k * 512) = pair8(cvt4v(raw[hc][2 * k]), cvt4v(raw[hc][2 * k + 1]));
            }
        }
    } else {
        if (KIND != 2) {
            f16x8 rawv[4][4];
#pragma unroll
            for (int hd = 0; hd < 4; ++hd)
#pragma unroll
                for (int j = 0; j < 4; ++j) rawv[hd][j] = *(const f16x8*)(prow + PC_VA + hd * 64 + 32 * hi + 8 * j);
#pragma unroll
            for (int hd = 0; hd < 4; ++hd) {
                f16* vt = VA + ((((size_t)m.b * 4 + hd) * NT + m.ktile) * 2 + hi) * 2048 + m.kin * 32;
#pragma unroll
                for (int j = 0; j < 4; ++j) {
                    const f16x8 v = rawv[hd][j];
                    if (KIND == 0) {
                        float* o = C.out + OUT_DV + m.ob * 256 + hd * 64 + 32 * hi + 8 * j;
                        *(f32x4*)o = (f32x4){(float)v[0], (float)v[1], (float)v[2], (float)v[3]}; *(f32x4*)(o + 4) = (f32x4){(float)v[4], (float)v[5], (float)v[6], (float)v[7]};
                    }
                    *(f16x8*)(vt + 8 * j) = v;
                }
            }
        } else {
            const float* cvp = C.in[I_CDV] + (((size_t)m.b * 2 + l) * PAST + m.t) * 256;
#pragma unroll
            for (int hd = 0; hd < 4; ++hd) {
                f16* vt = VA + ((((size_t)m.b * 4 + hd) * NT + m.ktile) * 2 + hi) * 2048 + m.kin * 32;
                f32x4 rawc[8];
#pragma unroll
                for (int j = 0; j < 8; ++j) rawc[j] = *(const f32x4*)(cvp + hd * 64 + 32 * hi + 4 * j);
#pragma unroll
                for (int j = 0; j < 8; ++j) *(f16x4*)(vt + 4 * j) = cvt4v(rawc[j]);
            }
        }
    }
}
template <int KIND>
__device__ __forceinline__ void mx_q(const Ctx& C, int l, int wt, int hd, LAS unsigned char* wl) {
    const int lane = lane_id_fresh(), tok = lane & 31, hi = lane >> 5;
    const MxTok m = mx_decode<KIND>(wt, tok, l);
    const f16* prow = WSP(f16, WS_ACT) + m.row * DINP;
    float cr[4], sr[4], cc[4], scn[4];
    mx_rope<KIND>(m.t, hi, cr, sr, cc, scn);
    f16x8 bq[12]; float ss = 0.f;
#pragma unroll
    for (int ks = 0; ks < 12; ++ks) { bq[ks] = *(const f16x8*)(prow + PC_CQ + 16 * ks + 8 * hi);
#pragma unroll
        for (int e = 0; e < 8; ++e) { const float f = (float)bq[ks][e]; ss += f * f; } }
    ss += __shfl_xor(ss, 32);
    const float rstd = 1.0f / sqrtf(ss * (1.0f / 192.0f) + EPS);
    const float* gq = C.in[I_QKN] + ((size_t)l * 2 + 0) * 96;
    f32x4 gqv[3][4];
#pragma unroll
    for (int t3 = 0; t3 < 3; ++t3)
#pragma unroll
        for (int g = 0; g < 4; ++g) gqv[t3][g] = *(const f32x4*)(gq + 32 * t3 + 8 * g + 4 * hi);
    ATT_WAITBAR(0);
    LAS unsigned char* wp = wl + hi * 512 + tok * 16;
    f32x16 acc[3];
#pragma unroll
    for (int t3 = 0; t3 < 3; ++t3) { acc[t3] = (f32x16){};
#pragma unroll
        for (int ks = 0; ks < 12; ++ks) acc[t3] = MFMA32(*(const LAS f16x8*)(wp + (t3 * 24 + 2 * ks) * 512), bq[ks], acc[t3]); }
    float s2 = 0.f;
#pragma unroll
    for (int t3 = 0; t3 < 3; ++t3)
#pragma unroll
        for (int r = 0; r < 16; ++r) s2 += acc[t3][r] * acc[t3][r];
    s2 += __shfl_xor(s2, 32);
    const float rs = rstd / sqrtf(s2 * (rstd * rstd) * (1.0f / 96.0f) + EPS);
#pragma unroll
    for (int t3 = 0; t3 < 3; ++t3)
#pragma unroll
        for (int g = 0; g < 4; ++g) { const f32x4 gg = gqv[t3][g];
#pragma unroll
            for (int e = 0; e < 4; ++e) acc[t3][4 * g + e] *= rs * gg[e]; }
    if (KIND == 1) {
#pragma unroll
        for (int e = 0; e < 4; ++e) {
            const float a1 = acc[2][e], a2 = acc[2][8 + e]; acc[2][e] = a1 * cr[e] - a2 * sr[e]; acc[2][8 + e] = a2 * cr[e] + a1 * sr[e];
            const float b1 = acc[2][4 + e], b2 = acc[2][12 + e]; acc[2][4 + e] = b1 * cc[e] - b2 * scn[e]; acc[2][12 + e] = b2 * cc[e] + b1 * scn[e];
        }
    }
    const float sc = 0.10206207261596575f * LOG2E;
    f16* o = WSP(f16, WS_QC) + m.row * 384 + hd * 96 + 8 * hi;
#pragma unroll
    for (int t3 = 0; t3 < 3; ++t3)
#pragma unroll
        for (int k = 0; k < 2; ++k) *(f16x8*)(o + 32 * t3 + 16 * k) = pair8(cvt4(acc[t3][8 * k] * sc, acc[t3][8 * k + 1] * sc, acc[t3][8 * k + 2] * sc, acc[t3][8 * k + 3] * sc),
                                                                                     cvt4(acc[t3][8 * k + 4] * sc, acc[t3][8 * k + 5] * sc, acc[t3][8 * k + 6] * sc, acc[t3][8 * k + 7] * sc));
}
template <int KIND>
__device__ __forceinline__ void mx_kv(const Ctx& C, int l, int wt, int hd, LAS unsigned char* wl) {
    const int lane = lane_id_fresh(), tok = lane & 31, hi = lane >> 5;
    constexpr int Tk = (KIND == 0) ? TP : TKS, NT = Tk / 64;
    const MxTok m = mx_decode<KIND>(wt, tok, l);
    const f16* prow = WSP(f16, WS_ACT) + m.row * DINP;
    f16* KC = (KIND == 0) ? WSP(f16, WS_KCP) : WSP(f16, WS_KCS);
    f16* VC = (KIND == 0) ? WSP(f16, WS_VCTP) : WSP(f16, WS_VCTS);
    float cr[4], sr[4], cc[4], scn[4];
    mx_rope<KIND>(m.t, hi, cr, sr, cc, scn);
    f16x8 bk[8]; f32x4 kr[4]; float rstd = 1.0f;
    if (KIND != 2) {
        float ss = 0.f;
#pragma unroll
        for (int ks = 0; ks < 8; ++ks) { bk[ks] = *(const f16x8*)(prow + PC_CKV + 16 * ks + 8 * hi);
#pragma unroll
            for (int e = 0; e < 8; ++e) { const float f = (float)bk[ks][e]; ss += f * f; } }
        ss += __shfl_xor(ss, 32);
        rstd = 1.0f / sqrtf(ss * (1.0f / 128.0f) + EPS);
        if (KIND == 0 && hd == 0) {
            f32x4 gv0[8], gv1[8];
#pragma unroll
            for (int ks = 0; ks < 8; ++ks) { gv0[ks] = *(const f32x4*)(C.in[I_CKVN] + (size_t)l * 128 + 16 * ks + 8 * hi); gv1[ks] = *(const f32x4*)(C.in[I_CKVN] + (size_t)l * 128 + 16 * ks + 8 * hi + 4); }
#pragma unroll
            for (int ks = 0; ks < 8; ++ks) {
                const f32x4 g0 = gv0[ks], g1 = gv1[ks];
                const f16x8 v = bk[ks];
                float* o = C.out + OUT_CKV + m.ob * 128 + 16 * ks + 8 * hi;
                *(f32x4*)o = (f32x4){(float)v[0] * rstd * g0[0], (float)v[1] * rstd * g0[1], (float)v[2] * rstd * g0[2], (float)v[3] * rstd * g0[3]};
                *(f32x4*)(o + 4) = (f32x4){(float)v[4] * rstd * g1[0], (float)v[5] * rstd * g1[1], (float)v[6] * rstd * g1[2], (float)v[7] * rstd * g1[3]};
            }
        }
#pragma unroll
        for (int g = 0; g < 4; ++g) kr[g] = tof32(*(const f16x4*)(prow + PC_KR + 8 * g + 4 * hi));
        if (KIND == 0 && hd == 0) { float* o = C.out + OUT_KR + m.ob * 32 + 4 * hi;
#pragma unroll
            for (int g = 0; g < 4; ++g) *(f32x4*)(o + 8 * g) = kr[g]; }
    } else {
        const float* cp = C.in[I_CCKV] + (((size_t)m.b * 2 + l) * PAST + m.t) * 128;
#pragma unroll
        for (int ks = 0; ks < 8; ++ks) bk[ks] = pack8(cvt4v(*(const f32x4*)(cp + 16 * ks + 8 * hi)), cvt4v(*(const f32x4*)(cp + 16 * ks + 8 * hi + 4)));
        const float* kp = C.in[I_CKR] + (((size_t)m.b * 2 + l) * PAST + m.t) * 32;
#pragma unroll
        for (int g = 0; g < 4; ++g) kr[g] = *(const f32x4*)(kp + 8 * g + 4 * hi);
    }
    float skr = 0.f;
#pragma unroll
    for (int g = 0; g < 4; ++g) skr += (kr[g].x * kr[g].x + kr[g].y * kr[g].y) + (kr[g].z * kr[g].z + kr[g].w * kr[g].w);
    const float* gk = C.in[I_QKN] + ((size_t)l * 2 + 1) * 96;
    f32x4 gkv[3][4];
#pragma unroll
    for (int t3 = 0; t3 < 3; ++t3)
#pragma unroll
        for (int g = 0; g < 4; ++g) gkv[t3][g] = *(const f32x4*)(gk + 32 * t3 + 8 * g + 4 * hi);
    ATT_WAITBAR(0);
    LAS unsigned char* wp = wl + hi * 512 + tok * 16;
    f32x16 acc[2];
#pragma unroll
    for (int t4 = 0; t4 < 2; ++t4) { acc[t4] = (f32x16){};
#pragma unroll
        for (int ks = 0; ks < 8; ++ks) acc[t4] = MFMA32(*(const LAS f16x8*)(wp + (t4 * 16 + 2 * ks) * 512), bk[ks], acc[t4]); }
    float s2 = 0.f;
#pragma unroll
    for (int t4 = 0; t4 < 2; ++t4)
#pragma unroll
        for (int r = 0; r < 16; ++r) s2 += acc[t4][r] * acc[t4][r];
    s2 = s2 * (rstd * rstd) + skr;
    s2 += __shfl_xor(s2, 32);
    const float rs = 1.0f / sqrtf(s2 * (1.0f / 96.0f) + EPS), rsn = rs * rstd;
    f16* ko = KC + ((((size_t)m.b * 4 + hd) * NT + m.ktile) * 12 + hi) * 512 + m.kin * 8;
#pragma unroll
    for (int t4 = 0; t4 < 2; ++t4)
#pragma unroll
        for (int k = 0; k < 2; ++k) { const f32x4 ga = gkv[t4][2 * k], gb = gkv[t4][2 * k + 1];
            *(f16x8*)(ko + (4 * t4 + 2 * k) * 512) = pair8(cvt4(acc[t4][8 * k] * rsn * ga[0], acc[t4][8 * k + 1] * rsn * ga[1], acc[t4][8 * k + 2] * rsn * ga[2], acc[t4][8 * k + 3] * rsn * ga[3]),
                                                             cvt4(acc[t4][8 * k + 4] * rsn * gb[0], acc[t4][8 * k + 5] * rsn * gb[1], acc[t4][8 * k + 6] * rsn * gb[2], acc[t4][8 * k + 7] * rsn * gb[3])); }
    f32x4 kn[4];
#pragma unroll
    for (int g = 0; g < 4; ++g) kn[g] = kr[g] * rs * gkv[2][g];
    if (KIND == 1) {
#pragma unroll
        for (int e = 0; e < 4; ++e) {
            const float a1 = kn[0][e], a2 = kn[2][e]; kn[0][e] = a1 * cr[e] - a2 * sr[e]; kn[2][e] = a2 * cr[e] + a1 * sr[e];
            const float b1 = kn[1][e], b2 = kn[3][e]; kn[1][e] = b1 * cc[e] - b2 * scn[e]; kn[3][e] = b2 * cc[e] + b1 * scn[e];
        }
    }
#pragma unroll
    for (int k = 0; k < 2; ++k) *(f16x8*)(ko + (8 + 2 * k) * 512) = pair8(cvt4v(kn[2 * k]), cvt4v(kn[2 * k + 1]));
    f16* vo = VC + ((((size_t)m.b * 4 + hd) * NT + m.ktile) * 2) * 2048 + m.kin * 32 + 8 * hi;
#pragma unroll
    for (int t4 = 2; t4 < 4; ++t4) {
        f32x16 av = (f32x16){};
#pragma unroll
        for (int ks = 0; ks < 8; ++ks) av = MFMA32(*(const LAS f16x8*)(wp + (t4 * 16 + 2 * ks) * 512), bk[ks], av);
#pragma unroll
        for (int k = 0; k < 2; ++k) *(f16x8*)(vo + (t4 - 2) * 2048 + 16 * k) = pair8(cvt4(av[8 * k] * rstd, av[8 * k + 1] * rstd, av[8 * k + 2] * rstd, av[8 * k + 3] * rstd),
                                                                                        cvt4(av[8 * k + 4] * rstd, av[8 * k + 5] * rstd, av[8 * k + 6] * rstd, av[8 * k + 7] * rstd));
    }
}

template <int DIR, bool PASS2>
__device__ __forceinline__ void lru_dir(const Ctx& C, int l, int ch, int n, const f16x8 (&bx)[2][4], int b, int T, int cidx, int seqch0, bool prompt, int row0, int lane) {
    const int l31 = lane & 31, hi = lane >> 5;
    const f16* wg = WSP(f16, WS_WG);
    const f16* PROJ = WSP(f16, WS_ACT);
    float* SUM = WSP(float, WS_SUM);
    f16* OC = WSP(f16, WS_OCAT);
    const int nch = T >> 6;
    float bg0[2], bg1[2], spl[2], hc[2], At[2], Bt[2];
#pragma unroll
    for (int t2 = 0; t2 < 2; ++t2) {
        const int chn = 64 * n + 32 * t2 + l31;
        bg0[t2] = C.in[I_BGATE][((size_t)(l * 2 + DIR) * 2 + 0) * 512 + chn]; bg1[t2] = C.in[I_BGATE][((size_t)(l * 2 + DIR) * 2 + 1) * 512 + chn];
        spl[t2] = -8.0f * LOG2E * log1pf(__expf(-C.in[I_LLAM][(size_t)(l * 2 + DIR) * 512 + chn]));
        At[t2] = 1.0f; Bt[t2] = 0.0f; hc[t2] = 0.0f;
    }
    if (PASS2) {
        const int cnt = (DIR == 0) ? cidx : (nch - 1 - cidx), m = (cnt + 1) >> 1;
        const int lo = hi ? m : 0, up = hi ? cnt : m;
        float A0 = 1.f, B0 = 0.f, A1 = 1.f, B1 = 0.f;
#pragma unroll 1
        for (int ib = lo; ib < up; ib += 8) {
            float a0[8], b0[8], a1[8], b1[8];
#pragma unroll
            for (int k = 0; k < 8; ++k) {
                const int i = (ib + k < up) ? ib + k : up - 1, j = (DIR == 0) ? i : (nch - 1 - i);
                const float* p = SUM + ((((size_t)(seqch0 + j)) * 8 + n) * 2 + DIR) * 128 + l31;
                a0[k] = p[0]; b0[k] = p[64]; a1[k] = p[32]; b1[k] = p[96];
            }
#pragma unroll
            for (int k = 0; k < 8; ++k) if (ib + k < up) { B0 = a0[k] * B0 + b0[k]; A0 *= a0[k]; B1 = a1[k] * B1 + b1[k]; A1 *= a1[k]; }
        }
        {
            const float pa0 = __shfl_xor(A0, 32), pb0 = __shfl_xor(B0, 32), pa1 = __shfl_xor(A1, 32), pb1 = __shfl_xor(B1, 32);
            const float fa0 = hi ? pa0 : A0, fb0 = hi ? pb0 : B0, sa0 = hi ? A0 : pa0, sb0 = hi ? B0 : pb0;
            const float fa1 = hi ? pa1 : A1, fb1 = hi ? pb1 : B1, sa1 = hi ? A1 : pa1, sb1 = hi ? B1 : pb1;
            float h00 = 0.f, h01 = 0.f;
            if (!prompt) { const float* st = C.in[I_ST] + (((size_t)b * 2 + l) * 2 + DIR) * 512 + 64 * n + l31; h00 = st[0]; h01 = st[32]; }
            hc[0] = sa0 * (fa0 * h00 + fb0) + sb0; hc[1] = sa1 * (fa1 * h01 + fb1) + sb1;
        }
    }
    const f16* idp = WSP(f16, WS_IDN);
    __builtin_amdgcn_sched_barrier(0);
#pragma unroll
    for (int t2 = 0; t2 < 2; ++t2) {
        f16x8 w0[4], w1[4], idn[4];
#pragma unroll
        for (int ks = 0; ks < 4; ++ks) {
            w0[ks] = *(const f16x8*)(wg + ((((size_t)(l * 2 + DIR) * 2 + 0) * 8 + n) * 64 + 32 * t2 + l31) * 64 + 16 * ks + 8 * hi);
            w1[ks] = *(const f16x8*)(wg + ((((size_t)(l * 2 + DIR) * 2 + 1) * 8 + n) * 64 + 32 * t2 + l31) * 64 + 16 * ks + 8 * hi);
            idn[ks] = *(const f16x8*)(idp + (32 * t2 + l31) * 64 + 16 * ks + 8 * hi);
        }
#pragma unroll
        for (int sci = 0; sci < 2; ++sci) {
            const int sc = DIR ? 1 - sci : sci;
            f32x16 g0 = (f32x16){}, g1 = (f32x16){}, X = (f32x16){};
#pragma unroll
            for (int ks = 0; ks < 4; ++ks) { g0 = MFMA32(bx[sc][ks], w0[ks], g0); g1 = MFMA32(bx[sc][ks], w1[ks], g1); X = MFMA32(bx[sc][ks], idn[ks], X); }
#pragma unroll
            for (int r = 0; r < 16; ++r) {
                const float rr = sigmoidf_(g0[r] + bg0[t2]), ii = sigmoidf_(g1[r] + bg1[t2]);
                const float a = fexp2(rr * spl[t2]);
                g0[r] = a; g1[r] = __builtin_amdgcn_sqrtf(fmaxf(1.0f - a * a, 0.f)) * (ii * X[r]);
            }
            float As[4], Bs[4], Ap[4], Bp[4];
#pragma unroll
            for (int g = 0; g < 4; ++g) {
                float pa = 1.f, pb = 0.f;
#pragma unroll
                for (int ee = 0; ee < 4; ++ee) { const int e = DIR ? 3 - ee : ee; pb = g0[4 * g + e] * pb + g1[4 * g + e]; pa *= g0[4 * g + e]; }
                As[g] = pa; Bs[g] = pb; Ap[g] = __shfl_xor(pa, 32); Bp[g] = __shfl_xor(pb, 32);
            }
            float h = hc[t2];
#pragma unroll
            for (int gi = 0; gi < 4; ++gi) {
                const int g = DIR ? 3 - gi : gi;
                const bool mine_first = DIR ? (hi == 1) : (hi == 0);
                const float fa = mine_first ? As[g] : Ap[g], fb = mine_first ? Bs[g] : Bp[g], sa = mine_first ? Ap[g] : As[g], sb = mine_first ? Bp[g] : Bs[g];
                const float mid = fa * h + fb;
                float hh = mine_first ? h : mid;
                if (PASS2) {
#pragma unroll
                    for (int ee = 0; ee < 4; ++ee) { const int e = DIR ? 3 - ee : ee; hh = g0[4 * g + e] * hh + g1[4 * g + e]; g1[4 * g + e] = hh; }
                }
                h = sa * mid + sb;
                if (!PASS2) { Bt[t2] = sa * (fa * Bt[t2] + fb) + sb; At[t2] *= fa * sa; }
            }
            hc[t2] = h;
            if (PASS2) {
                LAS f16* op = (LAS f16*)(C.lds + C.wave * 16384) + (32 * sc + 4 * hi) * 64 + 32 * t2 + l31;
                if (DIR == 0) {
#pragma unroll
                    for (int r = 0; r < 16; ++r) op[((r & 3) + 8 * (r >> 2)) * 64] = (f16)g1[r];
                } else {
                    f32x16 G = (f32x16){};
#pragma unroll
                    for (int ks = 0; ks < 4; ++ks) {
                        const f16x8 gbf = *(const f16x8*)(PROJ + (size_t)(row0 + 32 * sc + l31) * DINP + PC_GB + 64 * n + 16 * ks + 8 * hi);
                        G = MFMA32(gbf, idn[ks], G);
                    }
                    float hfv[16];
#pragma unroll
                    for (int r = 0; r < 16; ++r) hfv[r] = (float)op[((r & 3) + 8 * (r >> 2)) * 64];
#pragma unroll
                    for (int r = 0; r < 16; ++r) {
                        LAS f16* q = op + ((r & 3) + 8 * (r >> 2)) * 64;
                        const float hf = hfv[r];
                        const float x = G[r], u = 0.7978845608028654f * (x + 0.044715f * x * x * x);
                        const float th = 1.0f - 2.0f * frcp(1.0f + fexp2(2.0f * u * LOG2E));
                        *q = (f16)((hf + g1[r]) * (0.5f * x * (1.0f + th)));
                    }
                }
            }
            FENCE(); __builtin_amdgcn_sched_barrier(0);
        }
    }
    if (!PASS2) {
        if (hi == 0) { float* sa = SUM + ((((size_t)ch) * 8 + n) * 2 + DIR) * 128 + l31; sa[0] = At[0]; sa[64] = Bt[0]; sa[32] = At[1]; sa[96] = Bt[1]; }
    } else if (prompt) {
        const bool fin = (DIR == 0) ? (cidx == nch - 1) : (cidx == 0);
        if (fin && hi == 0) { float* o = C.out + OUT_ST + (((size_t)b * 2 + l) * 2 + DIR) * 512 + 64 * n + l31; o[0] = hc[0]; o[32] = hc[1]; }
    }
}
template <bool PASS2>
__device__ __forceinline__ void lru_item(const Ctx& C, int l, int ch, int n) {
    const int lane = lane_id_fresh(), l31 = lane & 31, hi = lane >> 5;
    const f16* PROJ = WSP(f16, WS_ACT);
    const int row0 = ch * 64;
    const bool prompt = row0 < MP;
    int b, t0, T, seqrow0;
    if (prompt) { b = row0 >> 8; t0 = row0 & 255; T = TP; seqrow0 = b * TP; } else { const int rs = row0 - MP; b = rs >> 11; t0 = rs & 2047; T = TS; seqrow0 = MP + b * TS; }
    const int cidx = t0 >> 6, seqch0 = seqrow0 >> 6;
    f16x8 bx[2][4];
    f16x8* xcbuf = WSP(f16x8, WS_XC) + ((size_t)(ch * 8 + n) * 8) * 64 + lane;
    if (PASS2) {
#pragma unroll
        for (int sc = 0; sc < 2; ++sc)
#pragma unroll
            for (int ks = 0; ks < 4; ++ks) bx[sc][ks] = xcbuf[(sc * 4 + ks) * 64];
    } else
#pragma unroll
    for (int ks = 0; ks < 4; ++ks) {
        int chn = 64 * n + 16 * ks + 8 * hi; asm volatile("" : "+v"(chn));
        f32x4 w0[4], w1[4];
#pragma unroll
        for (int j = 0; j < 4; ++j) { w0[j] = *(const f32x4*)(C.in[I_CONVW] + ((size_t)l * 4 + j) * 512 + chn); w1[j] = *(const f32x4*)(C.in[I_CONVW] + ((size_t)l * 4 + j) * 512 + chn + 4); }
        const f32x4 c0 = *(const f32x4*)(C.in[I_CONVB] + (size_t)l * 512 + chn), c1 = *(const f32x4*)(C.in[I_CONVB] + (size_t)l * 512 + chn + 4);
#pragma unroll
        for (int sc = 0; sc < 2; ++sc) {
            const int t = t0 + 32 * sc + l31;
            f16x8 v[4]; float wm[4];
#pragma unroll
            for (int j = 0; j < 4; ++j) { const int tt = t + j - 2; const bool ok = (tt >= 0 && tt < T); wm[j] = ok ? 1.0f : 0.0f;
                v[j] = *(const f16x8*)(PROJ + (size_t)(seqrow0 + (ok ? tt : t)) * DINP + PC_XB + chn); }
            f32x4 a0 = c0, a1 = c1;
#pragma unroll
            for (int j = 0; j < 4; ++j) { a0 += (w0[j] * wm[j]) * (f32x4){(float)v[j][0], (float)v[j][1], (float)v[j][2], (float)v[j][3]}; a1 += (w1[j] * wm[j]) * (f32x4){(float)v[j][4], (float)v[j][5], (float)v[j][6], (float)v[j][7]}; }
            bx[sc][ks] = pack8(cvt4v(a0), cvt4v(a1));
            xcbuf[(sc * 4 + ks) * 64] = bx[sc][ks];
        }
        FENCE(); __builtin_amdgcn_sched_barrier(0);
    }
    __builtin_amdgcn_sched_barrier(0);
    lru_dir<0, PASS2>(C, l, ch, n, bx, b, T, cidx, seqch0, prompt, row0, lane);
    FENCE(); __builtin_amdgcn_sched_barrier(0);
    lru_dir<1, PASS2>(C, l, ch, n, bx, b, T, cidx, seqch0, prompt, row0, lane);
    if (PASS2) {
        FENCE(); asm volatile("s_waitcnt lgkmcnt(0)" ::: "memory");
        const LAS unsigned char* tl = C.lds + C.wave * 16384;
        f16* oc = WSP(f16, WS_OCAT) + (size_t)row0 * DM + 256 + 64 * n;
        f16x8 ov[8];
#pragma unroll
        for (int i = 0; i < 8; ++i) ov[i] = *(const LAS f16x8*)(tl + (8 * i + (lane >> 3)) * 128 + (lane & 7) * 16);
#pragma unroll
        for (int i = 0; i < 8; ++i) *(f16x8*)(oc + (size_t)(8 * i + (lane >> 3)) * DM + (lane & 7) * 8) = ov[i];
        asm volatile("s_waitcnt lgkmcnt(0)" ::: "memory"); FENCE();
    }
}

constexpr int ATT_SLOT = 20480, ATT_VOFF = 12288;
constexpr float ATT_THR = 8.0f;
typedef short v4i16_t __attribute__((ext_vector_type(4)));
__device__ __forceinline__ f16x4 lds_tr(LAS unsigned char* p) { return __builtin_bit_cast(f16x4, __builtin_amdgcn_ds_read_tr16_b64_v4i16((LAS v4i16_t*)p)); }
template <int TYPE>
__device__ __forceinline__ void attn_unit(const Ctx& C, int l, int kind, int b, int hd, int qblk) {
    const int lane = lane_id_fresh(), tok = lane & 31, hi = lane >> 5, wid = C.wave;
    constexpr int NC = TYPE ? 12 : 8, KTILE = NC * 512;
    const int Tk = kind ? TKS : TP, NT = Tk >> 6;
    const size_t row = (kind ? (size_t)MP + (size_t)b * TS : (size_t)b * TP) + 256 * qblk + 32 * wid + tok;
    const f16* Kimg = (TYPE ? (kind ? WSP(f16, WS_KCS) : WSP(f16, WS_KCP)) : (kind ? WSP(f16, WS_KAS) : WSP(f16, WS_KAP))) + ((size_t)b * 4 + hd) * NT * KTILE + lane * 8;
    const f16* Vimg = (TYPE ? (kind ? WSP(f16, WS_VCTS) : WSP(f16, WS_VCTP)) : (kind ? WSP(f16, WS_VATS) : WSP(f16, WS_VATP))) + ((size_t)b * 4 + hd) * NT * 4096 + wid * 512 + lane * 8;
    LAS unsigned char* lds = C.lds;
    const bool two = (TYPE == 1) && (wid < 4);
#define ATT_DMA(t, sl) do { const f16* kt_ = Kimg + (size_t)(t) * KTILE; LAS unsigned char* ls_ = lds + (sl) * ATT_SLOT; \
        ATT_GLDS(kt_ + wid * 512, ls_ + wid * 1024); if (two) ATT_GLDS(kt_ + (8 + wid) * 512, ls_ + (8 + wid) * 1024); \
        ATT_GLDS(Vimg + (size_t)(t) * 4096, ls_ + ATT_VOFF + wid * 1024); } while (0)
    f16x8 bq[TYPE ? 6 : 4];
    if (TYPE) {
#pragma unroll
        for (int ks = 0; ks < 6; ++ks) bq[ks] = *(const f16x8*)(WSP(f16, WS_QC) + row * 384 + hd * 96 + 16 * ks + 8 * hi);
    } else {
#pragma unroll
        for (int i = 0; i < 4; ++i) bq[i] = *(const f16x8*)(WSP(f16, WS_QA) + row * 256 + hd * 64 + 16 * i + 8 * hi);
    }
    float lam = 0.f, lam_init = 0.f;
    if (TYPE == 0) {
        const float* lp = C.in[I_DLAM] + (size_t)l * 128;
        float s1 = (lane < 32) ? lp[lane] * lp[32 + lane] : 0.f, s2 = (lane < 32) ? lp[64 + lane] * lp[96 + lane] : 0.f;
        s1 = wave_sum(s1); s2 = wave_sum(s2);
        lam_init = 0.8f - 0.6f * expf(-0.3f * (float)l);
        lam = expf(s1) - expf(s2) + lam_init;
    }
#pragma unroll
    for (int i = 0; i < (TYPE ? 6 : 4); ++i) asm volatile("" : "+v"(bq[i]));
    asm volatile("" : "+v"(lam), "+v"(lam_init));
    ATT_DMA(0, 0); ATT_DMA(1, 1);
    if (two) { ATT_WAITBAR(3); } else { ATT_WAITBAR(2); }
    float m0 = 0.f, m1 = 0.f;
    f32x16 O0[2], O1[2], L0 = (f32x16){}, L1 = (f32x16){}; O0[0] = (f32x16){}; O0[1] = (f32x16){}; O1[0] = (f32x16){}; O1[1] = (f32x16){};
    const f16x8 ones = {(f16)1.0f, (f16)1.0f, (f16)1.0f, (f16)1.0f, (f16)1.0f, (f16)1.0f, (f16)1.0f, (f16)1.0f};
    int s_cur = 0, s_nx2 = 2;
    LAS unsigned char* vb0 = lds + ATT_VOFF + (4 * hi + ((lane & 15) >> 2)) * 64 + ((lane >> 4) & 1) * 32 + (lane & 3) * 8;
    LAS unsigned char* kb0 = lds + hi * 1024 + tok * 16;
#pragma unroll 1
    for (int t = 0; t < NT; ++t) {
        if (t + 2 < NT) ATT_DMA(t + 2, s_nx2);
        LAS unsigned char* kb = kb0 + s_cur * ATT_SLOT; LAS unsigned char* vb = vb0 + s_cur * ATT_SLOT;
        f16x8 pf[TYPE ? 1 : 2][2][2];
#pragma unroll
        for (int c = 0; c < (TYPE ? 1 : 2); ++c) {
            f32x16 S[2];
            {
                f16x8 kf[2][TYPE ? 6 : 2];
#pragma unroll
                for (int sub = 0; sub < 2; ++sub)
#pragma unroll
                    for (int ks = 0; ks < (TYPE ? 6 : 2); ++ks) kf[sub][ks] = *(const LAS f16x8*)(kb + c * 4096 + ks * 2048 + sub * 512);
                __builtin_amdgcn_sched_barrier(0);
#pragma unroll
                for (int sub = 0; sub < 2; ++sub) { S[sub] = (f32x16){};
#pragma unroll
                    for (int ks = 0; ks < (TYPE ? 6 : 2); ++ks) S[sub] = MFMA32(kf[sub][ks], bq[c * 2 + ks], S[sub]); }
                __builtin_amdgcn_sched_barrier(0);
            }
            float ma = fmaxf(fmaxf(S[0][0], S[0][1]), S[1][0]), mb = fmaxf(fmaxf(S[0][2], S[0][3]), S[1][1]);
            ma = fmaxf(fmaxf(ma, S[1][2]), S[1][3]);
#pragma unroll
            for (int r = 4; r < 16; r += 4) { ma = fmaxf(fmaxf(ma, S[0][r]), S[0][r + 1]); mb = fmaxf(fmaxf(mb, S[0][r + 2]), S[0][r + 3]); ma = fmaxf(fmaxf(ma, S[1][r]), S[1][r + 1]); mb = fmaxf(fmaxf(mb, S[1][r + 2]), S[1][r + 3]); }
            float rm = fmaxf(ma, mb); rm = fmaxf(rm, __shfl_xor(rm, 32));
            float mref = c ? m1 : m0;
            if (t == 0) mref = rm;
            else if (__any(rm - mref > ATT_THR)) {
                const float dl = fmaxf(rm - mref, 0.f), f = fexp2(-dl); mref += dl;
                if (c == 0) {
#pragma unroll
                    for (int r = 0; r < 16; ++r) { O0[0][r] *= f; O0[1][r] *= f; L0[r] *= f; }
                } else {
#pragma unroll
                    for (int r = 0; r < 16; ++r) { O1[0][r] *= f; O1[1][r] *= f; L1[r] *= f; }
                }
            }
            if (c == 0) m0 = mref; else m1 = mref;
#pragma unroll
            for (int sub = 0; sub < 2; ++sub)
#pragma unroll
                for (int r = 0; r < 16; ++r) S[sub][r] = fexp2(S[sub][r] - mref);
#pragma unroll
            for (int sub = 0; sub < 2; ++sub)
#pragma unroll
                for (int sp = 0; sp < 2; ++sp) pf[c][sub][sp] = pack8(cvt4(S[sub][8 * sp], S[sub][8 * sp + 1], S[sub][8 * sp + 2], S[sub][8 * sp + 3]), cvt4(S[sub][8 * sp + 4], S[sub][8 * sp + 5], S[sub][8 * sp + 6], S[sub][8 * sp + 7]));
        }
#pragma unroll
        for (int vt = 0; vt < 2; ++vt) {
            f16x4 vlo[4], vhi[4];
#pragma unroll
            for (int k4 = 0; k4 < 4; ++k4) { vlo[k4] = lds_tr(vb + vt * 4096 + k4 * 1024); vhi[k4] = lds_tr(vb + vt * 4096 + k4 * 1024 + 512); }
            __builtin_amdgcn_sched_barrier(0);
#pragma unroll
            for (int k4 = 0; k4 < 4; ++k4) {
                const f16x8 vf = pack8(vlo[k4], vhi[k4]);
                O0[vt] = MFMA32(vf, pf[0][k4 >> 1][k4 & 1], O0[vt]);
                if (TYPE == 0) O1[vt] = MFMA32(vf, pf[TYPE ? 0 : 1][k4 >> 1][k4 & 1], O1[vt]);
            }
            __builtin_amdgcn_sched_barrier(0);
        }
#pragma unroll
        for (int k4 = 0; k4 < 4; ++k4) { L0 = MFMA32(ones, pf[0][k4 >> 1][k4 & 1], L0); if (TYPE == 0) L1 = MFMA32(ones, pf[TYPE ? 0 : 1][k4 >> 1][k4 & 1], L1); }
        if (t + 1 < NT) {
            if (t + 2 < NT) { if (two) { ATT_WAITBAR(3); } else { ATT_WAITBAR(2); } } else { ATT_WAITBAR(0); }
        }
        s_nx2 = s_cur; s_cur = (s_cur == 2) ? 0 : s_cur + 1;
    }
#undef ATT_DMA
    f16* o = WSP(f16, WS_OCAT) + row * DM + (TYPE ? 768 : 0) + hd * 64 + 8 * hi;
    if (TYPE) {
        const float inv = 1.0f / L0[0];
#pragma unroll
        for (int vt = 0; vt < 2; ++vt)
#pragma unroll
            for (int k = 0; k < 2; ++k) *(f16x8*)(o + 32 * vt + 16 * k) = pair8(cvt4(O0[vt][8 * k] * inv, O0[vt][8 * k + 1] * inv, O0[vt][8 * k + 2] * inv, O0[vt][8 * k + 3] * inv),
                                                                                   cvt4(O0[vt][8 * k + 4] * inv, O0[vt][8 * k + 5] * inv, O0[vt][8 * k + 6] * inv, O0[vt][8 * k + 7] * inv));
    } else {
        const float i0 = 1.0f / L0[0], i1 = lam / L1[0];
        float ss = 0.f;
#pragma unroll
        for (int vt = 0; vt < 2; ++vt)
#pragma unroll
            for (int r = 0; r < 16; ++r) { const float v = O0[vt][r] * i0 - O1[vt][r] * i1; O0[vt][r] = v; ss += v * v; }
        ss += __shfl_xor(ss, 32);
        const float rs = (1.0f / sqrtf(ss * (1.0f / 64.0f) + EPS)) * (1.0f - lam_init);
        const float* sg = C.in[I_DSUB] + (size_t)l * 64 + 4 * hi;
        f32x4 sgv[2][4];
#pragma unroll
        for (int vt = 0; vt < 2; ++vt)
#pragma unroll
            for (int g = 0; g < 4; ++g) sgv[vt][g] = *(const f32x4*)(sg + 32 * vt + 8 * g);
#pragma unroll
        for (int vt = 0; vt < 2; ++vt)
#pragma unroll
            for (int k = 0; k < 2; ++k) { const f32x4 ga = sgv[vt][2 * k], gb = sgv[vt][2 * k + 1];
                *(f16x8*)(o + 32 * vt + 16 * k) = pair8(cvt4(O0[vt][8 * k] * rs * ga[0], O0[vt][8 * k + 1] * rs * ga[1], O0[vt][8 * k + 2] * rs * ga[2], O0[vt][8 * k + 3] * rs * ga[3]),
                                                         cvt4(O0[vt][8 * k + 4] * rs * gb[0], O0[vt][8 * k + 5] * rs * gb[1], O0[vt][8 * k + 6] * rs * gb[2], O0[vt][8 * k + 7] * rs * gb[3])); }
    }
    ATT_LBAR();
}

template <int mode>
__device__ __forceinline__ void phase_mx(const Ctx& C0, int l, unsigned* ctr) {
    const Ctx C = ctx_fresh(C0);
#pragma unroll 1
    for (int u = C.bid; u < 544; u += C.G) {
        ATT_LBAR();
        if (mode == 1 || mode == 4) continue;
#ifndef NO_MXT
        const int lane = lane_id_fresh();
        if (u < 288) {
            const int g = u >> 2, hd = u & 3;
            const f16* wsrc = ((g < 64) ? WSP(f16, WS_WUKV) : WSP(f16, WS_WUKV0)) + ((size_t)(l * 4 + hd) * 32) * 512 + lane * 8;
#pragma unroll
            for (int i = 0; i < 4; ++i) ATT_GLDS(wsrc + (C.wave + 8 * i) * 512, C.lds + (C.wave + 8 * i) * 1024);
            if (g < 32) mx_kv<0>(C, l, g * 8 + C.wave, hd, C.lds); else if (g < 64) mx_kv<1>(C, l, g * 8 + C.wave, hd, C.lds); else mx_kv<2>(C, l, 512 + (g - 64) * 8 + C.wave, hd, C.lds);
        } else {
            const int v = u - 288, g = v >> 2, hd = v & 3;
            const f16* wsrc = WSP(f16, WS_WUQ) + ((size_t)(l * 4 + hd) * 36) * 512 + lane * 8;
#pragma unroll
            for (int i = 0; i < 5; ++i) if (C.wave + 8 * i < 36) ATT_GLDS(wsrc + (C.wave + 8 * i) * 512, C.lds + (C.wave + 8 * i) * 1024);
            if (g < 32) mx_q<0>(C, l, g * 8 + C.wave, hd, C.lds); else mx_q<1>(C, l, g * 8 + C.wave, hd, C.lds);
        }
#endif
    }
    constexpr int NA = 512 + 576 + 576;
#ifndef NO_LRU1
    if (mode != 2 && mode != 3 && mode != 4)
#pragma unroll 1
        for (int i = C.gw; i < 2048; i += C.ngw) lru_item<false>(C, l, i >> 3, i & 7);
#endif
#ifndef NO_MXT
    if (mode != 1 && mode != 3)
#pragma unroll 1
        for (int it = C.ngw - 1 - C.gw; it < NA; it += C.ngw) {
            if (it < 512) { if (it < 256) mx_a<0, 0>(C, l, it); else mx_a<1, 0>(C, l, it); }
            else if (it < 1088) { const int w = it - 512; if (w < 256) mx_a<0, 1>(C, l, w); else if (w < 512) mx_a<1, 1>(C, l, w); else mx_a<2, 1>(C, l, w); }
            else { const int w = it - 1088; if (w < 256) mx_a<0, 2>(C, l, w); else if (w < 512) mx_a<1, 2>(C, l, w); else mx_a<2, 2>(C, l, w); }
        }
#endif
}

template <int mode>
__device__ __forceinline__ void phase_att(const Ctx& C0, int l, unsigned* ctr) {
    const Ctx C = ctx_fresh(C0);
    const int half = C.G >> 1;
    if (mode != 1) {
#pragma unroll 1
        for (int u = C.bid; u < 128; u += half) { if (C.bid >= half) break;
#ifndef NO_ATTA
            if (mode == 0 || mode == 2 || mode == 5) { const int pr = (u & 7) * 2 + ((u >> 3) >> 3), qb = (u >> 3) & 7;
                attn_unit<0>(C, l, 1, pr >> 2, pr & 3, qb); }
#endif
        }
        if (C.bid >= half) {
#pragma unroll 1
            for (int u = C.bid - half; u < 128; u += half) {
#ifndef NO_ATTC
                if (mode == 0 || mode == 2 || mode == 6) { const int pr = (u & 7) * 2 + ((u >> 3) >> 3), qb = (u >> 3) & 7;
                    attn_unit<1>(C, l, 1, pr >> 2, pr & 3, qb); }
#endif
            }
#pragma unroll 1
            for (int u = C.bid - half; u < 128; u += half) {
#ifndef NO_ATTA
                if (mode == 0 || mode == 2 || mode == 7) attn_unit<0>(C, l, 0, u >> 2, u & 3, 0);
#endif
#ifndef NO_ATTC
                if (mode == 0 || mode == 2 || mode == 7) attn_unit<1>(C, l, 0, u >> 2, u & 3, 0);
#endif
            }
        }
    }
#ifndef NO_LRU2
    if (mode == 0 || mode == 1) {
#pragma unroll 1
        for (int it = C.gw; it < 2048; it += C.ngw) lru_item<true>(C, l, it >> 3, it & 7);
    }
#endif
}

__global__ void __launch_bounds__(512, 2) mk_fwd(Args args) {
    extern __shared__ __attribute__((aligned(16))) unsigned char lds_raw[];
    Ctx C;
    C.in = args.in; C.out = args.out; C.ws = args.ws;
    C.lds = (LAS unsigned char*)lds_raw;
    C.tid = threadIdx.x; C.lane = C.tid & 63; C.wave = __builtin_amdgcn_readfirstlane(C.tid >> 6);
    C.gw = 0; C.ngw = 0; C.bid = 0; C.G = 0;
    volatile LAS unsigned* MISC = (volatile LAS unsigned*)(C.lds + MISC_OFF);
    for (int u = C.tid; u < (LDS_BYTES - LDSCTL_OFF) / 4; u += 512) ((LAS unsigned*)(C.lds + LDSCTL_OFF))[u] = 0u;
    __syncthreads();
    unsigned* ctl = (unsigned*)(args.ws + WS_CTL);
    XcdBarrier bar = xcd_barrier_post(ctl + CW_BAR, MISC + 8);
    const int lo = args.ph_lo, hi = args.ph_hi;
#define IN(k) (lo <= (k) && (k) < hi)
#define SEAM(k) do { if (IN(k) && IN((k) + 1)) xcd_barrier(bar); } while (0)

    int rep = 0;
#pragma unroll 1
    for (int p = lo; p < hi; ++p) {
        const int l = (p >= 10) ? 1 : 0, q = (p < 2) ? -1 - p : (p - 2 - 8 * l);
        int bid = blockIdx.x, G = gridDim.x; asm volatile("" : "+s"(bid), "+s"(G));
        const float* modl = WSP(float, WS_MOD) + (size_t)l * 5 * NMODV;
        if (q == -1) {
#ifndef NO_PREP
            phase_prep(C);
#endif
        } else if (q == -2) phase_norm<true>(C, 0, 0);
        else if (q == 0 || q == 6) {
            const int s = (q == 6);
            pg8::Gemm g{WSP(f16, WS_H), WSP(f16, WS_WFI) + (size_t)(l * 2 + s) * NFF2 * 1024, M, NFF2, 1024}; pg8::StaticOrder S; S.init(M, NFF2, G, bid);
            pg8::EpiSwiglu E{WSP(f16, WS_ACT)};
            pg8::gemm_phase<pg8::EpiSwiglu, pg8::StaticOrder, true, true>(C.lds, g, S, E, C.wave);
        } else if (q == 1 || q == 7 || q == 5) {
            const int s = (q == 7);
            const f16* A = (q == 5) ? WSP(f16, WS_OCAT) : WSP(f16, WS_ACT);
            const f16* B = (q == 5) ? WSP(f16, WS_WOUT) + (size_t)l * 1024 * 1024 : WSP(f16, WS_WFO) + (size_t)(l * 2 + s) * 1024 * DFF;
            pg8::Gemm g{A, B, M, 1024, (q == 5) ? 1024 : DFF}; pg8::StaticOrder S; S.init(M, 1024, G, bid);
            const int nl = (q == 7) ? l + 1 : l, nsub = (q == 1) ? 1 : ((q == 5) ? 2 : 0), donorm = (nl < DEPTH) ? 1 : 0, nlc = donorm ? nl : l;
            pg8::EpiResidNorm E{C.out, WSP(f16, WS_XH), modl, (q == 5) ? 5 : (s ? 8 : 2), (rep > 0) ? 0.0f : ((q == 5) ? 1.0f : 0.5f),
                                donorm, WSP(f16, WS_H), C.in[I_NG] + ((size_t)nlc * 3 + nsub) * DM, WSP(float, WS_MOD) + (size_t)nlc * 5 * NMODV + (3 * nsub) * DM,
                                WSP(float, WS_XBUF), ctl + CW_PAN + (p + 18 * rep) * 4096};
            pg8::gemm_phase<pg8::EpiResidNorm, pg8::StaticOrder, false, true>(C.lds, g, S, E, C.wave);
        } else if (q == 2) {
            pg8::Gemm g{WSP(f16, WS_H), WSP(f16, WS_WIN) + (size_t)l * DINP * 1024, M, DINP, 1024}; pg8::StaticOrder S; S.init(M, DINP, G, bid);
            pg8::EpiStore E{WSP(f16, WS_ACT), DINP};
            pg8::gemm_phase<pg8::EpiStore, pg8::StaticOrder, true, true>(C.lds, g, S, E, C.wave);
        } else if (q == 3) { if (REP_MODE != 0 && rep) phase_mx<REP_MODE>(C, l, ctl + CW_Q + 64 * (p + 32 * rep)); else phase_mx<0>(C, l, ctl + CW_Q + 64 * (p + 32 * rep)); }
        else if (q == 4) { if (REP_MODE != 0 && rep) phase_att<REP_MODE>(C, l, ctl + CW_Q + 64 * (p + 32 * rep)); else phase_att<0>(C, l, ctl + CW_Q + 64 * (p + 32 * rep)); }
        if (REP_Q == 99 && p == 1) { for (int k = 0; k < 10; ++k) xcd_barrier(bar, C.wave); }
        if (q == REP_Q && rep < REP_N) { ++rep; --p; xcd_barrier(bar, C.wave); continue; }
        rep = 0;
        if (p + 1 < hi) xcd_barrier(bar, C.wave);
    }
#undef IN
#undef SEAM
}

extern "C" void kernel_launch(void* const* d_in, const int* in_sizes, int n_in, void* d_out, int out_size, void* d_ws, size_t ws_size, hipStream_t stream) {
    static int grid = 0;
    if (grid == 0) {
        if (n_in != N_IN || ws_size < WS_END || out_size != 27852800) { fprintf(stderr, "kernel_launch: unexpected shapes: n_in %d ws %zu out %d\n", n_in, ws_size, out_size); grid = -1; return; }
        int dev = 0, cus = 0, per_cu = 0;
        if (hipGetDevice(&dev) != hipSuccess || hipDeviceGetAttribute(&cus, hipDeviceAttributeMultiprocessorCount, dev) != hipSuccess) { grid = -1; return; }
        if (hipFuncSetAttribute((const void*)mk_fwd, hipFuncAttributeMaxDynamicSharedMemorySize, LDS_BYTES) != hipSuccess) { fprintf(stderr, "kernel_launch: hipFuncSetAttribute failed\n"); grid = -1; return; }
        if (hipOccupancyMaxActiveBlocksPerMultiprocessor(&per_cu, (const void*)mk_fwd, 512, LDS_BYTES) != hipSuccess || per_cu < 1) { fprintf(stderr, "kernel_launch: occupancy query says %d\n", per_cu); per_cu = 1; }
        (void)hipGetLastError();
        grid = cus;
    }
    if (grid < 0) return;
    if (hipMemsetAsync((char*)d_ws + WS_CTL, 0, CTL_ZERO_BYTES, stream) != hipSuccess) return;
    Args a{};
    for (int i = 0; i < N_IN; ++i) a.in[i] = (const float*)d_in[i];
    a.out = (float*)d_out; a.ws = (unsigned char*)d_ws;
#if MK_MULTI
    for (int p = 0; p < MK_PH_HI; ++p) { a.ph_lo = p; a.ph_hi = p + 1; hipLaunchKernelGGL(mk_fwd, dim3(grid), dim3(512), LDS_BYTES, stream, a); }
#else
    a.ph_lo = 0; a.ph_hi = MK_PH_HI;
    void* kargs[] = {&a};
    hipError_t e = hipLaunchCooperativeKernel((const void*)mk_fwd, dim3(grid), dim3(512), kargs, LDS_BYTES, stream);
    if (e != hipSuccess) { (void)hipGetLastError(); fprintf(stderr, "kernel_launch: cooperative launch failed (%s), plain launch instead\n", hipGetErrorString(e));
        hipLaunchKernelGGL(mk_fwd, dim3(grid), dim3(512), LDS_BYTES, stream, a); }
#endif
}
```

```cpp
#include <hip/hip_runtime.h>
#include <cstdio>
#include <cstdint>

#define GAS __attribute__((address_space(1)))
#define LAS __attribute__((address_space(3)))
typedef _Float16 f16;
typedef _Float16 f16x2 __attribute__((ext_vector_type(2)));
typedef _Float16 f16x4 __attribute__((ext_vector_type(4)));
typedef _Float16 f16x8 __attribute__((ext_vector_type(8)));
typedef float f32x2 __attribute__((ext_vector_type(2)));
typedef float f32x4 __attribute__((ext_vector_type(4)));
typedef float f32x16 __attribute__((ext_vector_type(16)));
typedef unsigned u32x2 __attribute__((ext_vector_type(2)));
typedef unsigned u32x4 __attribute__((ext_vector_type(4)));
typedef GAS unsigned gu32;

#ifndef MK_PH_HI
#define MK_PH_HI 18
#endif
#ifndef REP_Q
#ifndef CHAIN_OFF
#define CHAIN_OFF 0
#endif
#ifndef CHAIN_BARS
#define CHAIN_BARS 0
#endif
#define REP_Q -9
#endif
#ifndef REP_N
#define REP_N 1
#endif
#ifndef REP_MODE
#define REP_MODE 0
#endif
#ifndef MK_MULTI
#define MK_MULTI 0
#endif

constexpr int DM = 1024, NBP = 32, TP = 256, NBS = 4, TS = 2048, PAST = 512, DEPTH = 2;
constexpr int MP = NBP * TP, MS = NBS * TS, M = MP + MS;
constexpr int DFF = 2816, NFF2 = 5632, DIN = 2144, DINP = 2304, NMODV = 9216;
constexpr int TKS = PAST + TS;
constexpr float EPS = 1e-6f;
constexpr float LOG2E = 1.4426950408889634f;
constexpr int PC_QA = 0, PC_KA = 256, PC_VA = 512, PC_XB = 768, PC_GB = 1280, PC_CQ = 1792, PC_CKV = 1984, PC_KR = 2112;
constexpr size_t OUT_YP = 0, OUT_YS = 8388608, OUT_DK = 16777216, OUT_DV = 20971520, OUT_CKV = 25165824, OUT_KR = 27262976, OUT_ST = 27787264;
enum { I_XP = 0, I_XS, I_CDK, I_CDV, I_CCKV, I_CKR, I_ST, I_C, I_CCTX, I_NG, I_WADA, I_BADA, I_WFI, I_WFO, I_WIN, I_WOUT, I_DQKN, I_DLAM, I_DSUB,
       I_CONVW, I_CONVB, I_WGATE, I_BGATE, I_LLAM, I_CQN, I_CKVN, I_WUQ, I_WUKV, I_QKN, N_IN };

constexpr size_t MiB = 1u << 20;
constexpr size_t WS_CTL = 0, CTL_ZERO_BYTES = 1 * MiB;
constexpr size_t WS_MOD = 1 * MiB;
constexpr size_t WS_WUQ = 2 * MiB;
constexpr size_t WS_WUKV = 2 * MiB + 512 * 1024;
constexpr size_t WS_WUKV0 = 3 * MiB + 512 * 1024;
constexpr size_t WS_IDN = 3 * MiB + 768 * 1024;
constexpr size_t WS_WG = 3 * MiB;
constexpr size_t WS_SUM = 4 * MiB;
constexpr size_t WS_XBUF = 4 * MiB + 2 * MiB + 512 * 1024;
constexpr size_t WS_WFI = 8 * MiB;
constexpr size_t WS_WFO = 52 * MiB;
constexpr size_t WS_WIN = 74 * MiB;
constexpr size_t WS_WOUT = 83 * MiB;
constexpr size_t WS_H = 88 * MiB;
constexpr size_t WS_OCAT = 120 * MiB;
constexpr size_t WS_ACT = 152 * MiB;
constexpr size_t WS_VB = 152 * MiB;
constexpr size_t WS_XC = 224 * MiB;
constexpr size_t WS_QA = 240 * MiB;
constexpr size_t WS_QC = 248 * MiB;
constexpr size_t WS_KAS = 260 * MiB;
constexpr size_t WS_KAP = 265 * MiB;
constexpr size_t WS_VATS = 269 * MiB;
constexpr size_t WS_VATP = 274 * MiB;
constexpr size_t WS_KCS = 278 * MiB;
constexpr size_t WS_KCP = 286 * MiB;
constexpr size_t WS_VCTS = 292 * MiB;
constexpr size_t WS_VCTP = 297 * MiB;
constexpr size_t WS_XH = 301 * MiB;
constexpr size_t WS_PROJ = 333 * MiB;
constexpr size_t WS_END = 405 * MiB;
constexpr int CW_BAR = 4096;
constexpr int CW_XCC = 8192;
constexpr int CW_Q = 16384;
constexpr int CW_DEP = 16384;
constexpr int CW_SB = 40960;
constexpr int CW_PAN = 65536;

constexpr int RING_BYTES = 131072;
constexpr int LDSCTL_OFF = RING_BYTES, MISC_OFF = LDSCTL_OFF + 320;
constexpr int LDS_BYTES = 147456;

__device__ __forceinline__ int crow(int r, int hi) { return (r & 3) + 8 * (r >> 2) + 4 * hi; }
__device__ __forceinline__ int swap23(int x) { return (x & ~12) | ((x & 4) << 1) | ((x & 8) >> 1); }
__device__ __forceinline__ f16x2 cvt2(float a, float b) { f32x2 v = {a, b}; return __builtin_convertvector(v, f16x2); }
__device__ __forceinline__ f16x4 cvt4(float a, float b, float c, float d) { f32x4 v = {a, b, c, d}; return __builtin_convertvector(v, f16x4); }
__device__ __forceinline__ f16x4 cvt4v(f32x4 v) { return __builtin_convertvector(v, f16x4); }
__device__ __forceinline__ f32x4 tof32(f16x4 v) { return __builtin_convertvector(v, f32x4); }
__device__ __forceinline__ f16x8 pack8(f16x4 a, f16x4 b) { return __builtin_shufflevector(a, b, 0, 1, 2, 3, 4, 5, 6, 7); }
__device__ __forceinline__ float fexp2(float x) { return __builtin_amdgcn_exp2f(x); }
__device__ __forceinline__ float frcp(float x) { return __builtin_amdgcn_rcpf(x); }
__device__ __forceinline__ float sigmoidf_(float x) { return frcp(1.0f + fexp2(-x * LOG2E)); }
__device__ __forceinline__ void sigmoid2(float x0, float x1, float& s0, float& s1) {
    const float d0 = 1.0f + fexp2(fminf(-x0 * LOG2E, 60.0f)), d1 = 1.0f + fexp2(fminf(-x1 * LOG2E, 60.0f)), ri = frcp(d0 * d1);
    s0 = d1 * ri; s1 = d0 * ri;
}
__device__ __forceinline__ float wave_sum(float v) {
#pragma unroll
    for (int o = 1; o < 64; o <<= 1) v += __shfl_xor(v, o);
    return v;
}
__device__ __forceinline__ f16x8 pair8(f16x4 a, f16x4 b) {
    const u32x2 ua = __builtin_bit_cast(u32x2, a), ub = __builtin_bit_cast(u32x2, b);
    const auto r0 = __builtin_amdgcn_permlane32_swap(ua.x, ub.x, false, false);
    const auto r1 = __builtin_amdgcn_permlane32_swap(ua.y, ub.y, false, false);
    const u32x4 o = {r0[0], r1[0], r0[1], r1[1]};
    return __builtin_bit_cast(f16x8, o);
}
__device__ __forceinline__ void unpair8(f16x8 v, f16x4& a, f16x4& b) {
    const u32x4 u = __builtin_bit_cast(u32x4, v);
    const auto r0 = __builtin_amdgcn_permlane32_swap(u.x, u.z, false, false);
    const auto r1 = __builtin_amdgcn_permlane32_swap(u.y, u.w, false, false);
    const u32x2 ua = {r0[0], r1[0]}, ub = {r0[1], r1[1]};
    a = __builtin_bit_cast(f16x4, ua); b = __builtin_bit_cast(f16x4, ub);
}
#define FENCE() asm volatile("" ::: "memory")
#define ST16_WT(p, v, wt) do { if (wt) st16_sc1_((p), (v)); else *(f16x8*)(p) = (v); } while (0)
__device__ __forceinline__ void st16_sc1_(void* p, f16x8 v) { asm volatile("global_store_dwordx4 %0, %1, off sc1\n\ts_nop 1" :: "v"(p), "v"(v) : "memory"); }
__device__ __forceinline__ int lane_id_fresh() { int l; asm volatile("v_mbcnt_lo_u32_b32 %0, -1, 0\n\tv_mbcnt_hi_u32_b32 %0, -1, %0" : "=v"(l)); return l; }
#define MFMA32(a, b, c) __builtin_amdgcn_mfma_f32_32x32x16_f16((a), (b), (c), 0, 0, 0)

namespace pg8 {
#define PG8_LAS __attribute__((address_space(3)))
constexpr int BM = 256, BK = 64, HALF = 128, HTB = HALF * BK * 2, STAGE_BYTES = 8 * HTB, NXCD = 8, WGM = 8;
__host__ __device__ __forceinline__ int lds_byte(int r, int c) { const int st = (r >> 4) * 2 + (c >> 5), rr = r & 15, cc = c & 31, ob = rr * 64 + cc * 2; return st * 1024 + (ob ^ (((ob >> 9) & 1) << 5)); }
__host__ __device__ __forceinline__ void stage_rc(int b, int& R, int& C) { const int st = b / 1024, sb = b % 1024, swz = sb ^ (((sb >> 9) & 1) << 5); R = (st >> 1) * 16 + swz / 64; C = (st & 1) * 32 + (swz % 64) / 2; }
__host__ __device__ __forceinline__ int perm32(int rho) { const int n = rho >> 4, i = rho & 15; return 8 * (i >> 2) + 4 * n + (i & 3); }
struct Unit { int pm, pn; };
struct Gemm { const f16* A; const f16* Bt; int M, N, K; };
struct StaticOrder {
    int nM, nN, nwg, G, c;
    __host__ __device__ void init(int M_, int N_, int G_, int c_) { nM = M_ / BM; nN = N_ / BM; nwg = nM * nN; G = G_; c = c_; }
    __host__ __device__ bool next(int i, Unit& u) const {
        const long L = (long)i * G + c; if (L >= nwg) return false;
        int wgid = (int)L; { const int q = nwg / NXCD, r = nwg % NXCD, xcd = wgid % NXCD, off = wgid / NXCD; wgid = (xcd < r ? xcd * (q + 1) : r * (q + 1) + (xcd - r) * q) + off; }
        const int nig = WGM * nN, gid = wgid / nig, fm = gid * WGM, gsz = (nM - fm) < WGM ? (nM - fm) : WGM;
        u.pm = fm + ((wgid % nig) % gsz); u.pn = (wgid % nig) / gsz; return true;
    }
};
struct ChainOrder {
    StaticOrder so; int kind, x, s, i0, i1; const unsigned* dep; unsigned target; unsigned* pub;
    __device__ void init(int M_, int N_, int G_, int bid, int kind_, const unsigned* dep_, unsigned target_, unsigned* pub_) { so.init(M_, N_, G_, bid); kind = kind_; x = bid & 7; s = bid >> 3; i0 = 0; i1 = 1 << 20; dep = dep_; target = target_; pub = pub_; }
    __device__ bool next(int i, Unit& u) const {
        if (kind < 0) return so.next(i, u);
        i += i0; if (i >= i1) return false;
        int h, j; const int gb = s >> 4, sl = s & 15;
        if (kind == 0) { const int idx = 32 * i + s; if (idx >= 176) return false; h = idx >= 88; j = idx - 88 * h; }
        else if (kind == 1) { if (gb) { if (i < 5) { h = 0; j = 16 * i + sl; } else if (i == 5) { h = sl >> 3; j = 80 + (sl & 7); } else return false; } else { if (i >= 5) return false; h = 1; j = 16 * i + sl; } }
        else if (kind == 2) { if (i) return false; h = gb ^ 1; j = sl; }
        else if (kind == 3) { if (i) return false; u.pm = 8 * x + (s & 7); u.pn = s >> 3; return true; }
        else if (kind == 4) { if (gb) { if (i < 2) { h = 0; j = 16 * i + sl; } else if (i == 2) { if (sl < 4) { h = 0; j = 32 + sl; } else { h = 1; j = 20 + sl; } } else return false; }
                              else { if (i == 0) { h = 1; j = sl; } else if (i == 1 && sl < 8) { h = 1; j = 16 + sl; } else return false; } }
        else { if (i < 2) { const int idx = 32 * i + s; h = idx >> 5; j = idx & 31; } else { if (i > 2 || s >= 8) return false; u.pm = 8 * x + s; u.pn = 8; return true; } }
        u.pm = 8 * x + 4 * h + (j & 3); u.pn = j >> 2; return true;
    }
};
__device__ __forceinline__ void dep_wait(const unsigned* c, unsigned target, bool acq) {
    if (acq) { __builtin_amdgcn_fence(__ATOMIC_ACQUIRE, "agent"); asm volatile("s_waitcnt vmcnt(0)" ::: "memory"); }
    unsigned spins = 0;
    while ((unsigned)__builtin_amdgcn_readfirstlane(__hip_atomic_load(c, __ATOMIC_RELAXED, __HIP_MEMORY_SCOPE_AGENT)) < target) { if (++spins > (1u << 21)) break; __builtin_amdgcn_s_sleep(1); }
}
struct EpiSwiglu {
    static constexpr bool PERM = true, AFTER_DRAIN = false, HALFN = false;
    f16* O; int wt;
    __device__ __forceinline__ void operator()(const f32x4 (&acc)[2][2][4][2], const Unit& u, int wr, int wc, int fr, int fq) const {
        const int row0 = wr * 64 + fr; f16* tb = O + (size_t)(unsigned)(((u.pm * (DFF / 64) + u.pn * 2 + (wc >> 1)) * 256) * 64 + (wc & 1) * 32 + 8 * fq);
#pragma unroll
        for (int ai = 0; ai < 2; ++ai)
#pragma unroll
            for (int m = 0; m < 4; ++m) {
                f16* rowp = tb + (row0 + ai * HALF + m * 16) * 64;
                f32x4 a0, a1;
#pragma unroll
                for (int e = 0; e < 4; ++e) {
                    const float g0 = acc[ai][0][m][0][e], g1 = acc[ai][0][m][1][e];
                    a0[e] = g0 * acc[ai][1][m][0][e] * frcp(1.0f + fexp2(g0));
                    a1[e] = g1 * acc[ai][1][m][1][e] * frcp(1.0f + fexp2(g1));
                }
                ST16_WT(rowp, pack8(cvt4v(a0), cvt4v(a1)), wt);
            }
    }
};
struct EpiStore {
    static constexpr bool PERM = true, AFTER_DRAIN = false, HALFN = true;
    f16* O; int ldc; int nhalf;
    __device__ __forceinline__ void operator()(const f32x4 (&acc)[2][2][4][2], const Unit& u, int wr, int wc, int fr, int fq) const {
        const int row0 = u.pm * BM + wr * 64 + fr, col0 = u.pn * BM + wc * 32 + 8 * fq;
#pragma unroll
        for (int ai = 0; ai < 2; ++ai)
#pragma unroll
            for (int m = 0; m < 4; ++m) {
                f16* rowp = O + (size_t)(row0 + ai * HALF + m * 16) * ldc + col0;
#pragma unroll
                for (int bj = 0; bj < 2; ++bj) if (bj == 0 || u.pn != nhalf) *(f16x8*)(rowp + bj * HALF) = pack8(cvt4v(acc[ai][bj][m][0]), cvt4v(acc[ai][bj][m][1]));
            }
    }
};
struct EpiResidNorm {
    static constexpr bool PERM = true, AFTER_DRAIN = true, HALFN = false;
    float* X; f16* XH; const float* modl; int gidx; float coef;
    int donorm; f16* H; const float* gn; const float* shn;
    float* xbuf; unsigned* cnt; int wt;
    __device__ __forceinline__ void fused(f32x4 (&acc)[2][2][4][2], const Unit& u, int wr, int wc, int fr, int fq, PG8_LAS unsigned char* lds, int wid, int lane) const {
        const int cond = (u.pm < 32) ? 4 : ((u.pm - 32) >> 3);
        const int col0 = u.pn * BM + wc * 32 + 8 * fq;
        {
            const float* gp = modl + (size_t)cond * NMODV + gidx * DM + col0;
            f32x4 gv[2][2];
#pragma unroll
            for (int bj = 0; bj < 2; ++bj)
#pragma unroll
                for (int n = 0; n < 2; ++n) gv[bj][n] = *(const f32x4*)(gp + bj * HALF + n * 4) * coef;
#pragma unroll
            for (int ai = 0; ai < 2; ++ai)
#pragma unroll
                for (int m = 0; m < 4; ++m) {
                    const f16* rowp = XH + (size_t)(u.pm * BM + ai * HALF + wr * 64 + m * 16 + fr) * DM + col0;
                    f32x4 xv[2][2];
#pragma unroll
                    for (int bj = 0; bj < 2; ++bj) { const f16x8 xh = *(const f16x8*)(rowp + bj * HALF);
                        xv[bj][0] = (f32x4){(float)xh[0], (float)xh[1], (float)xh[2], (float)xh[3]}; xv[bj][1] = (f32x4){(float)xh[4], (float)xh[5], (float)xh[6], (float)xh[7]}; }
#pragma unroll
                    for (int bj = 0; bj < 2; ++bj)
#pragma unroll
                        for (int n = 0; n < 2; ++n) { const f32x4 v = xv[bj][n] + gv[bj][n] * acc[ai][bj][m][n]; acc[ai][bj][m][n] = v; }
                    asm volatile("" : "+v"(acc[ai][0][m][0]), "+v"(acc[ai][0][m][1]), "+v"(acc[ai][1][m][0]), "+v"(acc[ai][1][m][1]));
                    if (m & 1) asm volatile("" ::: "memory");
                }
        }
        if (!donorm) {
#pragma unroll
            for (int ai = 0; ai < 2; ++ai)
#pragma unroll
                for (int m = 0; m < 4; ++m) {
                    float* rowp = X + (size_t)(u.pm * BM + ai * HALF + wr * 64 + m * 16 + fr) * DM + col0;
#pragma unroll
                    for (int bj = 0; bj < 2; ++bj)
#pragma unroll
                        for (int n = 0; n < 2; ++n) *(f32x4*)(rowp + bj * HALF + n * 4) = acc[ai][bj][m][n];
                }
            return;
        }
        PG8_LAS float* P = (PG8_LAS float*)lds;
        PG8_LAS float* S = (PG8_LAS float*)(lds + 4096);
#pragma unroll
        for (int ai = 0; ai < 2; ++ai)
#pragma unroll
            for (int m = 0; m < 4; ++m) {
                float q = 0.f;
#pragma unroll
                for (int bj = 0; bj < 2; ++bj)
#pragma unroll
                    for (int n = 0; n < 2; ++n) { const f32x4 x = acc[ai][bj][m][n]; q += (x[0] * x[0] + x[1] * x[1]) + (x[2] * x[2] + x[3] * x[3]); }
                q += __shfl_xor(q, 16); q += __shfl_xor(q, 32);
                if (fq == 0) P[(ai * HALF + wr * 64 + m * 16 + fr) * 4 + wc] = q;
            }
        asm volatile("s_waitcnt lgkmcnt(0)" ::: "memory"); __builtin_amdgcn_s_barrier(); asm volatile("" ::: "memory");
        const int row = wid * 32 + (lane & 31);
        if (lane < 32) {
            const float tot = (P[row * 4 + 0] + P[row * 4 + 1]) + (P[row * 4 + 2] + P[row * 4 + 3]);
            __hip_atomic_store(xbuf + ((size_t)(u.pm * BM + row) * 4 + u.pn), tot, __ATOMIC_RELAXED, __HIP_MEMORY_SCOPE_AGENT);
        }
        asm volatile("s_waitcnt vmcnt(0)" ::: "memory");
        if (lane == 0) __hip_atomic_fetch_add(cnt + 64 * u.pm, 1u, __ATOMIC_RELAXED, __HIP_MEMORY_SCOPE_AGENT);
#pragma unroll
        for (int ai = 0; ai < 2; ++ai)
#pragma unroll
            for (int m = 0; m < 4; ++m) {
                f16* rowp = XH + (size_t)(u.pm * BM + ai * HALF + wr * 64 + m * 16 + fr) * DM + col0;
#pragma unroll
                for (int bj = 0; bj < 2; ++bj) ST16_WT(rowp + bj * HALF, pack8(cvt4v(acc[ai][bj][m][0]), cvt4v(acc[ai][bj][m][1])), wt);
            }
        if (wid == 0) {
            unsigned spins = 0;
            for (;;) {
                if ((unsigned)__builtin_amdgcn_readfirstlane(__hip_atomic_load(cnt + 64 * u.pm, __ATOMIC_RELAXED, __HIP_MEMORY_SCOPE_AGENT)) >= 32u) break;
                if (++spins > (1u << 20)) break;
                __builtin_amdgcn_s_sleep(2);
            }
            __builtin_amdgcn_fence(__ATOMIC_ACQUIRE, "agent");
        }
        asm volatile("s_waitcnt vmcnt(0) lgkmcnt(0)" ::: "memory"); __builtin_amdgcn_s_barrier(); asm volatile("" ::: "memory");
        if (lane < 32) {
            const float* slot = xbuf + (size_t)(u.pm * BM + row) * 4;
            const float t0 = __hip_atomic_load(slot + 0, __ATOMIC_RELAXED, __HIP_MEMORY_SCOPE_AGENT), t1 = __hip_atomic_load(slot + 1, __ATOMIC_RELAXED, __HIP_MEMORY_SCOPE_AGENT);
            const float t2 = __hip_atomic_load(slot + 2, __ATOMIC_RELAXED, __HIP_MEMORY_SCOPE_AGENT), t3 = __hip_atomic_load(slot + 3, __ATOMIC_RELAXED, __HIP_MEMORY_SCOPE_AGENT);
            S[row] = 1.0f / sqrtf(((t0 + t1) + (t2 + t3)) * (1.0f / DM) + EPS);
        }
        asm volatile("s_waitcnt lgkmcnt(0)" ::: "memory"); __builtin_amdgcn_s_barrier(); asm volatile("" ::: "memory");
        const float* shp = shn + (size_t)cond * NMODV + col0;
        f32x4 gsv[2][2], shv[2][2];
#pragma unroll
        for (int bj = 0; bj < 2; ++bj)
#pragma unroll
            for (int n = 0; n < 2; ++n) { const int co = bj * HALF + n * 4;
                gsv[bj][n] = *(const f32x4*)(gn + col0 + co) * (*(const f32x4*)(shp + DM + co) + 1.0f); shv[bj][n] = *(const f32x4*)(shp + co); }
#pragma unroll
        for (int ai = 0; ai < 2; ++ai)
#pragma unroll
            for (int m = 0; m < 4; ++m) { const int r = ai * HALF + wr * 64 + m * 16 + fr; const float sr = S[r];
#pragma unroll
                for (int bj = 0; bj < 2; ++bj) ST16_WT(H + (size_t)(u.pm * BM + r) * DM + col0 + bj * HALF, pack8(cvt4v(acc[ai][bj][m][0] * sr * gsv[bj][0] + shv[bj][0]), cvt4v(acc[ai][bj][m][1] * sr * gsv[bj][1] + shv[bj][1])), wt); }
    }
};

template <class Epi, class Sched, bool ALIGN_EPI, bool SP2, bool TM = false>
__device__ __forceinline__ void gemm_phase(PG8_LAS unsigned char* lds, const Gemm g, const Sched& S, const Epi& E, int wave_id) {
    int wid_ = wave_id; asm volatile("" : "+s"(wid_));
    const int lane = lane_id_fresh(), wid = wid_, tid = wid * 64 + lane, wr = wid >> 2, wc = wid & 3, fr = lane & 15, fq = lane >> 4;
    const int K = g.K, nt = K / BK;
    unsigned voffA[2], voffB[2];
#pragma unroll
    for (int i = 0; i < 2; ++i) { int R, C; stage_rc(tid * 16 + i * 8192, R, C); const int Rb = Epi::PERM ? ((R & ~31) + perm32(R & 31)) : R;
        voffA[i] = (unsigned)(R * (TM ? 64 : K) + C) * 2u; voffB[i] = (unsigned)(Rb * (TM ? 64 : K) + C) * 2u; }
    const size_t ksA = TM ? 32768 : BK * 2, hsA = TM ? (size_t)16384 : (size_t)HALF * K * 2, ksB = ksA, hsB = hsA, tsA = TM ? (size_t)nt * 32768 : 2 * hsA, tsB = tsA;
    const unsigned ldsw = (unsigned)wid * 1024u;
    const int aoff = lds_byte(wr * 64 + fr, fq * 8), boff = lds_byte(wc * 32 + fr, fq * 8);
#define PG8_SA(b, h) (((b) * 2 + (h)) * HTB)
#define PG8_SB(b, h) ((4 + (b) * 2 + (h)) * HTB)
#define PG8_STAGE(bufoff, gbase, voff) do { _Pragma("unroll") for (int _i = 0; _i < 2; ++_i) \
        __builtin_amdgcn_global_load_lds((const unsigned*)((const char*)(gbase) + (voff)[_i]), (PG8_LAS unsigned*)(lds + (bufoff) + ldsw + _i * 8192), 16, 0, 0); } while (0)
#define PG8_LDA(dst, b, h) do { _Pragma("unroll") for (int m = 0; m < 4; ++m) _Pragma("unroll") for (int k = 0; k < 2; ++k) dst[m][k] = *(const PG8_LAS f16x8*)(lds + PG8_SA(b, h) + aoff + m * 2048 + k * 1024); } while (0)
#define PG8_LDB(dst, b, h) do { _Pragma("unroll") for (int n = 0; n < 2; ++n) _Pragma("unroll") for (int k = 0; k < 2; ++k) dst[n][k] = *(const PG8_LAS f16x8*)(lds + PG8_SB(b, h) + boff + n * 2048 + k * 1024); } while (0)
#define PG8_MMA(ai, bj, At, Bt) do { __builtin_amdgcn_s_setprio(1); _Pragma("unroll") for (int m = 0; m < 4; ++m) _Pragma("unroll") for (int n = 0; n < 2; ++n) _Pragma("unroll") for (int k = 0; k < 2; ++k) \
        acc[ai][bj][m][n] = __builtin_amdgcn_mfma_f32_16x16x32_f16(Bt[n][k], At[m][k], acc[ai][bj][m][n], 0, 0, 0); __builtin_amdgcn_s_setprio(0); } while (0)
#define PG8_WAIT_V(n) asm volatile("s_waitcnt vmcnt(" #n ")" ::: "memory")
#define PG8_WAIT_L(n) asm volatile("s_waitcnt lgkmcnt(" #n ")" ::: "memory")
#define PG8_BAR __builtin_amdgcn_s_barrier()
#define PG8_SCHED __builtin_amdgcn_sched_barrier(0)
    Unit cur, nxt; int ui = 0;
    if (!S.next(0, cur)) return;
    unsigned known = 0u;
#define PG8_DEPWAIT(U) do { if (S.dep) { const unsigned bit_ = 1u << (((U).pm >> 2) & 1); if (!(known & bit_)) { if (wid == 0) dep_wait(S.dep + 64 * ((U).pm >> 2), S.target, known == 0u); __builtin_amdgcn_s_barrier(); asm volatile("" ::: "memory"); known |= bit_; } } } while (0)
#define PG8_PUBLISH(U) do { if (S.pub) { asm volatile("s_waitcnt vmcnt(0)" ::: "memory"); if (lane == 0) __hip_atomic_fetch_add(S.pub + 64 * ((U).pm >> 2), 1u, __ATOMIC_RELAXED, __HIP_MEMORY_SCOPE_AGENT); } } while (0)
    f32x4 acc[2][2][4][2];
#pragma unroll
    for (int a = 0; a < 2; ++a)
#pragma unroll
        for (int b = 0; b < 2; ++b)
#pragma unroll
            for (int m = 0; m < 4; ++m)
#pragma unroll
                for (int n = 0; n < 2; ++n) acc[a][b][m][n] = (f32x4){0.f, 0.f, 0.f, 0.f};
    f16x8 At[4][2], B0[2][2], B1[2][2];
    const char* cA = (const char*)g.A + (size_t)cur.pm * tsA; const char* cB = (const char*)g.Bt + (size_t)cur.pn * tsB;
    if constexpr (SP2) {
        PG8_STAGE(PG8_SB(0, 0), cB, voffB); PG8_STAGE(PG8_SB(0, 1), cB + hsB, voffB);
        PG8_DEPWAIT(cur);
        PG8_STAGE(PG8_SA(0, 0), cA, voffA); PG8_STAGE(PG8_SA(0, 1), cA + hsA, voffA);
        if (wr == 1) PG8_BAR;
        PG8_WAIT_V(2); PG8_BAR;
        PG8_STAGE(PG8_SB(1, 0), cB + ksB, voffB); PG8_STAGE(PG8_SA(1, 0), cA + ksA, voffA); PG8_STAGE(PG8_SB(1, 1), cB + hsB + ksB, voffB);
        PG8_WAIT_V(6); PG8_BAR;
    } else {
        PG8_DEPWAIT(cur);
        PG8_STAGE(PG8_SB(0, 0), cB, voffB); PG8_STAGE(PG8_SA(0, 0), cA, voffA); PG8_STAGE(PG8_SB(0, 1), cB + hsB, voffB); PG8_STAGE(PG8_SA(0, 1), cA + hsA, voffA);
        if (wr == 1) PG8_BAR;
        PG8_WAIT_V(4); PG8_BAR;
        PG8_STAGE(PG8_SB(1, 0), cB + ksB, voffB); PG8_STAGE(PG8_SA(1, 0), cA + ksA, voffA); PG8_STAGE(PG8_SB(1, 1), cB + hsB + ksB, voffB);
        PG8_WAIT_V(6); PG8_BAR;
    }
    for (;;) {
        bool hn = false; if constexpr (Epi::HALFN) hn = (cur.pn == E.nhalf);
        const bool has_next = S.next(ui + 1, nxt);
        if (has_next) PG8_DEPWAIT(nxt);
        const char* nA = has_next ? (const char*)g.A + (size_t)nxt.pm * tsA : cA; const char* nB = has_next ? (const char*)g.Bt + (size_t)nxt.pn * tsB : cB;
        for (int t = 0; t < nt; t += 2) {
            const bool last = (t == nt - 2);
            const char* a1 = cA + (size_t)(t + 1) * ksA;
            const char* a2 = last ? nA : cA + (size_t)(t + 2) * ksA; const char* b2 = last ? nB : cB + (size_t)(t + 2) * ksB;
            const char* a3 = a2 + ksA; const char* b3 = b2 + ksB;
            if constexpr (SP2) {
            PG8_LDB(B0, 0, 0); PG8_LDB(B1, 0, 1); PG8_SCHED; PG8_LDA(At, 0, 0); PG8_STAGE(PG8_SA(1, 1), a1 + hsA, voffA);
            PG8_WAIT_V(8); PG8_WAIT_L(0); PG8_BAR; PG8_MMA(0, 0, At, B0); if (!hn) PG8_MMA(0, 1, At, B1); PG8_BAR; PG8_SCHED;
            PG8_LDA(At, 0, 1); PG8_STAGE(PG8_SB(0, 0), b2, voffB); PG8_STAGE(PG8_SB(0, 1), b2 + hsB, voffB); PG8_STAGE(PG8_SA(0, 0), a2, voffA);
            PG8_WAIT_V(8); PG8_WAIT_L(0); PG8_BAR; PG8_MMA(1, 0, At, B0); if (!hn) PG8_MMA(1, 1, At, B1); PG8_BAR; PG8_SCHED;
            PG8_LDB(B0, 1, 0); PG8_LDB(B1, 1, 1); PG8_SCHED; PG8_LDA(At, 1, 0); PG8_STAGE(PG8_SA(0, 1), a2 + hsA, voffA);
            PG8_WAIT_V(8); PG8_WAIT_L(0); PG8_BAR; PG8_MMA(0, 0, At, B0); if (!hn) PG8_MMA(0, 1, At, B1); PG8_BAR; PG8_SCHED;
            PG8_LDA(At, 1, 1); PG8_STAGE(PG8_SB(1, 0), b3, voffB); PG8_STAGE(PG8_SB(1, 1), b3 + hsB, voffB); PG8_STAGE(PG8_SA(1, 0), a3, voffA);
            PG8_WAIT_V(8); PG8_WAIT_L(0); PG8_BAR; PG8_MMA(1, 0, At, B0); if (!hn) PG8_MMA(1, 1, At, B1); PG8_BAR; PG8_SCHED;
            } else {
            PG8_LDB(B0, 0, 0); PG8_SCHED; PG8_LDA(At, 0, 0); PG8_STAGE(PG8_SA(1, 1), a1 + hsA, voffA);
            PG8_WAIT_L(8); PG8_BAR; PG8_WAIT_L(0); PG8_MMA(0, 0, At, B0); PG8_BAR; PG8_SCHED;
            PG8_LDB(B1, 0, 1); PG8_STAGE(PG8_SB(0, 0), b2, voffB);
            PG8_BAR; PG8_WAIT_L(0); PG8_MMA(0, 1, At, B1); PG8_BAR;
            PG8_LDA(At, 0, 1); PG8_STAGE(PG8_SA(0, 0), a2, voffA);
            PG8_BAR; PG8_WAIT_L(0); PG8_MMA(1, 0, At, B0); PG8_BAR; PG8_SCHED;
            PG8_STAGE(PG8_SB(0, 1), b2 + hsB, voffB);
            PG8_WAIT_V(6); PG8_BAR; PG8_MMA(1, 1, At, B1); PG8_BAR;
            PG8_LDB(B0, 1, 0); PG8_SCHED; PG8_LDA(At, 1, 0); PG8_STAGE(PG8_SA(0, 1), a2 + hsA, voffA);
            PG8_WAIT_L(8); PG8_BAR; PG8_WAIT_L(0); PG8_MMA(0, 0, At, B0); PG8_BAR; PG8_SCHED;
            PG8_LDB(B1, 1, 1); PG8_STAGE(PG8_SB(1, 0), b3, voffB);
            PG8_BAR; PG8_WAIT_L(0); PG8_MMA(0, 1, At, B1); PG8_BAR;
            PG8_LDA(At, 1, 1); PG8_STAGE(PG8_SA(1, 0), a3, voffA);
            PG8_BAR; PG8_WAIT_L(0); PG8_MMA(1, 0, At, B0); PG8_BAR; PG8_SCHED;
            PG8_STAGE(PG8_SB(1, 1), b3 + hsB, voffB);
            PG8_WAIT_V(6); PG8_BAR; PG8_MMA(1, 1, At, B1); PG8_BAR;
            }
        }
        if constexpr (ALIGN_EPI) { if (wr == 0) PG8_BAR; }
        if constexpr (!Epi::AFTER_DRAIN) { E(acc, cur, wr, wc, fr, fq); PG8_PUBLISH(cur); }
        if (!has_next) break;
#pragma unroll
        for (int a = 0; a < 2; ++a)
#pragma unroll
            for (int b = 0; b < 2; ++b)
#pragma unroll
                for (int m = 0; m < 4; ++m)
#pragma unroll
                    for (int n = 0; n < 2; ++n) acc[a][b][m][n] = (f32x4){0.f, 0.f, 0.f, 0.f};
        cur = nxt; cA = nA; cB = nB; ++ui;
        if constexpr (ALIGN_EPI) { if (wr == 1) PG8_BAR; }
    }
    PG8_WAIT_V(0);
    if constexpr (!ALIGN_EPI) { if (wr == 0) PG8_BAR; }
    PG8_BAR;
    if constexpr (Epi::AFTER_DRAIN) { E.fused(acc, cur, wr, wc, fr, fq, lds, wid, lane); PG8_PUBLISH(cur); }
#undef PG8_DEPWAIT
#undef PG8_PUBLISH
#undef PG8_SA
#undef PG8_SB
#undef PG8_STAGE
#undef PG8_LDA
#undef PG8_LDB
#undef PG8_MMA
#undef PG8_WAIT_V
#undef PG8_WAIT_L
#undef PG8_BAR
#undef PG8_SCHED
}
}

#define XB_TMO      128
#define XB_XCNT(j)  (256  + 64 * (j))
#define XB_XSUB(j)  (1280 + 64 * (j))
#define XB_XGEN(j)  (2304 + 64 * (j))
#define XB_TOP      3328
#define XB_TOPGEN   3392
#define XCD_BAR_WORDS 3456
#define XB_SPIN_CAP (1u << 18)
__device__ __forceinline__ unsigned xb_ld(unsigned* p)              { return __hip_atomic_load(p, __ATOMIC_RELAXED, __HIP_MEMORY_SCOPE_AGENT); }
__device__ __forceinline__ unsigned xb_add(unsigned* p, unsigned v) { return __hip_atomic_fetch_add(p, v, __ATOMIC_RELAXED, __HIP_MEMORY_SCOPE_AGENT); }
__device__ __forceinline__ unsigned xb_xcc_id() { return (unsigned)__builtin_amdgcn_s_getreg((3 << 11) | 20) & 0xFu; }
#define XB_SPIN(cond, bar) do { unsigned _sp = 0; while (cond) { __builtin_amdgcn_s_sleep(1); \
    if ((++_sp & 255u) == 0u) { if (xb_ld(&(bar)[XB_TMO])) break; if (_sp > XB_SPIN_CAP) { atomicAdd(&(bar)[XB_TMO], 1u); break; } } } } while (0)
struct XcdBarrier { unsigned* bar; unsigned x; volatile LAS unsigned* st; };
__device__ __forceinline__ XcdBarrier xcd_barrier_post(unsigned* bar, volatile LAS unsigned* st) {
    XcdBarrier b; b.bar = bar; b.x = xb_xcc_id(); b.st = st;
    if (threadIdx.x == 0) (void)xb_add(&bar[XB_XCNT(b.x)], 1u);
    return b;
}
__device__ __forceinline__ void xcd_barrier_complete(unsigned* bar, unsigned x, unsigned& nloc, unsigned& nx) {
    const unsigned G = gridDim.x * gridDim.y * gridDim.z;
    unsigned sum, cnt, mine, sp = 0u;
    for (;;) {
        sum = 0u; cnt = 0u; mine = 0u;
#pragma unroll
        for (unsigned j = 0; j < 16; ++j) { const unsigned c = xb_ld(&bar[XB_XCNT(j)]); sum += c; cnt += (c > 0u) ? 1u : 0u; mine = (j == x) ? c : mine; }
        if (sum == G) break;
        __builtin_amdgcn_s_sleep(1);
        if ((++sp & 255u) == 0u) { if (xb_ld(&bar[XB_TMO])) break; if (sp > XB_SPIN_CAP) { atomicAdd(&bar[XB_TMO], 1u); break; } }
    }
    nloc = mine > 0u ? mine : 1u; nx = cnt > 0u ? cnt : 1u;
}
__device__ __forceinline__ void xcd_barrier(const XcdBarrier& b, int wave_id) {
    asm volatile("s_waitcnt vmcnt(0)" ::: "memory");
    __syncthreads();
    if (wave_id == 0 && lane_id_fresh() == 0) {
        unsigned* bar = b.bar;
        __builtin_amdgcn_s_waitcnt(0);
        unsigned nloc = b.st[0], nx = b.st[1];
        if (nloc == 0u) { xcd_barrier_complete(bar, b.x, nloc, nx); b.st[0] = nloc; b.st[1] = nx; }
        const unsigned old = xb_add(&bar[XB_XSUB(b.x)], 1u);
        const unsigned gen = old / nloc;
        if (old + 1u == (gen + 1u) * nloc) {
            __builtin_amdgcn_fence(__ATOMIC_RELEASE, "agent");
            asm volatile("s_waitcnt vmcnt(0)" ::: "memory");
            const unsigned og = xb_add(&bar[XB_TOP], 1u);
            const unsigned tg = og / nx;
            __builtin_amdgcn_fence(__ATOMIC_ACQUIRE, "agent");
            if (og + 1u == (tg + 1u) * nx) xb_add(&bar[XB_TOPGEN], 1u);
            else XB_SPIN(xb_ld(&bar[XB_TOPGEN]) == tg, bar);
            xb_add(&bar[XB_XGEN(b.x)], 1u);
            asm volatile("s_waitcnt vmcnt(0)" ::: "memory");
        } else {
            __builtin_amdgcn_fence(__ATOMIC_ACQUIRE, "agent");
            XB_SPIN(xb_ld(&bar[XB_XGEN(b.x)]) == gen, bar);
            asm volatile("s_waitcnt vmcnt(0)" ::: "memory");
        }
    }
    __syncthreads();
}

__device__ __forceinline__ void split_arrive(const XcdBarrier& b, unsigned* sb, int wave_id) {
    asm volatile("s_waitcnt vmcnt(0)" ::: "memory");
    __syncthreads();
    if (wave_id == 0 && lane_id_fresh() == 0) {
        const unsigned nloc = b.st[0];
        const unsigned old = xb_add(&sb[64 * b.x], 1u);
        if (old + 1u == nloc) {
            __builtin_amdgcn_fence(__ATOMIC_RELEASE, "agent");
            asm volatile("s_waitcnt vmcnt(0)" ::: "memory");
            (void)xb_add(&sb[64 * 16], 1u);
        }
        asm volatile("s_waitcnt vmcnt(0)" ::: "memory");
    }
}
__device__ __forceinline__ void split_wait(const XcdBarrier& b, unsigned* sb, int wave_id) {
    __syncthreads();
    if (wave_id == 0 && lane_id_fresh() == 0) {
        const unsigned nx = b.st[1];
        __builtin_amdgcn_fence(__ATOMIC_ACQUIRE, "agent");
        XB_SPIN(xb_ld(&sb[64 * 16]) < nx, b.bar);
        asm volatile("s_waitcnt vmcnt(0)" ::: "memory");
    }
    __syncthreads();
}

struct Args { const float* in[N_IN]; float* out; unsigned char* ws; int ph_lo, ph_hi; };
static_assert(sizeof(Args) == N_IN * 8 + 8 + 8 + 8, "Args has no padding");

struct Ctx {
    const float* const* in; float* out; unsigned char* ws;
    LAS unsigned char* lds;
    int tid, lane, wave, gw, ngw, bid, G;
};
#define WSP(T, off) ((T*)(C.ws + (off)))
__device__ __forceinline__ Ctx ctx_fresh(const Ctx& C0) {
    Ctx C = C0; C.lane = lane_id_fresh(); C.tid = C.wave * 64 + C.lane;
    int bid = blockIdx.x, G = gridDim.x; asm volatile("" : "+s"(bid), "+s"(G));
    C.bid = bid; C.G = G; C.gw = bid * 8 + C.wave; C.ngw = G * 8;
    return C;
}

__device__ __forceinline__ int wq_next(unsigned* ctr, int lane) {
    unsigned v = 0;
    if (lane == 0) v = __hip_atomic_fetch_add(ctr, 1u, __ATOMIC_RELAXED, __HIP_MEMORY_SCOPE_AGENT);
    return (int)__builtin_amdgcn_readfirstlane(v);
}

__device__ __forceinline__ void transpose_item(const float* W, int ldw, f16* WT, int ldt, int dst_row0, int k0, int n0, LAS float* scr, int lane, float scale = 1.0f) {
    f32x4 wv[8];
#pragma unroll
    for (int i = 0; i < 8; ++i) wv[i] = __builtin_nontemporal_load((const f32x4*)(W + (size_t)(k0 + 8 * i + (lane >> 3)) * ldw + n0 + 4 * (lane & 7)));
#pragma unroll
    for (int i = 0; i < 8; ++i) { LAS float* d = scr + (8 * i + (lane >> 3)) * 33 + 4 * (lane & 7); d[0] = wv[i][0]; d[1] = wv[i][1]; d[2] = wv[i][2]; d[3] = wv[i][3]; }
    asm volatile("s_waitcnt lgkmcnt(0)" ::: "memory");
    const int c = lane & 7;
#pragma unroll
    for (int j = 0; j < 4; ++j) { const int n = (lane >> 3) + 8 * j; const LAS float* s = scr + (8 * c) * 33 + n;
        const f16x8 o = pack8(cvt4(s[0 * 33] * scale, s[1 * 33] * scale, s[2 * 33] * scale, s[3 * 33] * scale), cvt4(s[4 * 33] * scale, s[5 * 33] * scale, s[6 * 33] * scale, s[7 * 33] * scale));
        *(f16x8*)(WT + (size_t)(dst_row0 + n) * ldt + k0 + 8 * c) = o; }
    asm volatile("s_waitcnt lgkmcnt(0)" ::: "memory");
}
__device__ __forceinline__ void phase_prep(const Ctx& C0) {
    const Ctx C = ctx_fresh(C0);
    {
        LAS float* sc = (LAS float*)C.lds;
        LAS float* red = (LAS float*)(C.lds + 20480);
        const float* cv = C.in[I_C]; const float* cctx = C.in[I_CCTX];
        for (int i = C.tid; i < 5 * 1024; i += 512) { const int c = i >> 10, k = i & 1023; const float v = (c < 4) ? cv[c * 1024 + k] : cctx[k]; sc[i] = v / (1.0f + __expf(-v)); }
        __syncthreads();
        float* mod = WSP(float, WS_MOD);
        for (int item = C.bid; item < 2 * 144; item += C.G) {
            const int l = item / 144, j0 = (item % 144) * 64, k0 = C.wave * 128;
            const float* wp = C.in[I_WADA] + ((size_t)l * 1024 + k0) * NMODV + j0 + C.lane;
            float a0 = 0.f, a1 = 0.f, a2 = 0.f, a3 = 0.f, a4 = 0.f;
#pragma unroll 16
            for (int kk = 0; kk < 128; ++kk) {
                const float w = __builtin_nontemporal_load(&wp[(size_t)kk * NMODV]);
                a0 += sc[0 * 1024 + k0 + kk] * w; a1 += sc[1 * 1024 + k0 + kk] * w; a2 += sc[2 * 1024 + k0 + kk] * w; a3 += sc[3 * 1024 + k0 + kk] * w; a4 += sc[4 * 1024 + k0 + kk] * w;
            }
            red[(C.wave * 5 + 0) * 64 + C.lane] = a0; red[(C.wave * 5 + 1) * 64 + C.lane] = a1; red[(C.wave * 5 + 2) * 64 + C.lane] = a2;
            red[(C.wave * 5 + 3) * 64 + C.lane] = a3; red[(C.wave * 5 + 4) * 64 + C.lane] = a4;
            __syncthreads();
            if (C.tid < 320) { const int c = C.tid >> 6, ln = C.tid & 63; float s = 0.f;
#pragma unroll
                for (int w = 0; w < 8; ++w) s += red[(w * 5 + c) * 64 + ln];
                mod[((size_t)l * 5 + c) * NMODV + j0 + ln] = s + C.in[I_BADA][(size_t)l * NMODV + j0 + ln]; }
            __syncthreads();
        }
    }
    __syncthreads();
    {
        LAS float* scr = (LAS float*)(C.lds + C.wave * 16384);
        constexpr int IFI = 16 * 176, IFO = 44 * 32, IIN = 16 * 67, IOUT = 16 * 32;
        constexpr int NIT = 4 * IFI + 4 * IFO + 2 * IIN + 2 * IOUT;
        const bool skew = (C.G == 256);
        for (int rd = 0; ; ++rd) {
            int it;
            if (!skew) it = C.gw + rd * C.ngw;
            else if (rd < 4) { if (C.gw < 256) continue; it = rd * 1792 + (C.gw - 256); }
            else it = 4 * 1792 + (rd - 4) * 2048 + C.gw;
            if (it >= NIT) break;
            int r = it;
            if (r < 4 * IFI) { const int mat = r / IFI, rr = r % IFI, kb = rr / 176, n0 = (rr % 176) * 32;
                const int drow = (n0 < DFF) ? ((n0 >> 7) * 256 + (n0 & 127)) : (((n0 - DFF) >> 7) * 256 + 128 + ((n0 - DFF) & 127));
                transpose_item(C.in[I_WFI] + (size_t)mat * 1024 * NFF2, NFF2, WSP(f16, WS_WFI) + (size_t)mat * NFF2 * 1024, 1024, drow, kb * 64, n0, scr, C.lane, (n0 < DFF) ? -LOG2E : -0.6931471805599453f); continue; }
            r -= 4 * IFI;
            if (r < 4 * IFO) { const int mat = r / IFO, rr = r % IFO, kb = rr / 32, n0 = (rr % 32) * 32;
                transpose_item(C.in[I_WFO] + (size_t)mat * DFF * 1024, 1024, WSP(f16, WS_WFO) + (size_t)mat * 1024 * DFF + ((size_t)((n0 >> 8) * (DFF / 64) + kb) * 256) * 64 - kb * 64, 64, n0 & 255, kb * 64, n0, scr, C.lane); continue; }
            r -= 4 * IFO;
            if (r < 2 * IIN) { const int l = r / IIN, rr = r % IIN, kb = rr / 67, n0 = (rr % 67) * 32;
                transpose_item(C.in[I_WIN] + (size_t)l * 1024 * DIN, DIN, WSP(f16, WS_WIN) + (size_t)l * DINP * 1024, 1024, n0, kb * 64, n0, scr, C.lane); continue; }
            r -= 2 * IIN;
            { const int l = r / IOUT, rr = r % IOUT, kb = rr / 32, n0 = (rr % 32) * 32;
                transpose_item(C.in[I_WOUT] + (size_t)l * 1024 * 1024, 1024, WSP(f16, WS_WOUT) + (size_t)l * 1024 * 1024, 1024, n0, kb * 64, n0, scr, C.lane); }
        }
    }
    {
        const int gt = C.bid * 512 + C.tid, ngt = C.G * 512;
        for (int i = gt; i < 2 * 160 * 128; i += ngt) { const int l = i / (160 * 128), rr = i % (160 * 128);
            unsigned z = 0u; asm volatile("" : "+v"(z));
            *(u32x4*)(WSP(f16, WS_WIN) + ((size_t)l * DINP + DIN) * 1024 + (size_t)rr * 8) = (u32x4){z, z, z, z}; }
        f16* wuq = WSP(f16, WS_WUQ);
        for (int i = gt; i < 2 * 384 * 192; i += ngt) { const int e = i & 7, r = (i >> 3) & 31, rest = i >> 8, c = rest % 24, rest2 = rest / 24, t3 = rest2 % 3, lh = rest2 / 3, l = lh >> 2, hd = lh & 3;
            wuq[i] = (f16)(C.in[I_CQN][l * 192 + 8 * c + e] * C.in[I_WUQ][(size_t)l * 192 * 384 + (size_t)(8 * c + e) * 384 + hd * 96 + 32 * t3 + r]); }
        f16* wukv = WSP(f16, WS_WUKV);
        for (int i = gt; i < 2 * 512 * 128; i += ngt) { const int e = i & 7, r = (i >> 3) & 31, rest = i >> 8, c = rest & 15, rest2 = rest >> 4, t4 = rest2 & 3, lh = rest2 >> 2, l = lh >> 2, hd = lh & 3;
            const float w = C.in[I_WUKV][(size_t)l * 128 * 512 + (size_t)(8 * c + e) * 512 + hd * 128 + 32 * t4 + r];
            wukv[i] = (f16)(C.in[I_CKVN][l * 128 + 8 * c + e] * w); WSP(f16, WS_WUKV0)[i] = (f16)w; }
        for (int i = gt; i < 4096; i += ngt) WSP(f16, WS_IDN)[i] = ((i >> 6) == (i & 63)) ? (f16)1.0f : (f16)0.0f;
        f16* wg = WSP(f16, WS_WG);
        for (int i = gt; i < 64 * 4096; i += ngt) { const int m = i >> 12, d = (i >> 6) & 63, c = i & 63; wg[i] = (f16)(-LOG2E * C.in[I_WGATE][(size_t)m * 4096 + c * 64 + d]); }
    }
}

template <bool FIRST>
__device__ __forceinline__ void phase_norm(const Ctx& C0, int l, int sub) {
    const Ctx C = ctx_fresh(C0);
    const float* gvec = C.in[I_NG] + ((size_t)l * 3 + sub) * DM;
    const float* modl = WSP(float, WS_MOD) + (size_t)l * 5 * NMODV;
    f16* H = WSP(f16, WS_H);
    for (int row = C.gw; row < M; row += C.ngw) {
        const float* src = FIRST ? ((row < MP) ? C.in[I_XP] + (size_t)row * DM : C.in[I_XS] + (size_t)(row - MP) * DM) : C.out + (size_t)row * DM;
        const int cond = (row < MP) ? 4 : ((row - MP) >> 11);
        const float* shp = modl + (size_t)cond * NMODV + (3 * sub) * DM; const float* scp = shp + DM;
        f32x4 v[4]; float ss = 0.f;
#pragma unroll
        for (int j = 0; j < 4; ++j) { v[j] = FIRST ? __builtin_nontemporal_load((const f32x4*)(src + 256 * j + 4 * C.lane)) : *(const f32x4*)(src + 256 * j + 4 * C.lane); ss += (v[j].x * v[j].x + v[j].y * v[j].y) + (v[j].z * v[j].z + v[j].w * v[j].w); }
        const float rstd = 1.0f / sqrtf(wave_sum(ss) * (1.0f / DM) + EPS);
        f32x4 gs[4], shv[4];
#pragma unroll
        for (int j = 0; j < 4; ++j) { const int k = 256 * j + 4 * C.lane; gs[j] = *(const f32x4*)(gvec + k) * (*(const f32x4*)(scp + k) + 1.0f); shv[j] = *(const f32x4*)(shp + k); }
#pragma unroll
        for (int j = 0; j < 4; ++j) {
            const int k = 256 * j + 4 * C.lane;
            *(f16x4*)(H + (size_t)row * DM + k) = cvt4v(v[j] * rstd * gs[j] + shv[j]);
            if (FIRST) *(f16x4*)(WSP(f16, WS_XH) + (size_t)row * DM + k) = cvt4v(v[j]);
        }
    }
}

__device__ __forceinline__ void glds16(const void* gsrc, unsigned lds_dst) { unsigned keep;
    asm volatile("s_mov_b32 %0, m0\n\ts_mov_b32 m0, %2\n\ts_nop 0\n\tglobal_load_lds_dwordx4 %1, off\n\ts_mov_b32 m0, %0" : "=&s"(keep) : "v"(gsrc), "s"(lds_dst) : "memory"); }
#define ATT_GLDS(g, l) glds16((const void*)(g), (unsigned)__builtin_amdgcn_readfirstlane((unsigned)(uintptr_t)(l)))
#define ATT_WAITBAR(N) asm volatile("s_waitcnt vmcnt(" #N ") lgkmcnt(0)\n\ts_barrier" ::: "memory")
#define ATT_LBAR() asm volatile("s_waitcnt lgkmcnt(0)\n\ts_barrier" ::: "memory")
struct MxTok { int b, t, key, ktile, kin; size_t row, ob; };
template <int KIND>
__device__ __forceinline__ MxTok mx_decode(int wt, int tok, int l) {
    MxTok m; m.row = 0;
    if (KIND == 0) { m.row = (size_t)wt * 32 + tok; m.b = (int)(m.row >> 8); m.t = (int)(m.row & 255); m.key = m.t; }
    else if (KIND == 1) { m.row = (size_t)wt * 32 + tok; const int rs = (int)m.row - MP; m.b = rs >> 11; m.t = rs & 2047; m.key = PAST + m.t; }
    else { const int idx = (wt - 512) * 32 + tok; m.b = idx >> 9; m.t = idx & 511; m.key = m.t; }
    m.ktile = m.key >> 6; m.kin = m.key & 63; m.ob = ((size_t)m.b * 2 + l) * TP + m.t;
    return m;
}
template <int KIND>
__device__ __forceinline__ void mx_rope(int t, int hi, float (&cr)[4], float (&sr)[4], float (&cc)[4], float (&scn)[4]) {
#pragma unroll
    for (int e = 0; e < 4; ++e) { cr[e] = 1.f; sr[e] = 0.f; cc[e] = 1.f; scn[e] = 0.f; }
    if (KIND == 1) {
        const float gr = (float)(t >> 6), gc = (float)(t & 63);
#pragma unroll
        for (int e = 0; e < 4; ++e) { const float inv = exp2f(-(float)(4 * hi + e) * (13.287712379549449f / 8.0f));
            const float fr = gr * inv * 0.15915494309189535f, fc = gc * inv * 0.15915494309189535f;
            sr[e] = __builtin_amdgcn_sinf(fr); cr[e] = __builtin_amdgcn_cosf(fr); scn[e] = __builtin_amdgcn_sinf(fc); cc[e] = __builtin_amdgcn_cosf(fc); }
    }
}
template <int KIND, int SUB>
__device__ __forceinline__ void mx_a(const Ctx& C, int l, int wt) {
    const int lane = lane_id_fresh(), tok = lane & 31, hi = lane >> 5;
    constexpr int Tk = (KIND == 0) ? TP : TKS, NT = Tk / 64;
    const MxTok m = mx_decode<KIND>(wt, tok, l);
    const f16* prow = WSP(f16, WS_PROJ) + m.row * DINP;
    f16* KA = (KIND == 0) ? WSP(f16, WS_KAP) : WSP(f16, WS_KAS);
    f16* VA = (KIND == 0) ? WSP(f16, WS_VATP) : WSP(f16, WS_VATS);
    if (SUB < 2) {
        if (KIND != 2) {
            constexpr int qk = SUB;
            float cr[4], sr[4], cc[4], scn[4];
            mx_rope<KIND>(m.t, hi, cr, sr, cc, scn);
            f32x4 gain[4];
#pragma unroll
            for (int g = 0; g < 4; ++g) gain[g] = *(const f32x4*)(C.in[I_DQKN] + ((size_t)l * 2 + qk) * 32 + 8 * g + 4 * hi);
            f16x8 raw8[8][2];
#pragma unroll
            for (int hc = 0; hc < 8; ++hc)
#pragma unroll
                for (int k = 0; k < 2; ++k) raw8[hc][k] = *(const f16x8*)(prow + (qk ? PC_KA : PC_QA) + hc * 32 + 16 * k + 8 * hi);
            f16x4 raw[8][4];
#pragma unroll
            for (int hc = 0; hc < 8; ++hc)
#pragma unroll
                for (int k = 0; k < 2; ++k) unpair8(raw8[hc][k], raw[hc][2 * k], raw[hc][2 * k + 1]);
#pragma unroll
            for (int hc = 0; hc < 8; ++hc) {
                f32x4 x[4]; float ss = 0.f;
#pragma unroll
                for (int g = 0; g < 4; ++g) { x[g] = tof32(raw[hc][g]); ss += (x[g].x * x[g].x + x[g].y * x[g].y) + (x[g].z * x[g].z + x[g].w * x[g].w); }
                ss += __shfl_xor(ss, 32);
                const float rstd = 1.0f / sqrtf(ss * (1.0f / 32.0f) + EPS);
#pragma unroll
                for (int g = 0; g < 4; ++g) x[g] = x[g] * rstd * gain[g];
                if (qk == 1 && KIND == 0) {
                    float* o = C.out + OUT_DK + m.ob * 256 + hc * 32 + 4 * hi;
#pragma unroll
                    for (int g = 0; g < 4; ++g) *(f32x4*)(o + 8 * g) = x[g];
                }
                if (KIND == 1) {
#pragma unroll
                    for (int e = 0; e < 4; ++e) {
                        const float a1 = x[0][e], a2 = x[2][e]; x[0][e] = a1 * cr[e] - a2 * sr[e]; x[2][e] = a2 * cr[e] + a1 * sr[e];
                        const float b1 = x[1][e], b2 = x[3][e]; x[1][e] = b1 * cc[e] - b2 * scn[e]; x[3][e] = b2 * cc[e] + b1 * scn[e];
                    }
                }
                if (qk == 0) {
                    const float sc = 0.17677669529663687f * LOG2E;
                    f16* o = WSP(f16, WS_QA) + m.row * 256 + hc * 32 + 8 * hi;
#pragma unroll
                    for (int k = 0; k < 2; ++k) *(f16x8*)(o + 16 * k) = pair8(cvt4v(x[2 * k] * sc), cvt4v(x[2 * k + 1] * sc));
                } else {
                    f16* o = KA + ((((size_t)m.b * 4 + (hc >> 1)) * NT + m.ktile) * 8 + (hc & 1) * 4 + hi) * 512 + m.kin * 8;
#pragma unroll
                    for (int k = 0; k < 2; ++k) *(f16x8*)(o + 2 * k * 512) = pair8(cvt4v(x[2 * k]), cvt4v(x[2 * k + 1]));
                }
            }
        } else if (SUB == 1) {
            const float* ck = C.in[I_CDK] + (((size_t)m.b * 2 + l) * PAST + m.t) * 256;
            f32x4 raw[8][4];
#pragma unroll
            for (int hc = 0; hc < 8; ++hc)
#pragma unroll
                for (int g = 0; g < 4; ++g) raw[hc][g] = *(const f32x4*)(ck + hc * 32 + 4 * hi + 8 * g);
#pragma unroll
            for (int hc = 0; hc < 8; ++hc) {
                f16* o = KA + ((((size_t)m.b * 4 + (hc >> 1)) * NT + m.ktile) * 8 + (hc & 1) * 4 + hi) * 512 + m.kin * 8;
#pragma unroll
                for (int k = 0; k < 2; ++k) *(f16x8*)(o + 2 * k * 512) = pair8(cvt4v(raw[hc][2 * k]), cvt4v(raw[hc][2 * k + 1]));
            }
        }
    } else {
        if (KIND != 2) {
            f16x8 rawv[4][4];
#pragma unroll
            for (int hd = 0; hd < 4; ++hd)
#pragma unroll
                for (int j = 0; j < 4; ++j) rawv[hd][j] = *(const f16x8*)(prow + PC_VA + hd * 64 + 32 * hi + 8 * j);
#pragma unroll
            for (int hd = 0; hd < 4; ++hd) {
                f16* vt = VA + ((((size_t)m.b * 4 + hd) * NT + m.ktile) * 2 + hi) * 2048 + m.kin * 32;
#pragma unroll
                for (int j = 0; j < 4; ++j) {
                    const f16x8 v = rawv[hd][j];
                    if (KIND == 0) {
                        float* o = C.out + OUT_DV + m.ob * 256 + hd * 64 + 32 * hi + 8 * j;
                        *(f32x4*)o = (f32x4){(float)v[0], (float)v[1], (float)v[2], (float)v[3]}; *(f32x4*)(o + 4) = (f32x4){(float)v[4], (float)v[5], (float)v[6], (float)v[7]};
                    }
                    *(f16x8*)(vt + 8 * j) = v;
                }
            }
        } else {
            const float* cvp = C.in[I_CDV] + (((size_t)m.b * 2 + l) * PAST + m.t) * 256;
#pragma unroll
            for (int hd = 0; hd < 4; ++hd) {
                f16* vt = VA + ((((size_t)m.b * 4 + hd) * NT + m.ktile) * 2 + hi) * 2048 + m.kin * 32;
                f32x4 rawc[8];
#pragma unroll
                for (int j = 0; j < 8; ++j) rawc[j] = *(const f32x4*)(cvp + hd * 64 + 32 * hi + 4 * j);
#pragma unroll
                for (int j = 0; j < 8; ++j) *(f16x4*)(vt + 4 * j) = cvt4v(rawc[j]);
            }
        }
    }
}
template <int KIND>
__device__ __forceinline__ void mx_q(const Ctx& C, int l, int wt, int hd, LAS unsigned char* wl) {
    const int lane = lane_id_fresh(), tok = lane & 31, hi = lane >> 5;
    const MxTok m = mx_decode<KIND>(wt, tok, l);
    const f16* prow = WSP(f16, WS_PROJ) + m.row * DINP;
    float cr[4], sr[4], cc[4], scn[4];
    mx_rope<KIND>(m.t, hi, cr, sr, cc, scn);
    f16x8 bq[12]; float ss = 0.f;
#pragma unroll
    for (int ks = 0; ks < 12; ++ks) { bq[ks] = *(const f16x8*)(prow + PC_CQ + 16 * ks + 8 * hi);
#pragma unroll
        for (int e = 0; e < 8; ++e) { const float f = (float)bq[ks][e]; ss += f * f; } }
    ss += __shfl_xor(ss, 32);
    const float rstd = 1.0f / sqrtf(ss * (1.0f / 192.0f) + EPS);
    const float* gq = C.in[I_QKN] + ((size_t)l * 2 + 0) * 96;
    f32x4 gqv[3][4];
#pragma unroll
    for (int t3 = 0; t3 < 3; ++t3)
#pragma unroll
        for (int g = 0; g < 4; ++g) gqv[t3][g] = *(const f32x4*)(gq + 32 * t3 + 8 * g + 4 * hi);
    ATT_WAITBAR(0);
    LAS unsigned char* wp = wl + hi * 512 + tok * 16;
    f32x16 acc[3];
#pragma unroll
    for (int t3 = 0; t3 < 3; ++t3) { acc[t3] = (f32x16){};
#pragma unroll
        for (int ks = 0; ks < 12; ++ks) acc[t3] = MFMA32(*(const LAS f16x8*)(wp + (t3 * 24 + 2 * ks) * 512), bq[ks], acc[t3]); }
    float s2 = 0.f;
#pragma unroll
    for (int t3 = 0; t3 < 3; ++t3)
#pragma unroll
        for (int r = 0; r < 16; ++r) s2 += acc[t3][r] * acc[t3][r];
    s2 += __shfl_xor(s2, 32);
    const float rs = rstd / sqrtf(s2 * (rstd * rstd) * (1.0f / 96.0f) + EPS);
#pragma unroll
    for (int t3 = 0; t3 < 3; ++t3)
#pragma unroll
        for (int g = 0; g < 4; ++g) { const f32x4 gg = gqv[t3][g];
#pragma unroll
            for (int e = 0; e < 4; ++e) acc[t3][4 * g + e] *= rs * gg[e]; }
    if (KIND == 1) {
#pragma unroll
        for (int e = 0; e < 4; ++e) {
            const float a1 = acc[2][e], a2 = acc[2][8 + e]; acc[2][e] = a1 * cr[e] - a2 * sr[e]; acc[2][8 + e] = a2 * cr[e] + a1 * sr[e];
            const float b1 = acc[2][4 + e], b2 = acc[2][12 + e]; acc[2][4 + e] = b1 * cc[e] - b2 * scn[e]; acc[2][12 + e] = b2 * cc[e] + b1 * scn[e];
        }
    }
    const float sc = 0.10206207261596575f * LOG2E;
    f16* o = WSP(f16, WS_QC) + m.row * 384 + hd * 96 + 8 * hi;
#pragma unroll
    for (int t3 = 0; t3 < 3; ++t3)
#pragma unroll
        for (int k = 0; k < 2; ++k) *(f16x8*)(o + 32 * t3 + 16 * k) = pair8(cvt4(acc[t3][8 * k] * sc, acc[t3][8 * k + 1] * sc, acc[t3][8 * k + 2] * sc, acc[t3][8 * k + 3] * sc),
                                                                                     cvt4(acc[t3][8 * k + 4] * sc, acc[t3][8 * k + 5] * sc, acc[t3][8 * k + 6] * sc, acc[t3][8 * k + 7] * sc));
}
template <int KIND>
__device__ __forceinline__ void mx_kv(const Ctx& C, int l, int wt, int hd, LAS unsigned char* wl) {
    const int lane = lane_id_fresh(), tok = lane & 31, hi = lane >> 5;
    constexpr int Tk = (KIND == 0) ? TP : TKS, NT = Tk / 64;
    const MxTok m = mx_decode<KIND>(wt, tok, l);
    const f16* prow = WSP(f16, WS_PROJ) + m.row * DINP;
    f16* KC = (KIND == 0) ? WSP(f16, WS_KCP) : WSP(f16, WS_KCS);
    f16* VC = (KIND == 0) ? WSP(f16, WS_VCTP) : WSP(f16, WS_VCTS);
    float cr[4], sr[4], cc[4], scn[4];
    mx_rope<KIND>(m.t, hi, cr, sr, cc, scn);
    f16x8 bk[8]; f32x4 kr[4]; float rstd = 1.0f;
    if (KIND != 2) {
        float ss = 0.f;
#pragma unroll
        for (int ks = 0; ks < 8; ++ks) { bk[ks] = *(const f16x8*)(prow + PC_CKV + 16 * ks + 8 * hi);
#pragma unroll
            for (int e = 0; e < 8; ++e) { const float f = (float)bk[ks][e]; ss += f * f; } }
        ss += __shfl_xor(ss, 32);
        rstd = 1.0f / sqrtf(ss * (1.0f / 128.0f) + EPS);
        if (KIND == 0 && hd == 0) {
            f32x4 gv0[8], gv1[8];
#pragma unroll
            for (int ks = 0; ks < 8; ++ks) { gv0[ks] = *(const f32x4*)(C.in[I_CKVN] + (size_t)l * 128 + 16 * ks + 8 * hi); gv1[ks] = *(const f32x4*)(C.in[I_CKVN] + (size_t)l * 128 + 16 * ks + 8 * hi + 4); }
#pragma unroll
            for (int ks = 0; ks < 8; ++ks) {
                const f32x4 g0 = gv0[ks], g1 = gv1[ks];
                const f16x8 v = bk[ks];
                float* o = C.out + OUT_CKV + m.ob * 128 + 16 * ks + 8 * hi;
                *(f32x4*)o = (f32x4){(float)v[0] * rstd * g0[0], (float)v[1] * rstd * g0[1], (float)v[2] * rstd * g0[2], (float)v[3] * rstd * g0[3]};
                *(f32x4*)(o + 4) = (f32x4){(float)v[4] * rstd * g1[0], (float)v[5] * rstd * g1[1], (float)v[6] * rstd * g1[2], (float)v[7] * rstd * g1[3]};
            }
        }
#pragma unroll
        for (int g = 0; g < 4; ++g) kr[g] = tof32(*(const f16x4*)(prow + PC_KR + 8 * g + 4 * hi));
        if (KIND == 0 && hd == 0) { float* o = C.out + OUT_KR + m.ob * 32 + 4 * hi;
#pragma unroll
            for (int g = 0; g < 4; ++g) *(f32x4*)(o + 8 * g) = kr[g]; }
    } else {
        const float* cp = C.in[I_CCKV] + (((size_t)m.b * 2 + l) * PAST + m.t) * 128;
#pragma unroll
        for (int ks = 0; ks < 8; ++ks) bk[ks] = pack8(cvt4v(*(const f32x4*)(cp + 16 * ks + 8 * hi)), cvt4v(*(const f32x4*)(cp + 16 * ks + 8 * hi + 4)));
        const float* kp = C.in[I_CKR] + (((size_t)m.b * 2 + l) * PAST + m.t) * 32;
#pragma unroll
        for (int g = 0; g < 4; ++g) kr[g] = *(const f32x4*)(kp + 8 * g + 4 * hi);
    }
    float skr = 0.f;
#pragma unroll
    for (int g = 0; g < 4; ++g) skr += (kr[g].x * kr[g].x + kr[g].y * kr[g].y) + (kr[g].z * kr[g].z + kr[g].w * kr[g].w);
    const float* gk = C.in[I_QKN] + ((size_t)l * 2 + 1) * 96;
    f32x4 gkv[3][4];
#pragma unroll
    for (int t3 = 0; t3 < 3; ++t3)
#pragma unroll
        for (int g = 0; g < 4; ++g) gkv[t3][g] = *(const f32x4*)(gk + 32 * t3 + 8 * g + 4 * hi);
    ATT_WAITBAR(0);
    LAS unsigned char* wp = wl + hi * 512 + tok * 16;
    f32x16 acc[2];
#pragma unroll
    for (int t4 = 0; t4 < 2; ++t4) { acc[t4] = (f32x16){};
#pragma unroll
        for (int ks = 0; ks < 8; ++ks) acc[t4] = MFMA32(*(const LAS f16x8*)(wp + (t4 * 16 + 2 * ks) * 512), bk[ks], acc[t4]); }
    float s2 = 0.f;
#pragma unroll
    for (int t4 = 0; t4 < 2; ++t4)
#pragma unroll
        for (int r = 0; r < 16; ++r) s2 += acc[t4][r] * acc[t4][r];
    s2 = s2 * (rstd * rstd) + skr;
    s2 += __shfl_xor(s2, 32);
    const float rs = 1.0f / sqrtf(s2 * (1.0f / 96.0f) + EPS), rsn = rs * rstd;
    f16* ko = KC + ((((size_t)m.b * 4 + hd) * NT + m.ktile) * 12 + hi) * 512 + m.kin * 8;
#pragma unroll
    for (int t4 = 0; t4 < 2; ++t4)
#pragma unroll
        for (int k = 0; k < 2; ++k) { const f32x4 ga = gkv[t4][2 * k], gb = gkv[t4][2 * k + 1];
            *(f16x8*)(ko + (4 * t4 + 2 * k) * 512) = pair8(cvt4(acc[t4][8 * k] * rsn * ga[0], acc[t4][8 * k + 1] * rsn * ga[1], acc[t4][8 * k + 2] * rsn * ga[2], acc[t4][8 * k + 3] * rsn * ga[3]),
                                                             cvt4(acc[t4][8 * k + 4] * rsn * gb[0], acc[t4][8 * k + 5] * rsn * gb[1], acc[t4][8 * k + 6] * rsn * gb[2], acc[t4][8 * k + 7] * rsn * gb[3])); }
    f32x4 kn[4];
#pragma unroll
    for (int g = 0; g < 4; ++g) kn[g] = kr[g] * rs * gkv[2][g];
    if (KIND == 1) {
#pragma unroll
        for (int e = 0; e < 4; ++e) {
            const float a1 = kn[0][e], a2 = kn[2][e]; kn[0][e] = a1 * cr[e] - a2 * sr[e]; kn[2][e] = a2 * cr[e] + a1 * sr[e];
            const float b1 = kn[1][e], b2 = kn[3][e]; kn[1][e] = b1 * cc[e] - b2 * scn[e]; kn[3][e] = b2 * cc[e] + b1 * scn[e];
        }
    }
#pragma unroll
    for (int k = 0; k < 2; ++k) *(f16x8*)(ko + (8 + 2 * k) * 512) = pair8(cvt4v(kn[2 * k]), cvt4v(kn[2 * k + 1]));
    f16* vo = VC + ((((size_t)m.b * 4 + hd) * NT + m.ktile) * 2) * 2048 + m.kin * 32 + 8 * hi;
#pragma unroll
    for (int t4 = 2; t4 < 4; ++t4) {
        f32x16 av = (f32x16){};
#pragma unroll
        for (int ks = 0; ks < 8; ++ks) av = MFMA32(*(const LAS f16x8*)(wp + (t4 * 16 + 2 * ks) * 512), bk[ks], av);
#pragma unroll
        for (int k = 0; k < 2; ++k) *(f16x8*)(vo + (t4 - 2) * 2048 + 16 * k) = pair8(cvt4(av[8 * k] * rstd, av[8 * k + 1] * rstd, av[8 * k + 2] * rstd, av[8 * k + 3] * rstd),
                                                                                        cvt4(av[8 * k + 4] * rstd, av[8 * k + 5] * rstd, av[8 * k + 6] * rstd, av[8 * k + 7] * rstd));
    }
}

template <int DIR, bool PASS2>
__device__ __forceinline__ void lru_dir(const Ctx& C, int l, int ch, int n, const f16x8 (&bx)[2][4], int b, int T, int cidx, int seqch0, bool prompt, int row0, int lane) {
    const int l31 = lane & 31, hi = lane >> 5;
    const f16* wg = WSP(f16, WS_WG);
    const f16* PROJ = WSP(f16, WS_PROJ);
    float* SUM = WSP(float, WS_SUM);
    f16* OC = WSP(f16, WS_OCAT);
    const int nch = T >> 6;
    f16x8 w0a[2][4], w1a[2][4];
#pragma unroll
    for (int t2 = 0; t2 < 2; ++t2)
#pragma unroll
        for (int ks = 0; ks < 4; ++ks) {
            w0a[t2][ks] = *(const f16x8*)(wg + ((((size_t)(l * 2 + DIR) * 2 + 0) * 8 + n) * 64 + 32 * t2 + l31) * 64 + 16 * ks + 8 * hi);
            w1a[t2][ks] = *(const f16x8*)(wg + ((((size_t)(l * 2 + DIR) * 2 + 1) * 8 + n) * 64 + 32 * t2 + l31) * 64 + 16 * ks + 8 * hi);
        }
    f16x8 idn0[4];
#pragma unroll
    for (int ks = 0; ks < 4; ++ks) idn0[ks] = *(const f16x8*)(WSP(f16, WS_IDN) + (size_t)l31 * 64 + 16 * ks + 8 * hi);
    float bg0[2], bg1[2], spl[2], hc[2], At[2], Bt[2];
#pragma unroll
    for (int t2 = 0; t2 < 2; ++t2) {
        const int chn = 64 * n + 32 * t2 + l31;
        bg0[t2] = -LOG2E * C.in[I_BGATE][((size_t)(l * 2 + DIR) * 2 + 0) * 512 + chn]; bg1[t2] = -LOG2E * C.in[I_BGATE][((size_t)(l * 2 + DIR) * 2 + 1) * 512 + chn];
        spl[t2] = -8.0f * LOG2E * log1pf(__expf(-C.in[I_LLAM][(size_t)(l * 2 + DIR) * 512 + chn]));
        At[t2] = 1.0f; Bt[t2] = 0.0f; hc[t2] = 0.0f;
    }
    if (PASS2) {
        const int cnt = (DIR == 0) ? cidx : (nch - 1 - cidx), m = (cnt + 1) >> 1;
        const int lo = hi ? m : 0, up = hi ? cnt : m;
        float A0 = 1.f, B0 = 0.f, A1 = 1.f, B1 = 0.f;
#pragma unroll 1
        for (int ib = lo; ib < up; ib += 8) {
            float a0[8], b0[8], a1[8], b1[8];
#pragma unroll
            for (int k = 0; k < 8; ++k) {
                const int i = (ib + k < up) ? ib + k : up - 1, j = (DIR == 0) ? i : (nch - 1 - i);
                const float* p = SUM + ((((size_t)(seqch0 + j)) * 8 + n) * 2 + DIR) * 128 + l31;
                a0[k] = p[0]; b0[k] = p[64]; a1[k] = p[32]; b1[k] = p[96];
            }
#pragma unroll
            for (int k = 0; k < 8; ++k) if (ib + k < up) { B0 = a0[k] * B0 + b0[k]; A0 *= a0[k]; B1 = a1[k] * B1 + b1[k]; A1 *= a1[k]; }
        }
        {
            const float pa0 = __shfl_xor(A0, 32), pb0 = __shfl_xor(B0, 32), pa1 = __shfl_xor(A1, 32), pb1 = __shfl_xor(B1, 32);
            const float fa0 = hi ? pa0 : A0, fb0 = hi ? pb0 : B0, sa0 = hi ? A0 : pa0, sb0 = hi ? B0 : pb0;
            const float fa1 = hi ? pa1 : A1, fb1 = hi ? pb1 : B1, sa1 = hi ? A1 : pa1, sb1 = hi ? B1 : pb1;
            float h00 = 0.f, h01 = 0.f;
            if (!prompt) { const float* st = C.in[I_ST] + (((size_t)b * 2 + l) * 2 + DIR) * 512 + 64 * n + l31; h00 = st[0]; h01 = st[32]; }
            hc[0] = sa0 * (fa0 * h00 + fb0) + sb0; hc[1] = sa1 * (fa1 * h01 + fb1) + sb1;
        }
    }
    const f16* idp = WSP(f16, WS_IDN);
    __builtin_amdgcn_sched_barrier(0);
#pragma unroll
    for (int t2 = 0; t2 < 2; ++t2) {
        f16x8 w0[4], w1[4], idn[4];
#pragma unroll
        for (int ks = 0; ks < 4; ++ks) { w0[ks] = w0a[t2][ks]; w1[ks] = w1a[t2][ks]; idn[ks] = (t2 == 0) ? idn0[ks] : *(const f16x8*)(idp + (32 * t2 + l31) * 64 + 16 * ks + 8 * hi); }
#pragma unroll
        for (int sci = 0; sci < 2; ++sci) {
            const int sc = DIR ? 1 - sci : sci;
            f32x16 g0 = (f32x16){}, g1 = (f32x16){}, X = (f32x16){}; f16x8 vq[4];
#pragma unroll
            for (int ks = 0; ks < 4; ++ks) { g0 = MFMA32(bx[sc][ks], w0[ks], g0); g1 = MFMA32(bx[sc][ks], w1[ks], g1); X = MFMA32(bx[sc][ks], idn[ks], X); }
#pragma unroll
            for (int r = 0; r < 16; ++r) {
                const float rr = frcp(1.0f + fexp2(g0[r] + bg0[t2])), ii = frcp(1.0f + fexp2(g1[r] + bg1[t2]));
                const float v = rr * spl[t2], a = fexp2(v);
                g0[r] = a; g1[r] = __builtin_amdgcn_sqrtf(__builtin_fmaf(-a, a, 1.0f)) * (ii * X[r]);
                vq[r >> 3][r & 7] = (f16)v; vq[2 + (r >> 3)][r & 7] = (f16)g1[r];
            }
            {
                f16x8* vb = WSP(f16x8, WS_VB) + ((size_t)(ch * 8 + n) * 32 + ((DIR * 2 + t2) * 2 + sc) * 4) * 64 + lane;
#pragma unroll
                for (int k = 0; k < 4; ++k) vb[k * 64] = vq[k];
            }
            float As[4], Bs[4], Ap[4], Bp[4];
#pragma unroll
            for (int g = 0; g < 4; ++g) {
                float pa = 1.f, pb = 0.f;
#pragma unroll
                for (int ee = 0; ee < 4; ++ee) { const int e = DIR ? 3 - ee : ee; pb = g0[4 * g + e] * pb + g1[4 * g + e]; pa *= g0[4 * g + e]; }
                As[g] = pa; Bs[g] = pb; Ap[g] = __shfl_xor(pa, 32); Bp[g] = __shfl_xor(pb, 32);
            }
            float h = hc[t2];
#pragma unroll
            for (int gi = 0; gi < 4; ++gi) {
                const int g = DIR ? 3 - gi : gi;
                const bool mine_first = DIR ? (hi == 1) : (hi == 0);
                const float fa = mine_first ? As[g] : Ap[g], fb = mine_first ? Bs[g] : Bp[g], sa = mine_first ? Ap[g] : As[g], sb = mine_first ? Bp[g] : Bs[g];
                const float mid = fa * h + fb;
                float hh = mine_first ? h : mid;
                if (PASS2) {
#pragma unroll
                    for (int ee = 0; ee < 4; ++ee) { const int e = DIR ? 3 - ee : ee; hh = g0[4 * g + e] * hh + g1[4 * g + e]; g1[4 * g + e] = hh; }
                }
                h = sa * mid + sb;
                if (!PASS2) { Bt[t2] = sa * (fa * Bt[t2] + fb) + sb; At[t2] *= fa * sa; }
            }
            hc[t2] = h;
            if (PASS2) {
                LAS f16* op = (LAS f16*)(C.lds + C.wave * 16384) + (32 * sc + 4 * hi) * 64 + 32 * t2 + l31;
                if (DIR == 0) {
#pragma unroll
                    for (int r = 0; r < 16; ++r) op[((r & 3) + 8 * (r >> 2)) * 64] = (f16)g1[r];
                } else {
                    f32x16 G = (f32x16){};
#pragma unroll
                    for (int ks = 0; ks < 4; ++ks) {
                        const f16x8 gbf = *(const f16x8*)(PROJ + (size_t)(row0 + 32 * sc + l31) * DINP + PC_GB + 64 * n + 16 * ks + 8 * hi);
                        G = MFMA32(gbf, idn[ks], G);
                    }
                    float hfv[16];
#pragma unroll
                    for (int r = 0; r < 16; ++r) hfv[r] = (float)op[((r & 3) + 8 * (r >> 2)) * 64];
#pragma unroll
                    for (int r = 0; r < 16; ++r) {
                        LAS f16* q = op + ((r & 3) + 8 * (r >> 2)) * 64;
                        const float hf = hfv[r];
                        const float x = G[r], u = 0.7978845608028654f * (x + 0.044715f * x * x * x);
                        const float th = 1.0f - 2.0f * frcp(1.0f + fexp2(2.0f * u * LOG2E));
                        *q = (f16)((hf + g1[r]) * (0.5f * x * (1.0f + th)));
                    }
                }
            }
            FENCE(); __builtin_amdgcn_sched_barrier(0);
        }
    }
    if (!PASS2) {
        if (hi == 0) { float* sa = SUM + ((((size_t)ch) * 8 + n) * 2 + DIR) * 128 + l31; sa[0] = At[0]; sa[64] = Bt[0]; sa[32] = At[1]; sa[96] = Bt[1]; }
    } else if (prompt) {
        const bool fin = (DIR == 0) ? (cidx == nch - 1) : (cidx == 0);
        if (fin && hi == 0) { float* o = C.out + OUT_ST + (((size_t)b * 2 + l) * 2 + DIR) * 512 + 64 * n + l31; o[0] = hc[0]; o[32] = hc[1]; }
    }
}
template <int DIR>
__device__ __forceinline__ void lru2_dir(const Ctx& C, int l, int ch, int n, int b, int T, int cidx, int seqch0, bool prompt, int lane) {
    const int l31 = lane & 31, hi = lane >> 5;
    float* SUM = WSP(float, WS_SUM);
    const int nch = T >> 6;
    const f16x8* vbp = WSP(f16x8, WS_VB) + ((size_t)(ch * 8 + n) * 32 + DIR * 16) * 64 + lane;
    f16x8 q[4][4];
#pragma unroll
    for (int bl = 0; bl < 4; ++bl)
#pragma unroll
        for (int k = 0; k < 4; ++k) q[bl][k] = vbp[(bl * 4 + k) * 64];
    if (DIR == 0) {
        const f16* gp = WSP(f16, WS_PROJ) + (size_t)(ch * 64 + (lane >> 3)) * DINP + PC_GB + 64 * n + (lane & 7) * 8;
        f16x8 gv[8];
#pragma unroll
        for (int i = 0; i < 8; ++i) gv[i] = *(const f16x8*)(gp + (size_t)(8 * i) * DINP);
#pragma unroll
        for (int i = 0; i < 8; ++i) {
            f16x8 o;
#pragma unroll
            for (int e = 0; e < 8; ++e) {
                const float x = (float)gv[i][e], u = 0.7978845608028654f * (x + 0.044715f * x * x * x);
                const float th = 1.0f - 2.0f * frcp(1.0f + fexp2(2.0f * u * LOG2E));
                o[e] = (f16)(0.5f * x * (1.0f + th));
            }
            *(LAS f16x8*)(C.lds + C.wave * 16384 + 8192 + (8 * i + (lane >> 3)) * 128 + (lane & 7) * 16) = o;
        }
    }
    float hc[2];
    {
        const int cnt = (DIR == 0) ? cidx : (nch - 1 - cidx), m = (cnt + 1) >> 1;
        const int lo = hi ? m : 0, up = hi ? cnt : m;
        float A0 = 1.f, B0 = 0.f, A1 = 1.f, B1 = 0.f;
#pragma unroll 1
        for (int ib = lo; ib < up; ib += 8) {
            float a0[8], b0[8], a1[8], b1[8];
#pragma unroll
            for (int k = 0; k < 8; ++k) {
                const int i = (ib + k < up) ? ib + k : up - 1, j = (DIR == 0) ? i : (nch - 1 - i);
                const float* p = SUM + ((((size_t)(seqch0 + j)) * 8 + n) * 2 + DIR) * 128 + l31;
                a0[k] = p[0]; b0[k] = p[64]; a1[k] = p[32]; b1[k] = p[96];
            }
#pragma unroll
            for (int k = 0; k < 8; ++k) if (ib + k < up) { B0 = a0[k] * B0 + b0[k]; A0 *= a0[k]; B1 = a1[k] * B1 + b1[k]; A1 *= a1[k]; }
        }
        const float pa0 = __shfl_xor(A0, 32), pb0 = __shfl_xor(B0, 32), pa1 = __shfl_xor(A1, 32), pb1 = __shfl_xor(B1, 32);
        const float fa0 = hi ? pa0 : A0, fb0 = hi ? pb0 : B0, sa0 = hi ? A0 : pa0, sb0 = hi ? B0 : pb0;
        const float fa1 = hi ? pa1 : A1, fb1 = hi ? pb1 : B1, sa1 = hi ? A1 : pa1, sb1 = hi ? B1 : pb1;
        float h00 = 0.f, h01 = 0.f;
        if (!prompt) { const float* st = C.in[I_ST] + (((size_t)b * 2 + l) * 2 + DIR) * 512 + 64 * n + l31; h00 = st[0]; h01 = st[32]; }
        hc[0] = sa0 * (fa0 * h00 + fb0) + sb0; hc[1] = sa1 * (fa1 * h01 + fb1) + sb1;
    }
#pragma unroll
    for (int t2 = 0; t2 < 2; ++t2) {
#pragma unroll
        for (int sci = 0; sci < 2; ++sci) {
            const int sc = DIR ? 1 - sci : sci, bl = t2 * 2 + sc;
            float g0[16], g1[16];
#pragma unroll
            for (int r = 0; r < 8; ++r) { g0[r] = fexp2((float)q[bl][0][r]); g0[8 + r] = fexp2((float)q[bl][1][r]); g1[r] = (float)q[bl][2][r]; g1[8 + r] = (float)q[bl][3][r]; }
            float As[4], Bs[4], Ap[4], Bp[4];
#pragma unroll
            for (int g = 0; g < 4; ++g) {
                float pa = 1.f, pb = 0.f;
#pragma unroll
                for (int ee = 0; ee < 4; ++ee) { const int e = DIR ? 3 - ee : ee; pb = g0[4 * g + e] * pb + g1[4 * g + e]; pa *= g0[4 * g + e]; }
                As[g] = pa; Bs[g] = pb; Ap[g] = __shfl_xor(pa, 32); Bp[g] = __shfl_xor(pb, 32);
            }
            float h = hc[t2];
#pragma unroll
            for (int gi = 0; gi < 4; ++gi) {
                const int g = DIR ? 3 - gi : gi;
                const bool mine_first = DIR ? (hi == 1) : (hi == 0);
                const float fa = mine_first ? As[g] : Ap[g], fb = mine_first ? Bs[g] : Bp[g], sa = mine_first ? Ap[g] : As[g], sb = mine_first ? Bp[g] : Bs[g];
                const float mid = fa * h + fb;
                float hh = mine_first ? h : mid;
#pragma unroll
                for (int ee = 0; ee < 4; ++ee) { const int e = DIR ? 3 - ee : ee; hh = g0[4 * g + e] * hh + g1[4 * g + e]; g1[4 * g + e] = hh; }
                h = sa * mid + sb;
            }
            hc[t2] = h;
            LAS f16* op = (LAS f16*)(C.lds + C.wave * 16384) + (32 * sc + 4 * hi) * 64 + 32 * t2 + l31;
            if (DIR == 0) {
#pragma unroll
                for (int r = 0; r < 16; ++r) op[((r & 3) + 8 * (r >> 2)) * 64] = (f16)g1[r];
            } else {
                float hfv[16], gtv[16];
#pragma unroll
                for (int r = 0; r < 16; ++r) { hfv[r] = (float)op[((r & 3) + 8 * (r >> 2)) * 64]; gtv[r] = (float)op[4096 + ((r & 3) + 8 * (r >> 2)) * 64]; }
#pragma unroll
                for (int r = 0; r < 16; ++r) op[((r & 3) + 8 * (r >> 2)) * 64] = (f16)((hfv[r] + g1[r]) * gtv[r]);
            }
            FENCE();
        }
    }
    if (prompt) {
        const bool fin = (DIR == 0) ? (cidx == nch - 1) : (cidx == 0);
        if (fin && hi == 0) { float* o = C.out + OUT_ST + (((size_t)b * 2 + l) * 2 + DIR) * 512 + 64 * n + l31; o[0] = hc[0]; o[32] = hc[1]; }
    }
}
__device__ __forceinline__ void lru2_item(const Ctx& C, int l, int ch, int n) {
    const int lane = lane_id_fresh();
    const int row0 = ch * 64;
    const bool prompt = row0 < MP;
    int b, t0, T, seqrow0;
    if (prompt) { b = row0 >> 8; t0 = row0 & 255; T = TP; seqrow0 = b * TP; } else { const int rs = row0 - MP; b = rs >> 11; t0 = rs & 2047; T = TS; seqrow0 = MP + b * TS; }
    const int cidx = t0 >> 6, seqch0 = seqrow0 >> 6;
    lru2_dir<0>(C, l, ch, n, b, T, cidx, seqch0, prompt, lane);
    FENCE(); __builtin_amdgcn_sched_barrier(0);
    lru2_dir<1>(C, l, ch, n, b, T, cidx, seqch0, prompt, lane);
    FENCE(); asm volatile("s_waitcnt lgkmcnt(0)" ::: "memory");
    const LAS unsigned char* tl = C.lds + C.wave * 16384;
    f16* oc = WSP(f16, WS_OCAT) + (size_t)row0 * DM + 256 + 64 * n;
    f16x8 ov[8];
#pragma unroll
    for (int i = 0; i < 8; ++i) ov[i] = *(const LAS f16x8*)(tl + (8 * i + (lane >> 3)) * 128 + (lane & 7) * 16);
#pragma unroll
    for (int i = 0; i < 8; ++i) *(f16x8*)(oc + (size_t)(8 * i + (lane >> 3)) * DM + (lane & 7) * 8) = ov[i];
    asm volatile("s_waitcnt lgkmcnt(0)" ::: "memory"); FENCE();
}
template <bool PASS2>
__device__ __forceinline__ void lru_item(const Ctx& C, int l, int ch, int n) {
    const int lane = lane_id_fresh(), l31 = lane & 31, hi = lane >> 5;
    const f16* PROJ = WSP(f16, WS_PROJ);
    const int row0 = ch * 64;
    const bool prompt = row0 < MP;
    int b, t0, T, seqrow0;
    if (prompt) { b = row0 >> 8; t0 = row0 & 255; T = TP; seqrow0 = b * TP; } else { const int rs = row0 - MP; b = rs >> 11; t0 = rs & 2047; T = TS; seqrow0 = MP + b * TS; }
    const int cidx = t0 >> 6, seqch0 = seqrow0 >> 6;
    f16x8 bx[2][4];
    f16x8* xcbuf = WSP(f16x8, WS_XC) + ((size_t)(ch * 8 + n) * 8) * 64 + lane;
    if (PASS2) {
#pragma unroll
        for (int sc = 0; sc < 2; ++sc)
#pragma unroll
            for (int ks = 0; ks < 4; ++ks) bx[sc][ks] = xcbuf[(sc * 4 + ks) * 64];
    } else
#pragma unroll
    for (int kp = 0; kp < 2; ++kp) {
        int chb = 64 * n + 32 * kp + 8 * hi; asm volatile("" : "+v"(chb));
        f32x4 w0[2][4], w1[2][4], c0[2], c1[2]; f16x8 v[2][2][4]; float wm[2][4];
#pragma unroll
        for (int q = 0; q < 2; ++q) {
            const int chn = chb + 16 * q;
#pragma unroll
            for (int j = 0; j < 4; ++j) { w0[q][j] = *(const f32x4*)(C.in[I_CONVW] + ((size_t)l * 4 + j) * 512 + chn); w1[q][j] = *(const f32x4*)(C.in[I_CONVW] + ((size_t)l * 4 + j) * 512 + chn + 4); }
            c0[q] = *(const f32x4*)(C.in[I_CONVB] + (size_t)l * 512 + chn); c1[q] = *(const f32x4*)(C.in[I_CONVB] + (size_t)l * 512 + chn + 4);
#pragma unroll
            for (int sc = 0; sc < 2; ++sc) {
                const int t = t0 + 32 * sc + l31;
#pragma unroll
                for (int j = 0; j < 4; ++j) { const int tt = t + j - 2; const bool ok = (tt >= 0 && tt < T); if (q == 0) wm[sc][j] = ok ? 1.0f : 0.0f;
                    v[q][sc][j] = *(const f16x8*)(PROJ + (size_t)(seqrow0 + (ok ? tt : t)) * DINP + PC_XB + chn); }
            }
        }
        __builtin_amdgcn_sched_barrier(0);
#pragma unroll
        for (int q = 0; q < 2; ++q)
#pragma unroll
            for (int sc = 0; sc < 2; ++sc) {
                f32x4 a0 = c0[q], a1 = c1[q];
#pragma unroll
                for (int j = 0; j < 4; ++j) { a0 += (w0[q][j] * wm[sc][j]) * (f32x4){(float)v[q][sc][j][0], (float)v[q][sc][j][1], (float)v[q][sc][j][2], (float)v[q][sc][j][3]};
                                              a1 += (w1[q][j] * wm[sc][j]) * (f32x4){(float)v[q][sc][j][4], (float)v[q][sc][j][5], (float)v[q][sc][j][6], (float)v[q][sc][j][7]}; }
                bx[sc][2 * kp + q] = pack8(cvt4v(a0), cvt4v(a1));
            }
        FENCE(); __builtin_amdgcn_sched_barrier(0);
    }
    __builtin_amdgcn_sched_barrier(0);
    lru_dir<0, PASS2>(C, l, ch, n, bx, b, T, cidx, seqch0, prompt, row0, lane);
    FENCE(); __builtin_amdgcn_sched_barrier(0);
    lru_dir<1, PASS2>(C, l, ch, n, bx, b, T, cidx, seqch0, prompt, row0, lane);
    if (PASS2) {
        FENCE(); asm volatile("s_waitcnt lgkmcnt(0)" ::: "memory");
        const LAS unsigned char* tl = C.lds + C.wave * 16384;
        f16* oc = WSP(f16, WS_OCAT) + (size_t)row0 * DM + 256 + 64 * n;
        f16x8 ov[8];
#pragma unroll
        for (int i = 0; i < 8; ++i) ov[i] = *(const LAS f16x8*)(tl + (8 * i + (lane >> 3)) * 128 + (lane & 7) * 16);
#pragma unroll
        for (int i = 0; i < 8; ++i) *(f16x8*)(oc + (size_t)(8 * i + (lane >> 3)) * DM + (lane & 7) * 8) = ov[i];
        asm volatile("s_waitcnt lgkmcnt(0)" ::: "memory"); FENCE();
    }
}

constexpr int ATT_SLOT = 20480, ATT_VOFF = 12288;
constexpr float ATT_THR = 8.0f;
typedef short v4i16_t __attribute__((ext_vector_type(4)));
__device__ __forceinline__ f16x4 lds_tr(LAS unsigned char* p) { return __builtin_bit_cast(f16x4, __builtin_amdgcn_ds_read_tr16_b64_v4i16((LAS v4i16_t*)p)); }
template <int TYPE>
__device__ __forceinline__ void attn_unit(const Ctx& C, int l, int kind, int b, int hd, int qblk) {
    const int lane = lane_id_fresh(), tok = lane & 31, hi = lane >> 5, wid = C.wave;
    constexpr int NC = TYPE ? 12 : 8, KTILE = NC * 512;
    const int Tk = kind ? TKS : TP, NT = Tk >> 6;
    const size_t row = (kind ? (size_t)MP + (size_t)b * TS : (size_t)b * TP) + 256 * qblk + 32 * wid + tok;
    const f16* Kimg = (TYPE ? (kind ? WSP(f16, WS_KCS) : WSP(f16, WS_KCP)) : (kind ? WSP(f16, WS_KAS) : WSP(f16, WS_KAP))) + ((size_t)b * 4 + hd) * NT * KTILE + lane * 8;
    const f16* Vimg = (TYPE ? (kind ? WSP(f16, WS_VCTS) : WSP(f16, WS_VCTP)) : (kind ? WSP(f16, WS_VATS) : WSP(f16, WS_VATP))) + ((size_t)b * 4 + hd) * NT * 4096 + wid * 512 + lane * 8;
    LAS unsigned char* lds = C.lds;
    const bool two = (TYPE == 1) && (wid < 4);
#define ATT_DMA(t, sl) do { const f16* kt_ = Kimg + (size_t)(t) * KTILE; LAS unsigned char* ls_ = lds + (sl) * ATT_SLOT; \
        ATT_GLDS(kt_ + wid * 512, ls_ + wid * 1024); if (two) ATT_GLDS(kt_ + (8 + wid) * 512, ls_ + (8 + wid) * 1024); \
        ATT_GLDS(Vimg + (size_t)(t) * 4096, ls_ + ATT_VOFF + wid * 1024); } while (0)
    f16x8 bq[TYPE ? 6 : 4];
    if (TYPE) {
#pragma unroll
        for (int ks = 0; ks < 6; ++ks) bq[ks] = *(const f16x8*)(WSP(f16, WS_QC) + row * 384 + hd * 96 + 16 * ks + 8 * hi);
    } else {
#pragma unroll
        for (int i = 0; i < 4; ++i) bq[i] = *(const f16x8*)(WSP(f16, WS_QA) + row * 256 + hd * 64 + 16 * i + 8 * hi);
    }
    float lam = 0.f, lam_init = 0.f;
    if (TYPE == 0) {
        const float* lp = C.in[I_DLAM] + (size_t)l * 128;
        float s1 = 0.f, s2 = 0.f;
#pragma unroll 4
        for (int i = 0; i < 32; ++i) { s1 += lp[i] * lp[32 + i]; s2 += lp[64 + i] * lp[96 + i]; }
        lam_init = 0.8f - 0.6f * expf(-0.3f * (float)l);
        lam = expf(s1) - expf(s2) + lam_init;
    }
#pragma unroll
    for (int i = 0; i < (TYPE ? 6 : 4); ++i) asm volatile("" : "+v"(bq[i]));
    asm volatile("" : "+v"(lam), "+v"(lam_init));
    ATT_DMA(0, 0); ATT_DMA(1, 1);
    if (two) { ATT_WAITBAR(3); } else { ATT_WAITBAR(2); }
    f32x16 nM0 = (f32x16){}, nM1 = (f32x16){};
    float l0 = 0.f, l1 = 0.f;
    f32x16 O0[2], O1[2]; O0[0] = (f32x16){}; O0[1] = (f32x16){}; O1[0] = (f32x16){}; O1[1] = (f32x16){};
    int s_cur = 0, s_nx2 = 2;
    LAS unsigned char* vb0 = lds + ATT_VOFF + (4 * hi + ((lane & 15) >> 2)) * 64 + ((lane >> 4) & 1) * 32 + (lane & 3) * 8;
    LAS unsigned char* kb0 = lds + hi * 1024 + tok * 16;
#pragma unroll 1
    for (int t = 0; t < NT; ++t) {
        if (t + 2 < NT) ATT_DMA(t + 2, s_nx2);
        LAS unsigned char* kb = kb0 + s_cur * ATT_SLOT; LAS unsigned char* vb = vb0 + s_cur * ATT_SLOT;
        f16x8 pf[TYPE ? 1 : 2][2][2];
#pragma unroll
        for (int c = 0; c < (TYPE ? 1 : 2); ++c) {
            f32x16 S[2];
            float ps;
#define ATT_QK() do { f16x8 kf[2][TYPE ? 6 : 2]; \
                _Pragma("unroll") for (int sub = 0; sub < 2; ++sub) _Pragma("unroll") for (int ks = 0; ks < (TYPE ? 6 : 2); ++ks) kf[sub][ks] = *(const LAS f16x8*)(kb + c * 4096 + ks * 2048 + sub * 512); \
                __builtin_amdgcn_sched_barrier(0); \
                _Pragma("unroll") for (int sub = 0; sub < 2; ++sub) { S[sub] = c ? nM1 : nM0; \
                    _Pragma("unroll") for (int ks = 0; ks < (TYPE ? 6 : 2); ++ks) S[sub] = MFMA32(kf[sub][ks], bq[c * 2 + ks], S[sub]); } \
                __builtin_amdgcn_sched_barrier(0); } while (0)
#define ATT_EXPSUM() do { ps = 0.f; \
                _Pragma("unroll") for (int sub = 0; sub < 2; ++sub) _Pragma("unroll") for (int r = 0; r < 16; ++r) { S[sub][r] = fexp2(S[sub][r]); ps += S[sub][r]; } } while (0)
            ATT_QK();
            ATT_EXPSUM();
            if (t == 0 || __any(!(ps <= 32768.0f))) {
                ATT_QK();
                float ma = fmaxf(fmaxf(S[0][0], S[0][1]), S[1][0]), mb = fmaxf(fmaxf(S[0][2], S[0][3]), S[1][1]);
                ma = fmaxf(fmaxf(ma, S[1][2]), S[1][3]);
#pragma unroll
                for (int r = 4; r < 16; r += 4) { ma = fmaxf(fmaxf(ma, S[0][r]), S[0][r + 1]); mb = fmaxf(fmaxf(mb, S[0][r + 2]), S[0][r + 3]); ma = fmaxf(fmaxf(ma, S[1][r]), S[1][r + 1]); mb = fmaxf(fmaxf(mb, S[1][r + 2]), S[1][r + 3]); }
                float rm = fmaxf(ma, mb); rm = fmaxf(rm, __shfl_xor(rm, 32));
                const float dl = (t == 0) ? rm : fmaxf(rm, 0.f), f = (t == 0) ? 1.0f : fexp2(-dl);
#pragma unroll
                for (int sub = 0; sub < 2; ++sub)
#pragma unroll
                    for (int r = 0; r < 16; ++r) S[sub][r] -= dl;
                if (c == 0) {
#pragma unroll
                    for (int r = 0; r < 16; ++r) { nM0[r] -= dl; O0[0][r] *= f; O0[1][r] *= f; } l0 *= f;
                } else {
#pragma unroll
                    for (int r = 0; r < 16; ++r) { nM1[r] -= dl; O1[0][r] *= f; O1[1][r] *= f; } l1 *= f;
                }
                ATT_EXPSUM();
            }
#undef ATT_QK
#undef ATT_EXPSUM
            if (c == 0) l0 += ps; else l1 += ps;
#pragma unroll
            for (int sub = 0; sub < 2; ++sub)
#pragma unroll
                for (int sp = 0; sp < 2; ++sp) pf[c][sub][sp] = pack8(cvt4(S[sub][8 * sp], S[sub][8 * sp + 1], S[sub][8 * sp + 2], S[sub][8 * sp + 3]), cvt4(S[sub][8 * sp + 4], S[sub][8 * sp + 5], S[sub][8 * sp + 6], S[sub][8 * sp + 7]));
        }
#pragma unroll
        for (int vt = 0; vt < 2; ++vt) {
            f16x4 vlo[4], vhi[4];
#pragma unroll
            for (int k4 = 0; k4 < 4; ++k4) { vlo[k4] = lds_tr(vb + vt * 4096 + k4 * 1024); vhi[k4] = lds_tr(vb + vt * 4096 + k4 * 1024 + 512); }
            __builtin_amdgcn_sched_barrier(0);
#pragma unroll
            for (int k4 = 0; k4 < 4; ++k4) {
                const f16x8 vf = pack8(vlo[k4], vhi[k4]);
                O0[vt] = MFMA32(vf, pf[0][k4 >> 1][k4 & 1], O0[vt]);
                if (TYPE == 0) O1[vt] = MFMA32(vf, pf[TYPE ? 0 : 1][k4 >> 1][k4 & 1], O1[vt]);
            }
            __builtin_amdgcn_sched_barrier(0);
        }
        if (t + 1 < NT) {
            if (t + 2 < NT) { if (two) { ATT_WAITBAR(3); } else { ATT_WAITBAR(2); } } else { ATT_WAITBAR(0); }
        }
        s_nx2 = s_cur; s_cur = (s_cur == 2) ? 0 : s_cur + 1;
    }
#undef ATT_DMA
    f16* o = WSP(f16, WS_OCAT) + row * DM + (TYPE ? 768 : 0) + hd * 64 + 8 * hi;
    if (TYPE) {
        l0 += __shfl_xor(l0, 32);
        const float inv = 1.0f / l0;
#pragma unroll
        for (int vt = 0; vt < 2; ++vt)
#pragma unroll
            for (int k = 0; k < 2; ++k) *(f16x8*)(o + 32 * vt + 16 * k) = pair8(cvt4(O0[vt][8 * k] * inv, O0[vt][8 * k + 1] * inv, O0[vt][8 * k + 2] * inv, O0[vt][8 * k + 3] * inv),
                                                                                   cvt4(O0[vt][8 * k + 4] * inv, O0[vt][8 * k + 5] * inv, O0[vt][8 * k + 6] * inv, O0[vt][8 * k + 7] * inv));
    } else {
        l0 += __shfl_xor(l0, 32); l1 += __shfl_xor(l1, 32);
        const float i0 = 1.0f / l0, i1 = lam / l1;
        float ss = 0.f;
#pragma unroll
        for (int vt = 0; vt < 2; ++vt)
#pragma unroll
            for (int r = 0; r < 16; ++r) { const float v = O0[vt][r] * i0 - O1[vt][r] * i1; O0[vt][r] = v; ss += v * v; }
        ss += __shfl_xor(ss, 32);
        const float rs = (1.0f / sqrtf(ss * (1.0f / 64.0f) + EPS)) * (1.0f - lam_init);
        const float* sg = C.in[I_DSUB] + (size_t)l * 64 + 4 * hi;
        f32x4 sgv[2][4];
#pragma unroll
        for (int vt = 0; vt < 2; ++vt)
#pragma unroll
            for (int g = 0; g < 4; ++g) sgv[vt][g] = *(const f32x4*)(sg + 32 * vt + 8 * g);
#pragma unroll
        for (int vt = 0; vt < 2; ++vt)
#pragma unroll
            for (int k = 0; k < 2; ++k) { const f32x4 ga = sgv[vt][2 * k], gb = sgv[vt][2 * k + 1];
                *(f16x8*)(o + 32 * vt + 16 * k) = pair8(cvt4(O0[vt][8 * k] * rs * ga[0], O0[vt][8 * k + 1] * rs * ga[1], O0[vt][8 * k + 2] * rs * ga[2], O0[vt][8 * k + 3] * rs * ga[3]),
                                                         cvt4(O0[vt][8 * k + 4] * rs * gb[0], O0[vt][8 * k + 5] * rs * gb[1], O0[vt][8 * k + 6] * rs * gb[2], O0[vt][8 * k + 7] * rs * gb[3])); }
    }
    ATT_LBAR();
}

template <int mode>
__device__ __forceinline__ void phase_mx(const Ctx& C0, int l, unsigned* ctr, const XcdBarrier& bar, unsigned* sb, unsigned* sbA) {
    const Ctx C = ctx_fresh(C0);
    const bool tail = sbA != nullptr;
#pragma unroll 1
    for (int st = 0; st < 3; ++st) {
        const int what = tail ? ((st + 2) % 3) : st;
        if (what == 0) {
            if (tail) split_wait(bar, sbA + 2048, C.wave);
#pragma unroll 1
            for (int k = 0; ; ++k) {
                int u = C.bid + k * C.G;
                if (tail && k == 2) u = (C.bid >= 64 && C.bid < 96) ? C.bid + 448 : 544;
                if (u >= 544) break;
                ATT_LBAR();
                if (mode == 1 || mode == 4) continue;
#ifndef NO_MXT
                const int lane = lane_id_fresh();
                if (u < 288) {
                    const int g = u >> 2, hd = u & 3;
                    const f16* wsrc = ((g < 64) ? WSP(f16, WS_WUKV) : WSP(f16, WS_WUKV0)) + ((size_t)(l * 4 + hd) * 32) * 512 + lane * 8;
#pragma unroll
                    for (int i = 0; i < 4; ++i) ATT_GLDS(wsrc + (C.wave + 8 * i) * 512, C.lds + (C.wave + 8 * i) * 1024);
                    if (g < 32) mx_kv<0>(C, l, g * 8 + C.wave, hd, C.lds); else if (g < 64) mx_kv<1>(C, l, g * 8 + C.wave, hd, C.lds); else mx_kv<2>(C, l, 512 + (g - 64) * 8 + C.wave, hd, C.lds);
                } else {
                    const int v = u - 288, g = v >> 2, hd = v & 3;
                    const f16* wsrc = WSP(f16, WS_WUQ) + ((size_t)(l * 4 + hd) * 36) * 512 + lane * 8;
#pragma unroll
                    for (int i = 0; i < 5; ++i) if (C.wave + 8 * i < 36) ATT_GLDS(wsrc + (C.wave + 8 * i) * 512, C.lds + (C.wave + 8 * i) * 1024);
                    if (g < 32) mx_q<0>(C, l, g * 8 + C.wave, hd, C.lds); else mx_q<1>(C, l, g * 8 + C.wave, hd, C.lds);
                }
#endif
            }
        } else if (what == 1) {
            constexpr int NA = 512 + 576 + 576;
#ifndef NO_MXT
            if (mode != 1 && mode != 3) {
                int it = tail ? ((C.bid >= 64) ? (C.bid - 64) * 8 + C.wave : NA) : (C.ngw - 1 - C.gw);
#pragma unroll 1
                while (it < NA) {
                    if (it < 512) { if (it < 256) mx_a<0, 0>(C, l, it); else mx_a<1, 0>(C, l, it); }
                    else if (it < 1088) { const int w = it - 512; if (w < 256) mx_a<0, 1>(C, l, w); else if (w < 512) mx_a<1, 1>(C, l, w); else mx_a<2, 1>(C, l, w); }
                    else { const int w = it - 1088; if (w < 256) mx_a<0, 2>(C, l, w); else if (w < 512) mx_a<1, 2>(C, l, w); else mx_a<2, 2>(C, l, w); }
                    it = tail ? ((C.bid >= 240 && it < 1536) ? 1536 + (C.bid - 240) * 8 + C.wave : NA) : it + C.ngw;
                }
            }
#endif
            if (sb) split_arrive(bar, sb, C.wave);
        } else {
            if (tail) split_wait(bar, sbA, C.wave);
#ifndef NO_LRU1
            if (mode != 2 && mode != 3 && mode != 4)
#pragma unroll 1
                for (int i = C.gw; i < 2048; i += C.ngw) { if (C.wave >= 4) __builtin_amdgcn_s_sleep(48);
            lru_item<false>(C, l, i >> 3, i & 7); }
#endif
            if (sb) split_arrive(bar, sb + 2048, C.wave);
        }
    }
}
template <int mode>
__device__ __forceinline__ void phase_att(const Ctx& C0, int l, unsigned* ctr, const XcdBarrier& bar, unsigned* sb) {
    const Ctx C = ctx_fresh(C0);
    if (sb) split_wait(bar, sb, C.wave);
    const int half = C.G >> 1;
    if (mode != 1) {
#pragma unroll 1
        for (int u = C.bid; u < 128; u += half) { if (C.bid >= half) break;
#ifndef NO_ATTA
            if (mode == 0 || mode == 2 || mode == 5) { const int pr = (u & 7) * 2 + ((u >> 3) >> 3), qb = (u >> 3) & 7;
                attn_unit<0>(C, l, 1, pr >> 2, pr & 3, qb); }
#endif
        }
        if (C.bid >= half) {
#pragma unroll 1
            for (int u = C.bid - half; u < 128; u += half) {
#ifndef NO_ATTC
                if (mode == 0 || mode == 2 || mode == 6) { const int pr = (u & 7) * 2 + ((u >> 3) >> 3), qb = (u >> 3) & 7;
                    attn_unit<1>(C, l, 1, pr >> 2, pr & 3, qb); }
#endif
            }
#pragma unroll 1
            for (int u = C.bid - half; u < 128; u += half) {
#ifndef NO_ATTA
                if (mode == 0 || mode == 2 || mode == 7) attn_unit<0>(C, l, 0, u >> 2, u & 3, 0);
#endif
#ifndef NO_ATTC
                if (mode == 0 || mode == 2 || mode == 7) attn_unit<1>(C, l, 0, u >> 2, u & 3, 0);
#endif
            }
        }
    }
#ifndef NO_LRU2
    if (sb) split_wait(bar, sb + 2048, C.wave);
    if (mode == 0 || mode == 1) {
#pragma unroll 1
        for (int it = C.gw; it < 2048; it += C.ngw) lru2_item(C, l, it >> 3, it & 7);
    }
#endif
}

__global__ void __launch_bounds__(512, 2) mk_fwd(Args args) {
    extern __shared__ __attribute__((aligned(16))) unsigned char lds_raw[];
    Ctx C;
    C.in = args.in; C.out = args.out; C.ws = args.ws;
    C.lds = (LAS unsigned char*)lds_raw;
    C.tid = threadIdx.x; C.lane = C.tid & 63; C.wave = __builtin_amdgcn_readfirstlane(C.tid >> 6);
    C.gw = 0; C.ngw = 0; C.bid = 0; C.G = 0;
    volatile LAS unsigned* MISC = (volatile LAS unsigned*)(C.lds + MISC_OFF);
    for (int u = C.tid; u < (LDS_BYTES - LDSCTL_OFF) / 4; u += 512) ((LAS unsigned*)(C.lds + LDSCTL_OFF))[u] = 0u;
    __syncthreads();
    unsigned* ctl = (unsigned*)(args.ws + WS_CTL);
    XcdBarrier bar = xcd_barrier_post(ctl + CW_BAR, MISC + 8);
    if (C.tid == 0) (void)xb_add(ctl + CW_XCC + (blockIdx.x & 7) * 16 + (bar.x & 15u), 1u);
    const int lo = args.ph_lo, hi = args.ph_hi;
#define IN(k) (lo <= (k) && (k) < hi)
#define SEAM(k) do { if (IN(k) && IN((k) + 1)) xcd_barrier(bar); } while (0)

    int rep = 0, samexcd = 0;
#pragma unroll 1
    for (int p = lo; p < hi; ++p) {
        const int l = (p >= 10) ? 1 : 0, q = (p < 2) ? -1 - p : (p - 2 - 8 * l);
        int bid = blockIdx.x, G = gridDim.x; asm volatile("" : "+s"(bid), "+s"(G));
        const bool chain = (REP_Q == -9) && !MK_MULTI && (G == 256) && !CHAIN_OFF;
        const bool split = (REP_Q == -9) && !MK_MULTI && lo == 0;
        const bool tail = chain && split && q == 2 && l == 1;
        unsigned* const depp = ctl + CW_DEP + 1024 * p;
        const int wt = samexcd ^ 1;
        const float* modl = WSP(float, WS_MOD) + (size_t)l * 5 * NMODV;
        if (q == -1) {
#ifndef NO_PREP
            phase_prep(C);
#endif
        } else if (q == -2) {
            samexcd = (G == 256 && (unsigned)__builtin_amdgcn_readfirstlane(xb_ld(ctl + CW_XCC + (bid & 7) * 16 + (bar.x & 15u))) == (unsigned)(G >> 3)) ? 1 : 0;
            phase_norm<true>(C, 0, 0);
        }
        else if (q == 0 || q == 6) {
            const int s = (q == 6);
            pg8::Gemm g{WSP(f16, WS_H), WSP(f16, WS_WFI) + (size_t)(l * 2 + s) * NFF2 * 1024, M, NFF2, 1024}; pg8::ChainOrder S;
            S.init(M, NFF2, G, bid, chain ? ((q == 0 && l > 0) ? 1 : 0) : -1, (chain && p != 2) ? depp - 1024 : nullptr, 128u, chain ? depp : nullptr);
            pg8::EpiSwiglu E{WSP(f16, WS_ACT), wt};
            pg8::gemm_phase<pg8::EpiSwiglu, pg8::ChainOrder, true, true>(C.lds, g, S, E, C.wave);
        } else if (q == 1 || q == 7 || q == 5) {
            const int s = (q == 7);
            const f16* A = (q == 5) ? WSP(f16, WS_OCAT) : WSP(f16, WS_ACT);
            const f16* B = (q == 5) ? WSP(f16, WS_WOUT) + (size_t)l * 1024 * 1024 : WSP(f16, WS_WFO) + (size_t)(l * 2 + s) * 1024 * DFF;
            pg8::Gemm g{A, B, M, 1024, (q == 5) ? 1024 : DFF}; pg8::ChainOrder S;
            const int nl = (q == 7) ? l + 1 : l, nsub = (q == 1) ? 1 : ((q == 5) ? 2 : 0), donorm = (nl < DEPTH) ? 1 : 0, nlc = donorm ? nl : l;
            pg8::EpiResidNorm E{C.out, WSP(f16, WS_XH), modl, (q == 5) ? 5 : (s ? 8 : 2), (rep > 0) ? 0.0f : ((q == 5) ? 1.0f : 0.5f),
                                donorm, WSP(f16, WS_H), C.in[I_NG] + ((size_t)nlc * 3 + nsub) * DM, WSP(float, WS_MOD) + (size_t)nlc * 5 * NMODV + (3 * nsub) * DM,
                                WSP(float, WS_XBUF), ctl + CW_PAN + (p + 18 * rep) * 4096, wt};
            S.init(M, 1024, G, bid, chain ? ((q == 5) ? 3 : 2) : -1, (chain && q != 5) ? depp - 1024 : nullptr, 704u, (chain && donorm) ? depp : nullptr);
            if (q == 5) pg8::gemm_phase<pg8::EpiResidNorm, pg8::ChainOrder, false, true, false>(C.lds, g, S, E, C.wave);
            else pg8::gemm_phase<pg8::EpiResidNorm, pg8::ChainOrder, false, true, true>(C.lds, g, S, E, C.wave);
        } else if (q == 2) {
            pg8::Gemm g{WSP(f16, WS_H), WSP(f16, WS_WIN) + (size_t)l * DINP * 1024, M, DINP, 1024}; pg8::ChainOrder S;
            S.init(M, DINP, G, bid, chain ? ((l == 0) ? 4 : 5) : -1, chain ? depp - 1024 : nullptr, 128u, nullptr);
            pg8::EpiStore E{WSP(f16, WS_PROJ), DINP, (DIN - 1) / 256};
#pragma unroll 1
            for (int part = 0; part < (tail ? 2 : 1); ++part) {
                if (tail) { S.i0 = 2 * part; S.i1 = 2 + part; }
                pg8::gemm_phase<pg8::EpiStore, pg8::ChainOrder, true, true>(C.lds, g, S, E, C.wave);
                if (tail) split_arrive(bar, ctl + CW_SB + 8192 + 2048 * part, C.wave);
            }
        } else if (q == 3) { if (REP_MODE != 0 && rep) phase_mx<REP_MODE>(C, l, ctl + CW_Q + 64 * (p + 32 * rep), bar, nullptr, nullptr); else phase_mx<0>(C, l, ctl + CW_Q + 64 * (p + 32 * rep), bar, split ? ctl + CW_SB + 4096 * l : nullptr, (chain && split && l == 1) ? ctl + CW_SB + 8192 : nullptr); }
        else if (q == 4) { if (REP_MODE != 0 && rep) phase_att<REP_MODE>(C, l, ctl + CW_Q + 64 * (p + 32 * rep), bar, nullptr); else phase_att<0>(C, l, ctl + CW_Q + 64 * (p + 32 * rep), bar, split ? ctl + CW_SB + 4096 * l : nullptr); }
        if (REP_Q == 99 && p == 1) { for (int k = 0; k < 10; ++k) xcd_barrier(bar, C.wave); }
        if (q == REP_Q && rep < REP_N) { ++rep; --p; xcd_barrier(bar, C.wave); continue; }
        rep = 0;
        if (p + 1 < hi && (CHAIN_BARS || !chain || p < 2 || (q == 2 && !tail) || (q == 3 && !split) || q == 4)) xcd_barrier(bar, C.wave);
    }
#undef IN
#undef SEAM
}

extern "C" void kernel_launch(void* const* d_in, const int* in_sizes, int n_in, void* d_out, int out_size, void* d_ws, size_t ws_size, hipStream_t stream) {
    static int grid = 0;
    if (grid == 0) {
        if (n_in != N_IN || ws_size < WS_END || out_size != 27852800) { fprintf(stderr, "kernel_launch: unexpected shapes: n_in %d ws %zu out %d\n", n_in, ws_size, out_size); grid = -1; return; }
        int dev = 0, cus = 0, per_cu = 0;
        if (hipGetDevice(&dev) != hipSuccess || hipDeviceGetAttribute(&cus, hipDeviceAttributeMultiprocessorCount, dev) != hipSuccess) { grid = -1; return; }
        if (hipFuncSetAttribute((const void*)mk_fwd, hipFuncAttributeMaxDynamicSharedMemorySize, LDS_BYTES) != hipSuccess) { fprintf(stderr, "kernel_launch: hipFuncSetAttribute failed\n"); grid = -1; return; }
        if (hipOccupancyMaxActiveBlocksPerMultiprocessor(&per_cu, (const void*)mk_fwd, 512, LDS_BYTES) != hipSuccess || per_cu < 1) { fprintf(stderr, "kernel_launch: occupancy query says %d\n", per_cu); per_cu = 1; }
        (void)hipGetLastError();
        grid = cus;
    }
    if (grid < 0) return;
    if (hipMemsetAsync((char*)d_ws + WS_CTL, 0, CTL_ZERO_BYTES, stream) != hipSuccess) return;
    Args a{};
    for (int i = 0; i < N_IN; ++i) a.in[i] = (const float*)d_in[i];
    a.out = (float*)d_out; a.ws = (unsigned char*)d_ws;
#if MK_MULTI
    for (int p = 0; p < MK_PH_HI; ++p) { a.ph_lo = p; a.ph_hi = p + 1; hipLaunchKernelGGL(mk_fwd, dim3(grid), dim3(512), LDS_BYTES, stream, a); }
#else
    a.ph_lo = 0; a.ph_hi = MK_PH_HI;
    void* kargs[] = {&a};
    hipError_t e = hipLaunchCooperativeKernel((const void*)mk_fwd, dim3(grid), dim3(512), kargs, LDS_BYTES, stream);
    if (e != hipSuccess) { (void)hipGetLastError(); fprintf(stderr, "kernel_launch: cooperative launch failed (%s), plain launch instead\n", hipGetErrorString(e));
        hipLaunchKernelGGL(mk_fwd, dim3(grid), dim3(512), LDS_BYTES, stream, a); }
#endif
}
```
